# Optimizing an MI355X kernel written in HIP

```python
import math
import jax
import jax.numpy as jnp
from jax import lax
import numpy as np

D_MODEL = 2048
BATCH = 4
SEQ = 4096
DEPTH = 1

HEAD_DIM = 128
ROPE_DIM = HEAD_DIM // 4
NOPE_DIM = HEAD_DIM - ROPE_DIM
ROPE_THETA = 500000.0
EPS = 1e-6
NEG = -1e30

N_HEADS_A = 8
WIDTH_A = N_HEADS_A * HEAD_DIM
Q_RANK = 512
KV_RANK = 256
IDX_HEADS = 16
IDX_DIM = 64
IDX_ROPE = IDX_DIM // 4
TOPK_MAX = 256
QUERY_BLOCK = 128

N_HEADS_B = 8
WIDTH_B = N_HEADS_B * HEAD_DIM
DILATED_CONFIGS = ((128, 1), (512, 4), (2048, 16))
BAND_BLOCK = 128

MIX_WIDTH = WIDTH_A + WIDTH_B
IN_SPLITS = (Q_RANK, KV_RANK, ROPE_DIM, IDX_DIM, IDX_HEADS, WIDTH_A,
             WIDTH_B, WIDTH_B, WIDTH_B, WIDTH_B)
IN_WIDTH = sum(IN_SPLITS)

kernel_name = 'hybrid_dsa_dilated_parallel_heads'


def rms_norm(x, g):
    xf = x.astype(jnp.float32)
    y = xf * lax.rsqrt(jnp.mean(xf * xf, axis=-1, keepdims=True) + EPS)
    return (y * g.astype(jnp.float32)).astype(x.dtype)


def partial_rope(x, n_rot):
    L = x.shape[1]
    inv = ROPE_THETA ** (-jnp.arange(0, n_rot, 2, dtype=jnp.float32) / n_rot)
    ang = jnp.arange(L, dtype=jnp.float32)[:, None] * inv[None, :]
    cos = jnp.cos(ang).astype(x.dtype)[None, :, None, :]
    sin = jnp.sin(ang).astype(x.dtype)[None, :, None, :]
    half = n_rot // 2
    x1 = x[..., :half]
    x2 = x[..., half:n_rot]
    return jnp.concatenate([x1 * cos - x2 * sin, x2 * cos + x1 * sin, x[..., n_rot:]], axis=-1)


def dsa_branch(cq, ckv, krope, kidx, widx, g_q, g_kv, w_uq, w_uq_idx, w_uk, w_uv):
    Bsz, L, _ = cq.shape
    k_sel = min(TOPK_MAX, L // 4)
    nb = L // QUERY_BLOCK
    scale = HEAD_DIM ** -0.5
    cq = rms_norm(cq, g_q)
    q = partial_rope((cq @ w_uq).reshape(Bsz, L, N_HEADS_A, HEAD_DIM), ROPE_DIM)
    q_rope, q_nope = q[..., :ROPE_DIM], q[..., ROPE_DIM:]
    q_lat = jnp.einsum('blhn,hnr->blhr', q_nope, w_uk)
    q_idx = partial_rope((cq @ w_uq_idx).reshape(Bsz, L, IDX_HEADS, IDX_DIM), IDX_ROPE)
    w_idx = widx * (IDX_HEADS ** -0.5 * IDX_DIM ** -0.5)
    c_kv = rms_norm(ckv, g_kv)
    k_rope = partial_rope(krope[:, :, None, :], ROPE_DIM)[:, :, 0]
    k_idx = partial_rope(kidx[:, :, None, :], IDX_ROPE)[:, :, 0]
    key_pos = jnp.arange(L)
    gather = jax.vmap(lambda a, i: a[i])

    def attend_block(blk):
        ql, qr, qi, wi, qpos = blk
        logits = jnp.einsum('bqhd,bsd->bqhs', qi, k_idx)
        isc = jnp.einsum('bqh,bqhs->bqs', wi, jax.nn.relu(logits)).astype(jnp.float32)
        causal = key_pos[None, :] <= qpos[:, None]
        isc = jnp.where(causal[None], isc, NEG)
        _, idx = lax.top_k(isc, k_sel)
        valid = idx <= qpos[None, :, None]
        ckv_sel = gather(c_kv, idx)
        kr_sel = gather(k_rope, idx)
        s = (jnp.einsum('bqhr,bqkr->bqhk', ql, ckv_sel)
             + jnp.einsum('bqhe,bqke->bqhk', qr, kr_sel)).astype(jnp.float32) * scale
        s = jnp.where(valid[:, :, None, :], s, NEG)
        p = jax.nn.softmax(s, axis=-1).astype(ckv_sel.dtype)
        return jnp.einsum('bqhk,bqkr->bqhr', p, ckv_sel)

    def to_blocks(t):
        return jnp.moveaxis(t.reshape(Bsz, nb, QUERY_BLOCK, *t.shape[2:]), 1, 0)

    qpos = key_pos.reshape(nb, QUERY_BLOCK)
    o_lat = lax.map(attend_block, (to_blocks(q_lat), to_blocks(q_rope), to_blocks(q_idx),
                                   to_blocks(w_idx), qpos))
    o_lat = jnp.moveaxis(o_lat, 0, 1).reshape(Bsz, L, N_HEADS_A, KV_RANK)
    return jnp.einsum('blhr,hrv->blhv', o_lat, w_uv).reshape(Bsz, L, WIDTH_A)


def dilated_window_attention(q, k, v, dil, n_back):
    Bsz, L, H, Dh = q.shape
    M = L // dil
    N = Bsz * dil
    P = BAND_BLOCK
    nb = -(-M // P)
    Mp = nb * P
    scale = Dh ** -0.5

    def to_res(t):
        return jnp.swapaxes(t.reshape(Bsz, M, dil, H, Dh), 1, 2).reshape(N, M, H, Dh)

    def key_blocks(t):
        tp = jnp.pad(t, ((0, 0), (P, Mp - M), (0, 0), (0, 0))).reshape(N, nb + 1, P, H, Dh)
        return jnp.concatenate([tp[:, :-1], tp[:, 1:]], axis=2)

    qb = jnp.pad(to_res(q), ((0, 0), (0, Mp - M), (0, 0), (0, 0))).reshape(N, nb, P, H, Dh)
    kb = key_blocks(to_res(k))
    vb = key_blocks(to_res(v))
    qpos = jnp.arange(Mp).reshape(nb, P)
    kpos = jnp.arange(nb)[:, None] * P - P + jnp.arange(2 * P)[None, :]
    rel = qpos[:, :, None] - kpos[:, None, :]
    allowed = (rel >= 0) & (rel <= n_back) & (kpos[:, None, :] >= 0)
    s = jnp.einsum('nbqhd,nbkhd->nbhqk', qb, kb).astype(jnp.float32) * scale
    s = jnp.where(allowed[None, :, None], s, NEG)
    lse = jax.nn.logsumexp(s, axis=-1)
    p = jnp.exp(s - lse[..., None]).astype(v.dtype)
    o = jnp.einsum('nbhqk,nbkhd->nbqhd', p, vb).reshape(N, Mp, H, Dh)[:, :M]
    lse = jnp.swapaxes(lse, 2, 3).reshape(N, Mp, H)[:, :M]
    o = jnp.swapaxes(o.reshape(Bsz, dil, M, H, Dh), 1, 2).reshape(Bsz, L, H, Dh)
    lse = jnp.swapaxes(lse.reshape(Bsz, dil, M, H), 1, 2).reshape(Bsz, L, H)
    return o, lse


def dilated_branch(qb, kb, vb):
    Bsz, L, _ = qb.shape
    q = partial_rope(qb.reshape(Bsz, L, N_HEADS_B, HEAD_DIM), ROPE_DIM)
    k = partial_rope(kb.reshape(Bsz, L, N_HEADS_B, HEAD_DIM), ROPE_DIM)
    v = vb.reshape(Bsz, L, N_HEADS_B, HEAD_DIM)
    outs, lses = [], []
    for window, dil in DILATED_CONFIGS:
        o, lse = dilated_window_attention(q, k, v, dil, window // dil)
        outs.append(o)
        lses.append(lse)
    alpha = jax.nn.softmax(jnp.stack(lses), axis=0)
    o = jnp.sum(alpha[..., None] * jnp.stack(outs).astype(jnp.float32), axis=0)
    return o.astype(q.dtype).reshape(Bsz, L, WIDTH_B)


def hybrid_layer(x, c, w_ada, b_ada, g_pre, g_post, w_in, g_q, g_kv, w_uq, w_uq_idx,
                 w_uk, w_uv, w_out):
    mod = jax.nn.silu(c) @ w_ada + b_ada
    shift, scale, gate = jnp.split(mod, 3, axis=-1)
    h = rms_norm(x, g_pre) * (1 + scale[:, None, :]) + shift[:, None, :]
    proj = h @ w_in
    split_points = [int(v) for v in np.cumsum(IN_SPLITS)[:-1]]
    (cq, ckv, krope, kidx, widx, gate_a, qb, kb, vb, gate_b) = jnp.split(proj, split_points, axis=-1)
    o_a = dsa_branch(cq, ckv, krope, kidx, widx, g_q, g_kv, w_uq, w_uq_idx, w_uk, w_uv) * jax.nn.silu(gate_a)
    o_b = dilated_branch(qb, kb, vb) * jax.nn.silu(gate_b)
    y = jnp.concatenate([o_a, o_b], axis=-1) @ w_out
    return x + gate[:, None, :] * rms_norm(y, g_post)


def setup_inputs(seed: int = 0) -> dict:
    key = jax.random.key(seed)
    ks = jax.random.split(key, 14)

    def nrm(k, shape, s):
        return jax.random.normal(k, shape, jnp.float32) * s

    return {
        'x': nrm(ks[0], (BATCH, SEQ, D_MODEL), 1.0),
        'c': nrm(ks[1], (BATCH, D_MODEL), 1.0),
        'w_ada': nrm(ks[2], (DEPTH, D_MODEL, 3 * D_MODEL), D_MODEL ** -0.5),
        'b_ada': nrm(ks[3], (DEPTH, 3 * D_MODEL), 0.01),
        'g_pre': 1.0 + nrm(ks[4], (DEPTH, D_MODEL), 0.01),
        'g_post': 1.0 + nrm(ks[5], (DEPTH, D_MODEL), 0.01),
        'w_in': nrm(ks[6], (DEPTH, D_MODEL, IN_WIDTH), D_MODEL ** -0.5),
        'g_q': 1.0 + nrm(ks[7], (DEPTH, Q_RANK), 0.01),
        'g_kv': 1.0 + nrm(ks[8], (DEPTH, KV_RANK), 0.01),
        'w_uq': nrm(ks[9], (DEPTH, Q_RANK, WIDTH_A), Q_RANK ** -0.5),
        'w_uq_idx': nrm(ks[10], (DEPTH, Q_RANK, IDX_HEADS * IDX_DIM), Q_RANK ** -0.5),
        'w_uk': nrm(ks[11], (DEPTH, N_HEADS_A, NOPE_DIM, KV_RANK), KV_RANK ** -0.5),
        'w_uv': nrm(ks[12], (DEPTH, N_HEADS_A, KV_RANK, HEAD_DIM), KV_RANK ** -0.5),
        'w_out': nrm(ks[13], (DEPTH, MIX_WIDTH, D_MODEL), MIX_WIDTH ** -0.5),
    }


def reference(x, c, w_ada, b_ada, g_pre, g_post, w_in, g_q, g_kv, w_uq, w_uq_idx,
              w_uk, w_uv, w_out):
    for layer in range(DEPTH):
        x = hybrid_layer(x, c, w_ada[layer], b_ada[layer], g_pre[layer], g_post[layer],
                         w_in[layer], g_q[layer], g_kv[layer], w_uq[layer], w_uq_idx[layer],
                         w_uk[layer], w_uv[layer], w_out[layer])
    return x
```

```cpp
#include <hip/hip_runtime.h>
#include <cstdint>
#include <cstdio>
#include <cmath>

#define LAS __attribute__((address_space(3)))
typedef _Float16 h16;
typedef _Float16 h16x2 __attribute__((ext_vector_type(2)));
typedef _Float16 h16x4 __attribute__((ext_vector_type(4)));
typedef _Float16 h16x8 __attribute__((ext_vector_type(8)));
typedef float f32x2 __attribute__((ext_vector_type(2)));
typedef float f32x4 __attribute__((ext_vector_type(4)));
typedef unsigned u32x2 __attribute__((ext_vector_type(2)));
typedef unsigned u32x4 __attribute__((ext_vector_type(4)));

constexpr int NB = 4, SEQ = 4096, T = NB * SEQ, DM = 2048;
constexpr int NW1 = 6144;
constexpr int NQ = 3328;
constexpr int KVW = 288;
constexpr float EPS = 1e-6f;
constexpr float SCQ = 0.08838834764831845f * 1.4426950408889634f;

constexpr size_t MiB = 1u << 20;
constexpr size_t WS_CTL = 0;
constexpr size_t WS_MODP = 1 * MiB;
constexpr size_t WS_ROPE32 = 2 * MiB;
constexpr size_t WS_ROPE16 = 2 * MiB + 512 * 1024;
constexpr size_t WS_SSQ = 3 * MiB;
constexpr size_t WS_SSY = 4 * MiB;
constexpr size_t WS_W1T = 8 * MiB;
constexpr size_t WS_WQT = 32 * MiB;
constexpr size_t WS_WUVT = 36 * MiB;
constexpr size_t WS_WOT = 38 * MiB;
constexpr size_t WS_KVC = 46 * MiB;
constexpr size_t WS_KIDX = 55 * MiB;
constexpr size_t WS_WIDX = 57 * MiB;
constexpr size_t WS_SMALL = 58 * MiB;
constexpr size_t WS_CQ = 66 * MiB;
constexpr size_t WS_SGA = 82 * MiB;
constexpr size_t WS_OAB = 114 * MiB;
constexpr size_t WS_QA = 178 * MiB;
constexpr size_t WS_QIDX = 250 * MiB;
constexpr size_t WS_IDX = 282 * MiB;
constexpr size_t WS_H = 298 * MiB;
constexpr size_t WS_QB = 362 * MiB;
constexpr size_t WS_KB = 394 * MiB;
constexpr size_t WS_VB = 426 * MiB;
constexpr size_t WS_SGB = 458 * MiB;
constexpr size_t WS_END = 490 * MiB;
constexpr size_t WS_S = 298 * MiB;
constexpr size_t WS_OLAT = 426 * MiB;
constexpr size_t WS_Y = 178 * MiB;

struct Params {
    const float *x, *c, *w_ada, *b_ada, *g_pre, *g_post, *w_in, *g_q, *g_kv, *w_uq, *w_uq_idx, *w_uk, *w_uv, *w_out;
    float* out; unsigned char* ws;
    int half; int pad;
};

__device__ __forceinline__ unsigned pk2h(float a, float b) { h16x2 t = {(h16)a, (h16)b}; return __builtin_bit_cast(unsigned, t); }
__device__ __forceinline__ float siluf(float v) { return v / (1.0f + __expf(-v)); }
__device__ __forceinline__ float wave_sum(float v) {
#pragma unroll
    for (int o = 1; o < 64; o <<= 1) v += __shfl_xor(v, o);
    return v;
}
__device__ __forceinline__ float wave_max(float v) {
#pragma unroll
    for (int o = 1; o < 64; o <<= 1) v = fmaxf(v, __shfl_xor(v, o));
    return v;
}

namespace pg8 {
constexpr int BM = 256, BK = 64, HALF = 128, HTB = HALF * BK * 2, STAGE_BYTES = 8 * HTB, NXCD = 8, WGM = 8;
__host__ __device__ __forceinline__ int lds_byte(int r, int c) { const int st = (r >> 4) * 2 + (c >> 5), rr = r & 15, cc = c & 31, ob = rr * 64 + cc * 2; return st * 1024 + (ob ^ (((ob >> 9) & 1) << 5)); }
__host__ __device__ __forceinline__ void stage_rc(int b, int& R, int& C) { const int st = b / 1024, sb = b % 1024, swz = sb ^ (((sb >> 9) & 1) << 5); R = (st >> 1) * 16 + swz / 64; C = (st & 1) * 32 + (swz % 64) / 2; }
__host__ __device__ __forceinline__ int perm32(int rho) { const int n = rho >> 4, i = rho & 15; return 8 * (i >> 2) + 4 * n + (i & 3); }

struct Unit { int pm, pn; };
struct Gemm { const h16* A; const h16* Bt; int M, N, K, lda, ldb, a_pn_off; };

struct StaticOrder {
    int nM, nN, nwg, G, c;
    __host__ __device__ void init(int M, int N, int G_, int c_) { nM = M / BM; nN = N / BM; nwg = nM * nN; G = G_; c = c_; }
    __host__ __device__ bool next(int i, Unit& u) const {
        const long L = (long)i * G + c; if (L >= nwg) return false;
        int wgid = (int)L; { const int q = nwg / NXCD, r = nwg % NXCD, xcd = wgid % NXCD, off = wgid / NXCD; wgid = (xcd < r ? xcd * (q + 1) : r * (q + 1) + (xcd - r) * q) + off; }
        const int nig = WGM * nN, gid = wgid / nig, fm = gid * WGM, gsz = (nM - fm) < WGM ? (nM - fm) : WGM;
        u.pm = fm + ((wgid % nig) % gsz); u.pn = (wgid % nig) / gsz; return true;
    }
};

template <class Epi>
__device__ __forceinline__ void gemm_phase(LAS unsigned char* lds, const Gemm g, const StaticOrder& S, const Epi& E) {
    const int tid = threadIdx.x, wid = __builtin_amdgcn_readfirstlane(tid >> 6), lane = tid & 63, wr = wid >> 2, wc = wid & 3, fr = lane & 15, fq = lane >> 4;
    const int K = g.K, nt = K / BK;
    unsigned voffA[2], voffB[2];
#pragma unroll
    for (int i = 0; i < 2; ++i) { int R, C; stage_rc(tid * 16 + i * 8192, R, C); const int Rb = (R & ~31) + perm32(R & 31);
        voffA[i] = (unsigned)(R * g.lda + C) * 2u; voffB[i] = (unsigned)(Rb * g.ldb + C) * 2u; }
    const size_t kstep = (size_t)(BK * 2);
    const size_t hstepA = (size_t)HALF * g.lda * 2, hstepB = (size_t)HALF * g.ldb * 2;
    const size_t tstepA = 2 * hstepA, tstepB = 2 * hstepB;
    const unsigned ldsw = (unsigned)wid * 1024u;
    const int aoff = lds_byte(wr * 64 + fr, fq * 8), boff = lds_byte(wc * 32 + fr, fq * 8);
#define PG8_SA(b, h) (((b) * 2 + (h)) * HTB)
#define PG8_SB(b, h) ((4 + (b) * 2 + (h)) * HTB)
#define PG8_STAGE(bufoff, gbase, voff) do { _Pragma("unroll") for (int _i = 0; _i < 2; ++_i) \
        __builtin_amdgcn_global_load_lds((const unsigned*)((const char*)(gbase) + (voff)[_i]), (LAS unsigned*)(lds + (bufoff) + ldsw + _i * 8192), 16, 0, 0); } while (0)
#define PG8_LDA(dst, b, h) do { _Pragma("unroll") for (int m = 0; m < 4; ++m) _Pragma("unroll") for (int k = 0; k < 2; ++k) dst[m][k] = *(const LAS h16x8*)(lds + PG8_SA(b, h) + aoff + m * 2048 + k * 1024); } while (0)
#define PG8_LDB(dst, b, h) do { _Pragma("unroll") for (int n = 0; n < 2; ++n) _Pragma("unroll") for (int k = 0; k < 2; ++k) dst[n][k] = *(const LAS h16x8*)(lds + PG8_SB(b, h) + boff + n * 2048 + k * 1024); } while (0)
#define PG8_MMA(ai, bj, At, Bt) do { __builtin_amdgcn_s_setprio(1); _Pragma("unroll") for (int m = 0; m < 4; ++m) _Pragma("unroll") for (int n = 0; n < 2; ++n) _Pragma("unroll") for (int k = 0; k < 2; ++k) \
        acc[ai][bj][m][n] = __builtin_amdgcn_mfma_f32_16x16x32_f16(Bt[n][k], At[m][k], acc[ai][bj][m][n], 0, 0, 0); __builtin_amdgcn_s_setprio(0); } while (0)
#define PG8_WAIT_V(n) asm volatile("s_waitcnt vmcnt(" #n ")" ::: "memory")
#define PG8_WAIT_L(n) asm volatile("s_waitcnt lgkmcnt(" #n ")" ::: "memory")
#define PG8_BAR __builtin_amdgcn_s_barrier()
#define PG8_SCHED __builtin_amdgcn_sched_barrier(0)
    Unit cur, nxt; int ui = 0;
    if (!S.next(0, cur)) return;
    f32x4 acc[2][2][4][2];
#pragma unroll
    for (int a = 0; a < 2; ++a)
#pragma unroll
        for (int b = 0; b < 2; ++b)
#pragma unroll
            for (int m = 0; m < 4; ++m)
#pragma unroll
                for (int n = 0; n < 2; ++n) acc[a][b][m][n] = (f32x4){0.f, 0.f, 0.f, 0.f};
    h16x8 At[4][2], B0[2][2], B1[2][2];
    const char* cA = (const char*)g.A + (size_t)cur.pm * tstepA + (size_t)cur.pn * g.a_pn_off * 2; const char* cB = (const char*)g.Bt + (size_t)cur.pn * tstepB;
    PG8_STAGE(PG8_SB(0, 0), cB, voffB); PG8_STAGE(PG8_SB(0, 1), cB + hstepB, voffB); PG8_STAGE(PG8_SA(0, 0), cA, voffA); PG8_STAGE(PG8_SA(0, 1), cA + hstepA, voffA);
    if (wr == 1) PG8_BAR;
    PG8_WAIT_V(2); PG8_BAR;
    PG8_STAGE(PG8_SB(1, 0), cB + kstep, voffB); PG8_STAGE(PG8_SA(1, 0), cA + kstep, voffA); PG8_STAGE(PG8_SB(1, 1), cB + hstepB + kstep, voffB);
    PG8_WAIT_V(6); PG8_BAR;
    for (;;) {
        const bool has_next = S.next(ui + 1, nxt);
        const char* nA = has_next ? (const char*)g.A + (size_t)nxt.pm * tstepA + (size_t)nxt.pn * g.a_pn_off * 2 : cA; const char* nB = has_next ? (const char*)g.Bt + (size_t)nxt.pn * tstepB : cB;
        for (int t = 0; t < nt; t += 2) {
            const bool last = (t == nt - 2);
            const char* a1 = cA + (size_t)(t + 1) * kstep;
            const char* a2 = last ? nA : cA + (size_t)(t + 2) * kstep; const char* b2 = last ? nB : cB + (size_t)(t + 2) * kstep;
            const char* a3 = a2 + kstep; const char* b3 = b2 + kstep;
            PG8_LDB(B0, 0, 0); PG8_LDB(B1, 0, 1); PG8_SCHED; PG8_LDA(At, 0, 0); PG8_STAGE(PG8_SA(1, 1), a1 + hstepA, voffA);
            PG8_WAIT_V(8); PG8_WAIT_L(0); PG8_BAR; PG8_MMA(0, 0, At, B0); PG8_MMA(0, 1, At, B1); PG8_BAR; PG8_SCHED;
            PG8_LDA(At, 0, 1); PG8_STAGE(PG8_SB(0, 0), b2, voffB); PG8_STAGE(PG8_SB(0, 1), b2 + hstepB, voffB); PG8_STAGE(PG8_SA(0, 0), a2, voffA);
            PG8_WAIT_V(8); PG8_WAIT_L(0); PG8_BAR; PG8_MMA(1, 0, At, B0); PG8_MMA(1, 1, At, B1); PG8_BAR; PG8_SCHED;
            PG8_LDB(B0, 1, 0); PG8_LDB(B1, 1, 1); PG8_SCHED; PG8_LDA(At, 1, 0); PG8_STAGE(PG8_SA(0, 1), a2 + hstepA, voffA);
            PG8_WAIT_V(8); PG8_WAIT_L(0); PG8_BAR; PG8_MMA(0, 0, At, B0); PG8_MMA(0, 1, At, B1); PG8_BAR; PG8_SCHED;
            PG8_LDA(At, 1, 1); PG8_STAGE(PG8_SB(1, 0), b3, voffB); PG8_STAGE(PG8_SB(1, 1), b3 + hstepB, voffB); PG8_STAGE(PG8_SA(1, 0), a3, voffA);
            PG8_WAIT_V(8); PG8_WAIT_L(0); PG8_BAR; PG8_MMA(1, 0, At, B0); PG8_MMA(1, 1, At, B1); PG8_BAR; PG8_SCHED;
        }
        if (wr == 0) PG8_BAR;
        E(acc, cur, wr, wc, fr, fq);
        if (!has_next) break;
#pragma unroll
        for (int a = 0; a < 2; ++a)
#pragma unroll
            for (int b = 0; b < 2; ++b)
#pragma unroll
                for (int m = 0; m < 4; ++m)
#pragma unroll
                    for (int n = 0; n < 2; ++n) acc[a][b][m][n] = (f32x4){0.f, 0.f, 0.f, 0.f};
        cur = nxt; cA = nA; cB = nB; ++ui;
        if (wr == 1) PG8_BAR;
    }
    PG8_WAIT_V(0);
    PG8_BAR;
#undef PG8_SA
#undef PG8_SB
#undef PG8_STAGE
#undef PG8_LDA
#undef PG8_LDB
#undef PG8_MMA
#undef PG8_WAIT_V
#undef PG8_WAIT_L
#undef PG8_BAR
#undef PG8_SCHED
}
}

using pg8::Unit;
__device__ __forceinline__ u32x4 pack8(const f32x4 a, const f32x4 b) { u32x4 w; w.x = pk2h(a[0], a[1]); w.y = pk2h(a[2], a[3]); w.z = pk2h(b[0], b[1]); w.w = pk2h(b[2], b[3]); return w; }

struct EpiProj {
    h16 *CQ, *KVC, *SGA, *QB, *KB, *VB, *SGB; float *SMALL, *SSQ; const float* rope32;
    __device__ __forceinline__ void operator()(const f32x4 (&acc)[2][2][4][2], const Unit& u, int wr, int wc, int fr, int fq) const {
        const int pn = u.pn;
#pragma unroll
        for (int ai = 0; ai < 2; ++ai)
#pragma unroll
            for (int m = 0; m < 4; ++m) {
                const int row = u.pm * 256 + ai * 128 + wr * 64 + m * 16 + fr;
                if (pn < 2) {
                    float s = 0.f;
#pragma unroll
                    for (int bj = 0; bj < 2; ++bj) { const f32x4 v0 = acc[ai][bj][m][0], v1 = acc[ai][bj][m][1];
                        s += (v0[0] * v0[0] + v0[1] * v0[1]) + (v0[2] * v0[2] + v0[3] * v0[3]) + (v1[0] * v1[0] + v1[1] * v1[1]) + (v1[2] * v1[2] + v1[3] * v1[3]);
                        *(u32x4*)(CQ + (size_t)row * 512 + pn * 256 + bj * 128 + wc * 32 + fq * 8) = pack8(v0, v1); }
                    s += __shfl_xor(s, 16); s += __shfl_xor(s, 32);
                    if (fq == 0) SSQ[(size_t)(pn * 4 + wc) * T + row] = s;
                } else if (pn == 2) {
#pragma unroll
                    for (int bj = 0; bj < 2; ++bj) *(u32x4*)(KVC + (size_t)row * KVW + bj * 128 + wc * 32 + fq * 8) = pack8(acc[ai][bj][m][0], acc[ai][bj][m][1]);
                } else if (pn == 3) {
                    float* p = SMALL + (size_t)row * 128 + wc * 32 + fq * 8;
                    *(f32x4*)p = acc[ai][0][m][0]; *(f32x4*)(p + 4) = acc[ai][0][m][1];
                } else if (pn < 8 || pn >= 20) {
                    h16* dst = (pn < 8 ? SGA + (pn - 4) * 256 : SGB + (pn - 20) * 256) + (size_t)row * 1024 + wc * 32 + fq * 8;
#pragma unroll
                    for (int bj = 0; bj < 2; ++bj) { f32x4 v0 = acc[ai][bj][m][0], v1 = acc[ai][bj][m][1];
#pragma unroll
                        for (int e = 0; e < 4; ++e) { v0[e] = siluf(v0[e]); v1[e] = siluf(v1[e]); }
                        *(u32x4*)(dst + bj * 128) = pack8(v0, v1); }
                } else if (pn >= 16) {
                    h16* dst = VB + (size_t)row * 1024 + (pn - 16) * 256 + wc * 32 + fq * 8;
#pragma unroll
                    for (int bj = 0; bj < 2; ++bj) *(u32x4*)(dst + bj * 128) = pack8(acc[ai][bj][m][0], acc[ai][bj][m][1]);
                } else {
                    const bool isq = pn < 12; const float sc = isq ? SCQ : 1.0f;
                    h16* dst = (isq ? QB + (pn - 8) * 256 : KB + (pn - 12) * 256) + (size_t)row * 1024 + wc * 32 + fq * 8;
                    const int pos = row & (SEQ - 1);
#pragma unroll
                    for (int bj = 0; bj < 2; ++bj) { f32x4 v0 = acc[ai][bj][m][0], v1 = acc[ai][bj][m][1];
                        if (wc == 0) {
                            const float* cs = rope32 + ((size_t)pos * 16 + 8 * (fq & 1)) * 2;
                            const float sg = (fq < 2) ? -1.f : 1.f;
#pragma unroll
                            for (int e = 0; e < 4; ++e) { const float p0 = __shfl_xor(v0[e], 32), p1 = __shfl_xor(v1[e], 32);
                                const f32x2 c0 = *(const f32x2*)(cs + 2 * e), c1 = *(const f32x2*)(cs + 2 * (4 + e));
                                v0[e] = v0[e] * c0.x + sg * p0 * c0.y; v1[e] = v1[e] * c1.x + sg * p1 * c1.y; }
                        }
                        v0 = v0 * sc; v1 = v1 * sc;
                        *(u32x4*)(dst + bj * 128) = pack8(v0, v1); }
                }
            }
    }
};

struct EpiQ {
    h16 *QA, *QIDX; const float *SSQ, *rope32, *rope16;
    __device__ __forceinline__ void operator()(const f32x4 (&acc)[2][2][4][2], const Unit& u, int wr, int wc, int fr, int fq) const {
        const int pn = u.pn;
#pragma unroll
        for (int ai = 0; ai < 2; ++ai)
#pragma unroll
            for (int m = 0; m < 4; ++m) {
                const int row = u.pm * 256 + ai * 128 + wr * 64 + m * 16 + fr;
                float ss = 0.f;
#pragma unroll
                for (int p = 0; p < 8; ++p) ss += SSQ[(size_t)p * T + row];
                const float rstd = 1.0f / sqrtf(ss * (1.0f / 512.0f) + EPS);
                const int pos = row & (SEQ - 1);
#pragma unroll
                for (int bj = 0; bj < 2; ++bj) { f32x4 v0 = acc[ai][bj][m][0] * rstd, v1 = acc[ai][bj][m][1] * rstd;
                    if (pn == 0) {
                        const float* cs = rope32 + ((size_t)pos * 16 + 8 * (fq & 1)) * 2;
                        const float sg = (fq < 2) ? -1.f : 1.f;
#pragma unroll
                        for (int e = 0; e < 4; ++e) { const float p0 = __shfl_xor(v0[e], 32), p1 = __shfl_xor(v1[e], 32);
                            const f32x2 c0 = *(const f32x2*)(cs + 2 * e), c1 = *(const f32x2*)(cs + 2 * (4 + e));
                            v0[e] = v0[e] * c0.x + sg * p0 * c0.y; v1[e] = v1[e] * c1.x + sg * p1 * c1.y; }
                        v0 = v0 * SCQ; v1 = v1 * SCQ;
                        *(u32x4*)(QA + ((size_t)row * 8 + (4 * bj + wc)) * KVW + 256 + fq * 8) = pack8(v0, v1);
                    } else if (pn < 9) {
                        v0 = v0 * SCQ; v1 = v1 * SCQ;
                        *(u32x4*)(QA + ((size_t)row * 8 + (pn - 1)) * KVW + bj * 128 + wc * 32 + fq * 8) = pack8(v0, v1);
                    } else {
                        if ((wc & 1) == 0) {
                            const float* cs = rope16 + (size_t)pos * 16;
                            const float sg = (fq == 0) ? -1.f : 1.f;
#pragma unroll
                            for (int e = 0; e < 4; ++e) { const float p0 = __shfl_xor(v0[e], 16), p1 = __shfl_xor(v1[e], 16);
                                const f32x2 c0 = *(const f32x2*)(cs + 2 * e), c1 = *(const f32x2*)(cs + 2 * (4 + e));
                                if (fq < 2) { v0[e] = v0[e] * c0.x + sg * p0 * c0.y; v1[e] = v1[e] * c1.x + sg * p1 * c1.y; } }
                        }
                        *(u32x4*)(QIDX + (size_t)row * 1024 + (pn - 9) * 256 + bj * 128 + wc * 32 + fq * 8) = pack8(v0, v1);
                    } }
            }
    }
};

struct EpiOA {
    h16* OAB; const h16* SGA;
    __device__ __forceinline__ void operator()(const f32x4 (&acc)[2][2][4][2], const Unit& u, int wr, int wc, int fr, int fq) const {
#pragma unroll
        for (int ai = 0; ai < 2; ++ai)
#pragma unroll
            for (int m = 0; m < 4; ++m) {
                const int row = u.pm * 256 + ai * 128 + wr * 64 + m * 16 + fr;
#pragma unroll
                for (int bj = 0; bj < 2; ++bj) { const int col = u.pn * 256 + bj * 128 + wc * 32 + fq * 8;
                    const h16x8 g = *(const h16x8*)(SGA + (size_t)row * 1024 + col);
                    f32x4 v0 = acc[ai][bj][m][0], v1 = acc[ai][bj][m][1];
#pragma unroll
                    for (int e = 0; e < 4; ++e) { v0[e] *= (float)g[e]; v1[e] *= (float)g[4 + e]; }
                    *(u32x4*)(OAB + (size_t)row * 2048 + col) = pack8(v0, v1); }
            }
    }
};

struct EpiY {
    h16* Y; float* SSY;
    __device__ __forceinline__ void operator()(const f32x4 (&acc)[2][2][4][2], const Unit& u, int wr, int wc, int fr, int fq) const {
#pragma unroll
        for (int ai = 0; ai < 2; ++ai)
#pragma unroll
            for (int m = 0; m < 4; ++m) {
                const int row = u.pm * 256 + ai * 128 + wr * 64 + m * 16 + fr;
                float s = 0.f;
#pragma unroll
                for (int bj = 0; bj < 2; ++bj) { const f32x4 v0 = acc[ai][bj][m][0], v1 = acc[ai][bj][m][1];
                    s += (v0[0] * v0[0] + v0[1] * v0[1]) + (v0[2] * v0[2] + v0[3] * v0[3]) + (v1[0] * v1[0] + v1[1] * v1[1]) + (v1[2] * v1[2] + v1[3] * v1[3]);
                    *(u32x4*)(Y + (size_t)row * 2048 + u.pn * 256 + bj * 128 + wc * 32 + fq * 8) = pack8(v0, v1); }
                s += __shfl_xor(s, 16); s += __shfl_xor(s, 32);
                if (fq == 0) SSY[(size_t)(u.pn * 4 + wc) * T + row] = s;
            }
    }
};

constexpr int NTHR = 512, NWAVE = 8;
constexpr int LDS_BYTES = 147456;

__device__ __forceinline__ void p0_mod_unit(const Params& P, int unit, LAS unsigned char* lds) {
    const int tid = threadIdx.x, lane = tid & 63, w = tid >> 6, kc = unit >> 5, cc = unit & 31;
    LAS float* sc = (LAS float*)lds;
    LAS float* red = (LAS float*)(lds + 4096);
    for (int i = tid; i < 1024; i += NTHR) { const int b = i >> 8, kk = i & 255; sc[i] = siluf(P.c[b * DM + kc * 256 + kk]); }
    __syncthreads();
    f32x4 acc[4];
#pragma unroll
    for (int b = 0; b < 4; ++b) acc[b] = (f32x4){0.f, 0.f, 0.f, 0.f};
    if (lane < 48) {
        const float* wp = P.w_ada + (size_t)(kc * 256 + w * 32) * 6144 + cc * 192 + 4 * lane;
#pragma unroll 8
        for (int i = 0; i < 32; ++i) { const f32x4 wv = *(const f32x4*)(wp + (size_t)i * 6144);
#pragma unroll
            for (int b = 0; b < 4; ++b) acc[b] += wv * sc[b * 256 + w * 32 + i]; }
#pragma unroll
        for (int b = 0; b < 4; ++b) *(LAS f32x4*)(red + (w * 4 + b) * 192 + 4 * lane) = acc[b];
    }
    __syncthreads();
    float* MODP = (float*)(P.ws + WS_MODP);
    for (int o = tid; o < 768; o += NTHR) { const int b = o / 192, j = o % 192; float s = 0.f;
#pragma unroll
        for (int ww = 0; ww < 8; ++ww) s += red[(ww * 4 + b) * 192 + j];
        MODP[(size_t)(kc * 4 + b) * 6144 + cc * 192 + j] = s; }
    __syncthreads();
}
template <class SrcCol>
__device__ __forceinline__ void transpose_item(const float* W, int ldw, const float* kscale, h16* WT, int ldt, int k0, int n0, SrcCol srccol, LAS float* scr, int lane) {
    const int s = srccol(n0 + (lane & 31));
#pragma unroll 8
    for (int i = 0; i < 32; ++i) { const int kk = 2 * i + (lane >> 5); float v = (s >= 0) ? W[(size_t)(k0 + kk) * ldw + s] : 0.f; if (kscale) v *= kscale[k0 + kk]; scr[kk * 33 + (lane & 31)] = v; }
    asm volatile("s_waitcnt lgkmcnt(0)" ::: "memory");
    const int c = lane & 7;
#pragma unroll
    for (int j = 0; j < 4; ++j) { const int n = (lane >> 3) + 8 * j; const LAS float* sp = scr + (8 * c) * 33 + n;
        u32x4 o; o.x = pk2h(sp[0 * 33], sp[1 * 33]); o.y = pk2h(sp[2 * 33], sp[3 * 33]); o.z = pk2h(sp[4 * 33], sp[5 * 33]); o.w = pk2h(sp[6 * 33], sp[7 * 33]);
        *(u32x4*)(WT + (size_t)(n0 + n) * ldt + k0 + 8 * c) = o; }
    asm volatile("s_waitcnt lgkmcnt(0)" ::: "memory");
}
struct SrcW1 { __device__ int operator()(int n) const { return n < 880 ? n : (n < 1024 ? -1 : n - 144); } };
struct SrcId { __device__ int operator()(int n) const { return n; } };
struct SrcQRope { __device__ int operator()(int n) const { return (n >> 5) * 128 + (n & 31); } };

__device__ __forceinline__ void p0_fold_unit(const Params& P, int unit, LAS unsigned char* lds) {
    const int tid = threadIdx.x, h = unit >> 3, kb = unit & 7;
    LAS float* wuk = (LAS float*)lds;
    LAS float* wuq = (LAS float*)(lds + 98304);
    for (int i = tid; i < 96 * 256; i += NTHR) wuk[i] = P.w_uk[(size_t)h * 96 * 256 + i];
    for (int i = tid; i < 64 * 96; i += NTHR) { const int k = i / 96, nn = i % 96; wuq[i] = P.w_uq[(size_t)(kb * 64 + k) * 1024 + h * 128 + 32 + nn]; }
    __syncthreads();
    const int r = tid & 255, kh = tid >> 8;
    float acc[32];
#pragma unroll
    for (int i = 0; i < 32; ++i) acc[i] = 0.f;
    for (int nn = 0; nn < 96; ++nn) { const float b = wuk[nn * 256 + r];
#pragma unroll
        for (int i = 0; i < 32; ++i) acc[i] += wuq[(kh * 32 + i) * 96 + nn] * b; }
    h16* dst = (h16*)(P.ws + WS_WQT) + (size_t)(256 + h * 256 + r) * 512 + kb * 64 + kh * 32;
    const float* gq = P.g_q + kb * 64 + kh * 32;
#pragma unroll
    for (int i = 0; i < 32; i += 8) { u32x4 o; o.x = pk2h(acc[i] * gq[i], acc[i + 1] * gq[i + 1]); o.y = pk2h(acc[i + 2] * gq[i + 2], acc[i + 3] * gq[i + 3]);
        o.z = pk2h(acc[i + 4] * gq[i + 4], acc[i + 5] * gq[i + 5]); o.w = pk2h(acc[i + 6] * gq[i + 6], acc[i + 7] * gq[i + 7]); *(u32x4*)(dst + i) = o; }
    __syncthreads();
}
__device__ __forceinline__ void phase_prologue(const Params& P, LAS unsigned char* lds) {
    const int tid = threadIdx.x, lane = tid & 63, w = tid >> 6, G = gridDim.x, bid = blockIdx.x;
    for (int u = bid; u < 256; u += G) p0_mod_unit(P, u, lds);
    for (int u = bid; u < 64; u += G) p0_fold_unit(P, u, lds);
    {
        float* r32 = (float*)(P.ws + WS_ROPE32); float* r16 = (float*)(P.ws + WS_ROPE16);
        for (int e = bid * NTHR + tid; e < SEQ * 24; e += G * NTHR) {
            const int pos = e / 24, i = e % 24;
            const float inv = (i < 16) ? (float)pow(500000.0, -(double)i / 16.0) : (float)pow(500000.0, -(double)(i - 16) / 8.0);
            const float ang = (float)pos * inv;
            const float cv = (float)cos((double)ang), sv = (float)sin((double)ang);
            if (i < 16) { r32[((size_t)pos * 16 + i) * 2] = cv; r32[((size_t)pos * 16 + i) * 2 + 1] = sv; }
            else { r16[((size_t)pos * 8 + (i - 16)) * 2] = cv; r16[((size_t)pos * 8 + (i - 16)) * 2 + 1] = sv; }
        }
    }
    {
        h16* WUVT = (h16*)(P.ws + WS_WUVT);
        for (int e = bid * NTHR + tid; e < 1024 * 32; e += G * NTHR) { const int n = e >> 5, c8 = e & 31, hh = n >> 7; const int k = ((hh & 1) ? 0 : 256) + c8 * 8;
            *(u32x4*)(WUVT + (size_t)n * 512 + k) = (u32x4){0u, 0u, 0u, 0u}; }
    }
    LAS float* scr = (LAS float*)(lds + w * 16384);
    const int gw = bid * NWAVE + w, NGW = G * NWAVE;
    constexpr int I_W1 = 32 * 192, I_QR = 8 * 8, I_QI = 8 * 32, I_UV = 8 * 4 * 4, I_WO = 32 * 64;
    for (int it = gw; it < I_W1 + I_QR + I_QI + I_UV + I_WO; it += NGW) {
        int r = it;
        if (r < I_W1) { transpose_item(P.w_in, 6000, nullptr, (h16*)(P.ws + WS_W1T), 2048, (r / 192) * 64, (r % 192) * 32, SrcW1(), scr, lane); continue; } r -= I_W1;
        if (r < I_QR) { transpose_item(P.w_uq, 1024, P.g_q, (h16*)(P.ws + WS_WQT), 512, (r / 8) * 64, (r % 8) * 32, SrcQRope(), scr, lane); continue; } r -= I_QR;
        if (r < I_QI) { transpose_item(P.w_uq_idx, 1024, P.g_q, (h16*)(P.ws + WS_WQT) + (size_t)2304 * 512, 512, (r / 32) * 64, (r % 32) * 32, SrcId(), scr, lane); continue; } r -= I_QI;
        if (r < I_UV) { const int hh = r >> 4, kb = (r >> 2) & 3, nb = r & 3;
            transpose_item(P.w_uv + (size_t)hh * 256 * 128, 128, nullptr, (h16*)(P.ws + WS_WUVT) + (size_t)(hh * 128) * 512 + 256 * (hh & 1), 512, kb * 64, nb * 32, SrcId(), scr, lane); continue; } r -= I_UV;
        transpose_item(P.w_out, 2048, nullptr, (h16*)(P.ws + WS_WOT), 2048, (r / 64) * 64, (r % 64) * 32, SrcId(), scr, lane);
    }
}

__device__ __forceinline__ void load_mod(const Params& P, int b, int off, LAS float* dst, bool plus1) {
    const float* MODP = (const float*)(P.ws + WS_MODP);
    for (int j = threadIdx.x; j < 2048; j += NTHR) { float s = P.b_ada[off + j];
#pragma unroll
        for (int kc = 0; kc < 8; ++kc) s += MODP[(size_t)(kc * 4 + b) * 6144 + off + j];
        dst[j] = plus1 ? 1.0f + s : s; }
}
__device__ __forceinline__ void phase_h(const Params& P, LAS unsigned char* lds) {
    const int tid = threadIdx.x, lane = tid & 63, w = tid >> 6;
    LAS float* shift = (LAS float*)lds; LAS float* scale1 = (LAS float*)(lds + 8192);
    h16* H = (h16*)(P.ws + WS_H);
    for (int ch = blockIdx.x; ch < 256; ch += gridDim.x) {
        const int b = ch >> 6;
        __syncthreads();
        load_mod(P, b, 0, shift, false); load_mod(P, b, 2048, scale1, true);
        __syncthreads();
        for (int i = 0; i < 8; ++i) {
            const int row = ch * 64 + w * 8 + i;
            const float* xr = P.x + (size_t)row * DM + 4 * lane;
            f32x4 v[8]; float ss = 0.f;
#pragma unroll
            for (int j = 0; j < 8; ++j) { v[j] = *(const f32x4*)(xr + 256 * j); ss += (v[j][0] * v[j][0] + v[j][1] * v[j][1]) + (v[j][2] * v[j][2] + v[j][3] * v[j][3]); }
            const float rstd = 1.0f / sqrtf(wave_sum(ss) * (1.0f / DM) + EPS);
#pragma unroll
            for (int j = 0; j < 8; ++j) { const int col = 4 * lane + 256 * j; const f32x4 g = *(const f32x4*)(P.g_pre + col);
                const f32x4 s1 = *(const LAS f32x4*)(scale1 + col), sh = *(const LAS f32x4*)(shift + col);
                const f32x4 o = v[j] * rstd * g * s1 + sh; u32x2 pk; pk.x = pk2h(o[0], o[1]); pk.y = pk2h(o[2], o[3]);
                *(u32x2*)(H + (size_t)row * DM + col) = pk; }
        }
    }
}
__device__ __forceinline__ void phase_rowops(const Params& P) {
    const int tid = threadIdx.x, lane = tid & 63, w = tid >> 6;
    h16* KVC = (h16*)(P.ws + WS_KVC); h16* KIDX = (h16*)(P.ws + WS_KIDX); float* WIDX = (float*)(P.ws + WS_WIDX);
    const float* SMALL = (const float*)(P.ws + WS_SMALL); const float* r32 = (const float*)(P.ws + WS_ROPE32); const float* r16 = (const float*)(P.ws + WS_ROPE16);
    for (int row = blockIdx.x * NWAVE + w; row < T; row += gridDim.x * NWAVE) {
        const int pos = row & (SEQ - 1);
        h16* kr = KVC + (size_t)row * KVW;
        const h16x4 raw = *(const h16x4*)(kr + 4 * lane);
        float v[4]; float ss = 0.f;
#pragma unroll
        for (int e = 0; e < 4; ++e) { v[e] = (float)raw[e]; ss += v[e] * v[e]; }
        const float rstd = 1.0f / sqrtf(wave_sum(ss) * (1.0f / 256.0f) + EPS);
        const f32x4 g = *(const f32x4*)(P.g_kv + 4 * lane);
        u32x2 pk; pk.x = pk2h(v[0] * rstd * g[0], v[1] * rstd * g[1]); pk.y = pk2h(v[2] * rstd * g[2], v[3] * rstd * g[3]);
        *(u32x2*)(kr + 4 * lane) = pk;
        const float* sm = SMALL + (size_t)row * 128;
        if (lane < 32) {
            const int i = lane & 15; const float x1 = sm[i], x2 = sm[i + 16]; const float cv = r32[((size_t)pos * 16 + i) * 2], sv = r32[((size_t)pos * 16 + i) * 2 + 1];
            kr[256 + lane] = (h16)(lane < 16 ? x1 * cv - x2 * sv : x2 * cv + x1 * sv);
        }
        {
            float o = sm[32 + lane];
            if (lane < 16) { const int i = lane & 7; const float x1 = sm[32 + i], x2 = sm[32 + i + 8]; const float cv = r16[((size_t)pos * 8 + i) * 2], sv = r16[((size_t)pos * 8 + i) * 2 + 1];
                o = lane < 8 ? x1 * cv - x2 * sv : x2 * cv + x1 * sv; }
            KIDX[(size_t)row * 64 + lane] = (h16)o;
        }
        if (lane < 16) WIDX[(size_t)row * 16 + lane] = sm[96 + lane] * (1.0f / 32.0f);
    }
}
__device__ __forceinline__ void phase_final(const Params& P, LAS unsigned char* lds) {
    const int tid = threadIdx.x, lane = tid & 63, w = tid >> 6;
    LAS float* gate = (LAS float*)lds;
    const h16* Y = (const h16*)(P.ws + WS_Y); const float* SSY = (const float*)(P.ws + WS_SSY);
    for (int ch = blockIdx.x; ch < 256; ch += gridDim.x) {
        const int b = ch >> 6;
        __syncthreads();
        load_mod(P, b, 4096, gate, false);
        __syncthreads();
        for (int i = 0; i < 8; ++i) {
            const int row = ch * 64 + w * 8 + i;
            float ss = (lane < 32) ? SSY[(size_t)lane * T + row] : 0.f;
            const float rstd = 1.0f / sqrtf(wave_sum(ss) * (1.0f / DM) + EPS);
#pragma unroll
            for (int j = 0; j < 8; ++j) { const int col = 4 * lane + 256 * j;
                const f32x4 xv = *(const f32x4*)(P.x + (size_t)row * DM + col); const h16x4 yv = *(const h16x4*)(Y + (size_t)row * DM + col);
                const f32x4 g = *(const f32x4*)(P.g_post + col), gt = *(const LAS f32x4*)(gate + col);
                f32x4 o;
#pragma unroll
                for (int e = 0; e < 4; ++e) o[e] = xv[e] + gt[e] * ((float)yv[e] * rstd * g[e]);
                *(f32x4*)(P.out + (size_t)row * DM + col) = o; }
        }
    }
}

__global__ void __launch_bounds__(256) k_dilated(Params P) {
    __shared__ float qs[4][128]; __shared__ float ps[4][392];
    const int tid = threadIdx.x, lane = tid & 63, w = tid >> 6;
    const h16* QB = (const h16*)(P.ws + WS_QB); const h16* KB = (const h16*)(P.ws + WS_KB); const h16* VB = (const h16*)(P.ws + WS_VB); const h16* SGB = (const h16*)(P.ws + WS_SGB);
    h16* OAB = (h16*)(P.ws + WS_OAB);
    for (int item = blockIdx.x * 4 + w; item < T * 8; item += gridDim.x * 4) {
        const int row = item >> 3, h = item & 7, b = row >> 12, t = row & (SEQ - 1);
        { const h16x2 q2 = *(const h16x2*)(QB + (size_t)row * 1024 + h * 128 + 2 * lane); qs[w][2 * lane] = (float)q2[0]; qs[w][2 * lane + 1] = (float)q2[1]; }
        float sv[7]; float mx = -INFINITY;
#pragma unroll
        for (int i = 0; i < 7; ++i) {
            const int e = lane + 64 * i; sv[i] = -INFINITY;
            if (e < 387) { const int c = e / 129, j = e % 129, dil = c == 0 ? 1 : (c == 1 ? 4 : 16), kt = t - j * dil;
                if (kt >= 0) { const h16* kr = KB + (size_t)(b * SEQ + kt) * 1024 + h * 128; float s = 0.f;
                    for (int d = 0; d < 128; d += 8) { const h16x8 kv = *(const h16x8*)(kr + d);
#pragma unroll
                        for (int x = 0; x < 8; ++x) s += qs[w][d + x] * (float)kv[x]; }
                    sv[i] = s; } }
            mx = fmaxf(mx, sv[i]);
        }
        mx = wave_max(mx);
        float sum = 0.f;
#pragma unroll
        for (int i = 0; i < 7; ++i) { const int e = lane + 64 * i; const float p = (sv[i] == -INFINITY) ? 0.f : exp2f(sv[i] - mx); sum += p; if (e < 392) ps[w][e] = p; }
        sum = wave_sum(sum);
        float a0 = 0.f, a1 = 0.f;
        for (int e = 0; e < 387; ++e) { const int c = e / 129, j = e % 129, dil = c == 0 ? 1 : (c == 1 ? 4 : 16), kt = t - j * dil;
            if (kt >= 0) { const float p = ps[w][e]; const h16x2 v2 = *(const h16x2*)(VB + (size_t)(b * SEQ + kt) * 1024 + h * 128 + 2 * lane); a0 += p * (float)v2[0]; a1 += p * (float)v2[1]; } }
        const float inv = 1.0f / sum;
        const h16x2 g2 = *(const h16x2*)(SGB + (size_t)row * 1024 + h * 128 + 2 * lane);
        const h16x2 o2 = {(h16)(a0 * inv * (float)g2[0]), (h16)(a1 * inv * (float)g2[1])};
        *(h16x2*)(OAB + (size_t)row * 2048 + 1024 + h * 128 + 2 * lane) = o2;
    }
}

__global__ void __launch_bounds__(256) k_scores(Params P) {
    __shared__ float qv[16 * 64]; __shared__ float wv[16];
    const int tid = threadIdx.x;
    const h16* QIDX = (const h16*)(P.ws + WS_QIDX); const h16* KIDX = (const h16*)(P.ws + WS_KIDX); const float* WIDX = (const float*)(P.ws + WS_WIDX);
    float* S = (float*)(P.ws + WS_S);
    for (int rl = blockIdx.x; rl < 8192; rl += gridDim.x) {
        const int row = P.half * 8192 + rl, b = row >> 12, t = row & (SEQ - 1);
        __syncthreads();
        for (int i = tid; i < 1024; i += 256) qv[i] = (float)QIDX[(size_t)row * 1024 + i];
        if (tid < 16) wv[tid] = WIDX[(size_t)row * 16 + tid];
        __syncthreads();
        for (int k = tid; k <= t; k += 256) {
            float kf[64];
            const h16* kr = KIDX + (size_t)(b * SEQ + k) * 64;
#pragma unroll
            for (int d = 0; d < 64; d += 8) { const h16x8 kv = *(const h16x8*)(kr + d);
#pragma unroll
                for (int x = 0; x < 8; ++x) kf[d + x] = (float)kv[x]; }
            float acc = 0.f;
            for (int h = 0; h < 16; ++h) { float dt = 0.f;
#pragma unroll
                for (int d = 0; d < 64; ++d) dt += qv[h * 64 + d] * kf[d];
                acc += wv[h] * fmaxf(dt, 0.f); }
            S[(size_t)rl * SEQ + k] = acc + 0.0f;
        }
    }
}

__global__ void __launch_bounds__(256) k_select(Params P) {
    const int tid = threadIdx.x, lane = tid & 63, w = tid >> 6;
    const float* S = (const float*)(P.ws + WS_S); int* IDX = (int*)(P.ws + WS_IDX);
    for (int rl = blockIdx.x * 4 + w; rl < 8192; rl += gridDim.x * 4) {
        const int row = P.half * 8192 + rl, t = row & (SEQ - 1), n = t + 1;
        int* out = IDX + (size_t)row * 256;
        if (n <= 256) {
#pragma unroll
            for (int i = 0; i < 4; ++i) { const int k = lane + 64 * i; out[k] = (k < n) ? k : -1; }
            continue;
        }
        unsigned long long comp[64];
#pragma unroll
        for (int i = 0; i < 64; ++i) { const int k = 64 * i + lane; unsigned long long cv = 0ull;
            if (k < n) { const unsigned bits = __float_as_uint(S[(size_t)rl * SEQ + k]); const unsigned u = (bits & 0x80000000u) ? ~bits : (bits | 0x80000000u);
                cv = ((unsigned long long)u << 12) | (unsigned long long)(4095 - k); }
            comp[i] = cv; }
        unsigned long long thr = 0ull;
        for (int bit = 43; bit >= 0; --bit) {
            const unsigned long long cand = thr | (1ull << bit); int cnt = 0;
#pragma unroll
            for (int i = 0; i < 64; ++i) cnt += __popcll(__ballot(comp[i] >= cand));
            if (cnt >= 256) thr = cand;
        }
        int base = 0;
#pragma unroll
        for (int i = 0; i < 64; ++i) { const bool sel = comp[i] >= thr; const unsigned long long mk = __ballot(sel);
            const int pos = base + __popcll(mk & ((1ull << lane) - 1ull));
            if (sel && pos < 256) out[pos] = 64 * i + lane;
            base += __popcll(mk); }
    }
}

__global__ void __launch_bounds__(256) k_sparse(Params P) {
    __shared__ int idxs[4][256]; __shared__ float ps[4][256]; __shared__ float qs[4][288];
    const int tid = threadIdx.x, lane = tid & 63, w = tid >> 6;
    const h16* QA = (const h16*)(P.ws + WS_QA); const h16* KVC = (const h16*)(P.ws + WS_KVC); const int* IDX = (const int*)(P.ws + WS_IDX);
    h16* OLAT = (h16*)(P.ws + WS_OLAT);
    for (int row = blockIdx.x * 4 + w; row < T; row += gridDim.x * 4) {
        const int b = row >> 12;
#pragma unroll
        for (int i = 0; i < 4; ++i) idxs[w][lane + 64 * i] = IDX[(size_t)row * 256 + lane + 64 * i];
        for (int h = 0; h < 8; ++h) {
            const h16* qr = QA + ((size_t)row * 8 + h) * KVW;
            for (int d = lane; d < KVW; d += 64) qs[w][d] = (float)qr[d];
            float sv[4]; float mx = -INFINITY;
#pragma unroll
            for (int i = 0; i < 4; ++i) { const int id = idxs[w][lane + 64 * i]; sv[i] = -INFINITY;
                if (id >= 0) { const h16* kr = KVC + (size_t)(b * SEQ + id) * KVW; float s = 0.f;
                    for (int d = 0; d < KVW; d += 8) { const h16x8 kv = *(const h16x8*)(kr + d);
#pragma unroll
                        for (int x = 0; x < 8; ++x) s += qs[w][d + x] * (float)kv[x]; }
                    sv[i] = s; }
                mx = fmaxf(mx, sv[i]); }
            mx = wave_max(mx);
            float sum = 0.f;
#pragma unroll
            for (int i = 0; i < 4; ++i) { const float p = (sv[i] == -INFINITY) ? 0.f : exp2f(sv[i] - mx); sum += p; ps[w][lane + 64 * i] = p; }
            sum = wave_sum(sum);
            float a[4] = {0.f, 0.f, 0.f, 0.f};
            for (int j = 0; j < 256; ++j) { const int id = idxs[w][j];
                if (id >= 0) { const float p = ps[w][j]; const h16x4 v4 = *(const h16x4*)(KVC + (size_t)(b * SEQ + id) * KVW + 4 * lane);
#pragma unroll
                    for (int e = 0; e < 4; ++e) a[e] += p * (float)v4[e]; } }
            const float inv = 1.0f / sum;
            u32x2 pk; pk.x = pk2h(a[0] * inv, a[1] * inv); pk.y = pk2h(a[2] * inv, a[3] * inv);
            *(u32x2*)(OLAT + ((size_t)row * 8 + h) * 256 + 4 * lane) = pk;
        }
    }
}

extern __shared__ __attribute__((aligned(16))) unsigned char dyn_lds[];
__global__ void __launch_bounds__(NTHR, 2) k_prologue(Params P) { phase_prologue(P, (LAS unsigned char*)dyn_lds); }
__global__ void __launch_bounds__(NTHR, 2) k_h(Params P) { phase_h(P, (LAS unsigned char*)dyn_lds); }
__global__ void __launch_bounds__(NTHR, 2) k_gemm1(Params P) {
    pg8::Gemm g{(const h16*)(P.ws + WS_H), (const h16*)(P.ws + WS_W1T), T, NW1, DM, DM, DM, 0}; pg8::StaticOrder S; S.init(T, NW1, gridDim.x, blockIdx.x);
    EpiProj E{(h16*)(P.ws + WS_CQ), (h16*)(P.ws + WS_KVC), (h16*)(P.ws + WS_SGA), (h16*)(P.ws + WS_QB), (h16*)(P.ws + WS_KB), (h16*)(P.ws + WS_VB), (h16*)(P.ws + WS_SGB),
              (float*)(P.ws + WS_SMALL), (float*)(P.ws + WS_SSQ), (const float*)(P.ws + WS_ROPE32)};
    pg8::gemm_phase(( LAS unsigned char*)dyn_lds, g, S, E);
}
__global__ void __launch_bounds__(NTHR, 2) k_rowops(Params P) { phase_rowops(P); }
__global__ void __launch_bounds__(NTHR, 2) k_gemmq(Params P) {
    pg8::Gemm g{(const h16*)(P.ws + WS_CQ), (const h16*)(P.ws + WS_WQT), T, NQ, 512, 512, 512, 0}; pg8::StaticOrder S; S.init(T, NQ, gridDim.x, blockIdx.x);
    EpiQ E{(h16*)(P.ws + WS_QA), (h16*)(P.ws + WS_QIDX), (const float*)(P.ws + WS_SSQ), (const float*)(P.ws + WS_ROPE32), (const float*)(P.ws + WS_ROPE16)};
    pg8::gemm_phase((LAS unsigned char*)dyn_lds, g, S, E);
}
__global__ void __launch_bounds__(NTHR, 2) k_gemmoa(Params P) {
    pg8::Gemm g{(const h16*)(P.ws + WS_OLAT), (const h16*)(P.ws + WS_WUVT), T, 1024, 512, 2048, 512, 512}; pg8::StaticOrder S; S.init(T, 1024, gridDim.x, blockIdx.x);
    EpiOA E{(h16*)(P.ws + WS_OAB), (const h16*)(P.ws + WS_SGA)};
    pg8::gemm_phase((LAS unsigned char*)dyn_lds, g, S, E);
}
__global__ void __launch_bounds__(NTHR, 2) k_gemmy(Params P) {
    pg8::Gemm g{(const h16*)(P.ws + WS_OAB), (const h16*)(P.ws + WS_WOT), T, DM, DM, DM, DM, 0}; pg8::StaticOrder S; S.init(T, DM, gridDim.x, blockIdx.x);
    EpiY E{(h16*)(P.ws + WS_Y), (float*)(P.ws + WS_SSY)};
    pg8::gemm_phase((LAS unsigned char*)dyn_lds, g, S, E);
}
__global__ void __launch_bounds__(NTHR, 2) k_final(Params P) { phase_final(P, (LAS unsigned char*)dyn_lds); }

extern "C" void kernel_launch(void* const* d_in, const int* in_sizes, int n_in, void* d_out, int out_size, void* d_ws, size_t ws_size, hipStream_t stream) {
    static int ready = 0;
    if (!ready) {
        if (n_in != 14 || in_sizes[0] != T * DM || out_size != T * DM || ws_size < WS_END) { fprintf(stderr, "kernel_launch: unexpected shapes (n_in %d, in0 %d, out %d, ws %zu)\n", n_in, n_in > 0 ? in_sizes[0] : -1, out_size, ws_size); ready = -1; return; }
        const void* ks[] = {(const void*)k_prologue, (const void*)k_h, (const void*)k_gemm1, (const void*)k_rowops, (const void*)k_gemmq, (const void*)k_gemmoa, (const void*)k_gemmy, (const void*)k_final};
        for (const void* k : ks) if (hipFuncSetAttribute(k, hipFuncAttributeMaxDynamicSharedMemorySize, LDS_BYTES) != hipSuccess) { fprintf(stderr, "kernel_launch: hipFuncSetAttribute failed\n"); ready = -1; return; }
        ready = 1;
    }
    if (ready < 0) return;
    Params P{};
    P.x = (const float*)d_in[0]; P.c = (const float*)d_in[1]; P.w_ada = (const float*)d_in[2]; P.b_ada = (const float*)d_in[3]; P.g_pre = (const float*)d_in[4]; P.g_post = (const float*)d_in[5];
    P.w_in = (const float*)d_in[6]; P.g_q = (const float*)d_in[7]; P.g_kv = (const float*)d_in[8]; P.w_uq = (const float*)d_in[9]; P.w_uq_idx = (const float*)d_in[10]; P.w_uk = (const float*)d_in[11];
    P.w_uv = (const float*)d_in[12]; P.w_out = (const float*)d_in[13]; P.out = (float*)d_out; P.ws = (unsigned char*)d_ws; P.half = 0; P.pad = 0;
    const int G = 256;
    hipLaunchKernelGGL(k_prologue, dim3(G), dim3(NTHR), LDS_BYTES, stream, P);
    hipLaunchKernelGGL(k_h, dim3(G), dim3(NTHR), LDS_BYTES, stream, P);
    hipLaunchKernelGGL(k_gemm1, dim3(G), dim3(NTHR), LDS_BYTES, stream, P);
    hipLaunchKernelGGL(k_rowops, dim3(G), dim3(NTHR), LDS_BYTES, stream, P);
    hipLaunchKernelGGL(k_gemmq, dim3(G), dim3(NTHR), LDS_BYTES, stream, P);
    hipLaunchKernelGGL(k_dilated, dim3(2048), dim3(256), 0, stream, P);
    for (int half = 0; half < 2; ++half) { P.half = half;
        hipLaunchKernelGGL(k_scores, dim3(8192), dim3(256), 0, stream, P);
        hipLaunchKernelGGL(k_select, dim3(2048), dim3(256), 0, stream, P); }
    P.half = 0;
    hipLaunchKernelGGL(k_sparse, dim3(4096), dim3(256), 0, stream, P);
    hipLaunchKernelGGL(k_gemmoa, dim3(G), dim3(NTHR), LDS_BYTES, stream, P);
    hipLaunchKernelGGL(k_gemmy, dim3(G), dim3(NTHR), LDS_BYTES, stream, P);
    hipLaunchKernelGGL(k_final, dim3(G), dim3(NTHR), LDS_BYTES, stream, P);
}
```

```cpp
#include <hip/hip_runtime.h>
#include <cstdint>
#include <cstdio>
#include <cmath>

#define LAS __attribute__((address_space(3)))
typedef _Float16 h16;
typedef _Float16 h16x2 __attribute__((ext_vector_type(2)));
typedef _Float16 h16x4 __attribute__((ext_vector_type(4)));
typedef _Float16 h16x8 __attribute__((ext_vector_type(8)));
typedef float f32x2 __attribute__((ext_vector_type(2)));
typedef float f32x4 __attribute__((ext_vector_type(4)));
typedef unsigned u32x2 __attribute__((ext_vector_type(2)));
typedef unsigned u32x4 __attribute__((ext_vector_type(4)));

constexpr int NB = 4, SEQ = 4096, T = NB * SEQ, DM = 2048;
constexpr int NW1 = 6144;
constexpr int NQ = 3328;
constexpr int KVW = 288;
constexpr float EPS = 1e-6f;
constexpr float SCQ = 0.08838834764831845f * 1.4426950408889634f;

constexpr size_t MiB = 1u << 20;
constexpr size_t WS_CTL = 0;
constexpr size_t WS_MODP = 1 * MiB;
constexpr size_t WS_ROPE32 = 2 * MiB;
constexpr size_t WS_ROPE16 = 2 * MiB + 512 * 1024;
constexpr size_t WS_SSQ = 3 * MiB;
constexpr size_t WS_SSY = 4 * MiB;
constexpr size_t WS_W1T = 8 * MiB;
constexpr size_t WS_WQT = 32 * MiB;
constexpr size_t WS_WUVT = 36 * MiB;
constexpr size_t WS_WOT = 38 * MiB;
constexpr size_t WS_KVC = 46 * MiB;
constexpr size_t WS_KIDX = 55 * MiB;
constexpr size_t WS_WIDX = 57 * MiB;
constexpr size_t WS_SMALL = 58 * MiB;
constexpr size_t WS_CQ = 66 * MiB;
constexpr size_t WS_SGA = 82 * MiB;
constexpr size_t WS_OAB = 114 * MiB;
constexpr size_t WS_QA = 178 * MiB;
constexpr size_t WS_QIDX = 250 * MiB;
constexpr size_t WS_IDX = 282 * MiB;
constexpr size_t WS_H = 298 * MiB;
constexpr size_t WS_QB = 362 * MiB;
constexpr size_t WS_KB = 394 * MiB;
constexpr size_t WS_VB = 426 * MiB;
constexpr size_t WS_SGB = 458 * MiB;
constexpr size_t WS_END = 490 * MiB;
constexpr size_t WS_S = 298 * MiB;
constexpr size_t WS_OLAT = 426 * MiB;
constexpr size_t WS_Y = 178 * MiB;

struct Params {
    const float *x, *c, *w_ada, *b_ada, *g_pre, *g_post, *w_in, *g_q, *g_kv, *w_uq, *w_uq_idx, *w_uk, *w_uv, *w_out;
    float* out; unsigned char* ws;
    int ph_lo, ph_hi;
};

__device__ __forceinline__ unsigned pk2h(float a, float b) { h16x2 t = {(h16)a, (h16)b}; return __builtin_bit_cast(unsigned, t); }
__device__ __forceinline__ float siluf(float v) { return v / (1.0f + __expf(-v)); }
__device__ __forceinline__ float wave_sum(float v) {
#pragma unroll
    for (int o = 1; o < 64; o <<= 1) v += __shfl_xor(v, o);
    return v;
}
__device__ __forceinline__ float wave_max(float v) {
#pragma unroll
    for (int o = 1; o < 64; o <<= 1) v = fmaxf(v, __shfl_xor(v, o));
    return v;
}

namespace pg8 {
constexpr int BM = 256, BK = 64, HALF = 128, HTB = HALF * BK * 2, STAGE_BYTES = 8 * HTB, NXCD = 8, WGM = 8;
__host__ __device__ __forceinline__ int lds_byte(int r, int c) { const int st = (r >> 4) * 2 + (c >> 5), rr = r & 15, cc = c & 31, ob = rr * 64 + cc * 2; return st * 1024 + (ob ^ (((ob >> 9) & 1) << 5)); }
__host__ __device__ __forceinline__ void stage_rc(int b, int& R, int& C) { const int st = b / 1024, sb = b % 1024, swz = sb ^ (((sb >> 9) & 1) << 5); R = (st >> 1) * 16 + swz / 64; C = (st & 1) * 32 + (swz % 64) / 2; }
__host__ __device__ __forceinline__ int perm32(int rho) { const int n = rho >> 4, i = rho & 15; return 8 * (i >> 2) + 4 * n + (i & 3); }

struct Unit { int pm, pn; };
struct Gemm { const h16* A; const h16* Bt; int M, N, K, lda, ldb, a_pn_off; };

struct StaticOrder {
    int nM, nN, nwg, G, c;
    __device__ void init(int M, int N, int G_, int c_) { nM = M / BM; nN = N / BM; nwg = nM * nN; G = __builtin_amdgcn_readfirstlane(G_); c = __builtin_amdgcn_readfirstlane(c_); }
    __device__ bool next(int i, Unit& u) const {
        const int L = __builtin_amdgcn_readfirstlane(i * G + c); if (L >= nwg) return false;
        int wgid = L; { const int q = nwg / NXCD, r = nwg % NXCD, xcd = wgid % NXCD, off = wgid / NXCD; wgid = (xcd < r ? xcd * (q + 1) : r * (q + 1) + (xcd - r) * q) + off; }
        const int nig = WGM * nN, gid = wgid / nig, fm = gid * WGM, gsz = (nM - fm) < WGM ? (nM - fm) : WGM;
        u.pm = __builtin_amdgcn_readfirstlane(fm + ((wgid % nig) % gsz)); u.pn = __builtin_amdgcn_readfirstlane((wgid % nig) / gsz); return true;
    }
};

template <class Epi>
__device__ __forceinline__ void gemm_phase(LAS unsigned char* lds, const Gemm g, const StaticOrder& S, const Epi& E) {
    const int tid = threadIdx.x, wid = __builtin_amdgcn_readfirstlane(tid >> 6), lane = tid & 63, wr = wid >> 2, wc = wid & 3, fr = lane & 15, fq = lane >> 4;
    const int K = g.K, nt = K / BK;
    unsigned voffA[2], voffB[2];
#pragma unroll
    for (int i = 0; i < 2; ++i) { int R, C; stage_rc(tid * 16 + i * 8192, R, C); const int Rb = (R & ~31) + perm32(R & 31);
        voffA[i] = (unsigned)(R * g.lda + C) * 2u; voffB[i] = (unsigned)(Rb * g.ldb + C) * 2u; }
    const size_t kstep = (size_t)(BK * 2);
    const size_t hstepA = (size_t)HALF * g.lda * 2, hstepB = (size_t)HALF * g.ldb * 2;
    const size_t tstepA = 2 * hstepA, tstepB = 2 * hstepB;
    const unsigned ldsw = (unsigned)wid * 1024u;
    const int aoff = lds_byte(wr * 64 + fr, fq * 8), boff = lds_byte(wc * 32 + fr, fq * 8);
#define PG8_SA(b, h) (((b) * 2 + (h)) * HTB)
#define PG8_SB(b, h) ((4 + (b) * 2 + (h)) * HTB)
#define PG8_STAGE(bufoff, gbase, voff) do { _Pragma("unroll") for (int _i = 0; _i < 2; ++_i) \
        __builtin_amdgcn_global_load_lds((const unsigned*)((const char*)(gbase) + (voff)[_i]), (LAS unsigned*)(lds + (bufoff) + ldsw + _i * 8192), 16, 0, 0); } while (0)
#define PG8_LDA(dst, b, h) do { _Pragma("unroll") for (int m = 0; m < 4; ++m) _Pragma("unroll") for (int k = 0; k < 2; ++k) dst[m][k] = *(const LAS h16x8*)(lds + PG8_SA(b, h) + aoff + m * 2048 + k * 1024); } while (0)
#define PG8_LDB(dst, b, h) do { _Pragma("unroll") for (int n = 0; n < 2; ++n) _Pragma("unroll") for (int k = 0; k < 2; ++k) dst[n][k] = *(const LAS h16x8*)(lds + PG8_SB(b, h) + boff + n * 2048 + k * 1024); } while (0)
#define PG8_MMA(ai, bj, At, Bt) do { __builtin_amdgcn_s_setprio(1); _Pragma("unroll") for (int m = 0; m < 4; ++m) _Pragma("unroll") for (int n = 0; n < 2; ++n) _Pragma("unroll") for (int k = 0; k < 2; ++k) \
        acc[ai][bj][m][n] = __builtin_amdgcn_mfma_f32_16x16x32_f16(Bt[n][k], At[m][k], acc[ai][bj][m][n], 0, 0, 0); __builtin_amdgcn_s_setprio(0); } while (0)
#define PG8_WAIT_V(n) asm volatile("s_waitcnt vmcnt(" #n ")" ::: "memory")
#define PG8_WAIT_L(n) asm volatile("s_waitcnt lgkmcnt(" #n ")" ::: "memory")
#define PG8_BAR __builtin_amdgcn_s_barrier()
#define PG8_SCHED __builtin_amdgcn_sched_barrier(0)
    Unit cur, nxt; int ui = 0;
    if (!S.next(0, cur)) return;
    f32x4 acc[2][2][4][2];
#pragma unroll
    for (int a = 0; a < 2; ++a)
#pragma unroll
        for (int b = 0; b < 2; ++b)
#pragma unroll
            for (int m = 0; m < 4; ++m)
#pragma unroll
                for (int n = 0; n < 2; ++n) acc[a][b][m][n] = (f32x4){0.f, 0.f, 0.f, 0.f};
    h16x8 At[4][2], B0[2][2], B1[2][2];
    const char* cA = (const char*)g.A + (size_t)cur.pm * tstepA + (size_t)cur.pn * g.a_pn_off * 2; const char* cB = (const char*)g.Bt + (size_t)cur.pn * tstepB;
    PG8_STAGE(PG8_SB(0, 0), cB, voffB); PG8_STAGE(PG8_SB(0, 1), cB + hstepB, voffB); PG8_STAGE(PG8_SA(0, 0), cA, voffA); PG8_STAGE(PG8_SA(0, 1), cA + hstepA, voffA);
    if (wr == 1) PG8_BAR;
    PG8_WAIT_V(2); PG8_BAR;
    PG8_STAGE(PG8_SB(1, 0), cB + kstep, voffB); PG8_STAGE(PG8_SA(1, 0), cA + kstep, voffA); PG8_STAGE(PG8_SB(1, 1), cB + hstepB + kstep, voffB);
    PG8_WAIT_V(6); PG8_BAR;
    for (;;) {
        const bool has_next = S.next(ui + 1, nxt);
        const char* nA = has_next ? (const char*)g.A + (size_t)nxt.pm * tstepA + (size_t)nxt.pn * g.a_pn_off * 2 : cA; const char* nB = has_next ? (const char*)g.Bt + (size_t)nxt.pn * tstepB : cB;
        for (int t = 0; t < nt; t += 2) {
            const bool last = (t == nt - 2);
            const char* a1 = cA + (size_t)(t + 1) * kstep;
            const char* a2 = last ? nA : cA + (size_t)(t + 2) * kstep; const char* b2 = last ? nB : cB + (size_t)(t + 2) * kstep;
            const char* a3 = a2 + kstep; const char* b3 = b2 + kstep;
            PG8_LDB(B0, 0, 0); PG8_LDB(B1, 0, 1); PG8_SCHED; PG8_LDA(At, 0, 0); PG8_STAGE(PG8_SA(1, 1), a1 + hstepA, voffA);
            PG8_WAIT_V(8); PG8_WAIT_L(0); PG8_BAR; PG8_MMA(0, 0, At, B0); PG8_MMA(0, 1, At, B1); PG8_BAR; PG8_SCHED;
            PG8_LDA(At, 0, 1); PG8_STAGE(PG8_SB(0, 0), b2, voffB); PG8_STAGE(PG8_SB(0, 1), b2 + hstepB, voffB); PG8_STAGE(PG8_SA(0, 0), a2, voffA);
            PG8_WAIT_V(8); PG8_WAIT_L(0); PG8_BAR; PG8_MMA(1, 0, At, B0); PG8_MMA(1, 1, At, B1); PG8_BAR; PG8_SCHED;
            PG8_LDB(B0, 1, 0); PG8_LDB(B1, 1, 1); PG8_SCHED; PG8_LDA(At, 1, 0); PG8_STAGE(PG8_SA(0, 1), a2 + hstepA, voffA);
            PG8_WAIT_V(8); PG8_WAIT_L(0); PG8_BAR; PG8_MMA(0, 0, At, B0); PG8_MMA(0, 1, At, B1); PG8_BAR; PG8_SCHED;
            PG8_LDA(At, 1, 1); PG8_STAGE(PG8_SB(1, 0), b3, voffB); PG8_STAGE(PG8_SB(1, 1), b3 + hstepB, voffB); PG8_STAGE(PG8_SA(1, 0), a3, voffA);
            PG8_WAIT_V(8); PG8_WAIT_L(0); PG8_BAR; PG8_MMA(1, 0, At, B0); PG8_MMA(1, 1, At, B1); PG8_BAR; PG8_SCHED;
        }
        if (wr == 0) PG8_BAR;
        E(acc, cur, wr, wc, fr, fq);
        if (!has_next) break;
#pragma unroll
        for (int a = 0; a < 2; ++a)
#pragma unroll
            for (int b = 0; b < 2; ++b)
#pragma unroll
                for (int m = 0; m < 4; ++m)
#pragma unroll
                    for (int n = 0; n < 2; ++n) acc[a][b][m][n] = (f32x4){0.f, 0.f, 0.f, 0.f};
        cur = nxt; cA = nA; cB = nB; ++ui;
        if (wr == 1) PG8_BAR;
    }
    PG8_WAIT_V(0);
    PG8_BAR;
#undef PG8_SA
#undef PG8_SB
#undef PG8_STAGE
#undef PG8_LDA
#undef PG8_LDB
#undef PG8_MMA
#undef PG8_WAIT_V
#undef PG8_WAIT_L
#undef PG8_BAR
#undef PG8_SCHED
}
}

using pg8::Unit;
__device__ __forceinline__ u32x4 pack8(const f32x4 a, const f32x4 b) { u32x4 w; w.x = pk2h(a[0], a[1]); w.y = pk2h(a[2], a[3]); w.z = pk2h(b[0], b[1]); w.w = pk2h(b[2], b[3]); return w; }

struct EpiProj {
    h16 *CQ, *KVC, *SGA, *QB, *KB, *VB, *SGB; float *SMALL, *SSQ; const float* rope32;
    __device__ __forceinline__ void operator()(const f32x4 (&acc)[2][2][4][2], const Unit& u, int wr, int wc, int fr_in, int fq_in) const {
        int fr = fr_in, fq = fq_in; asm volatile("" : "+v"(fr), "+v"(fq));
        const int pn = u.pn;
#pragma unroll
        for (int ai = 0; ai < 2; ++ai)
#pragma unroll
            for (int m = 0; m < 4; ++m) {
                const int row = u.pm * 256 + ai * 128 + wr * 64 + m * 16 + fr;
                if (pn < 2) {
                    float s = 0.f;
#pragma unroll
                    for (int bj = 0; bj < 2; ++bj) { const f32x4 v0 = acc[ai][bj][m][0], v1 = acc[ai][bj][m][1];
                        s += (v0[0] * v0[0] + v0[1] * v0[1]) + (v0[2] * v0[2] + v0[3] * v0[3]) + (v1[0] * v1[0] + v1[1] * v1[1]) + (v1[2] * v1[2] + v1[3] * v1[3]);
                        *(u32x4*)(CQ + (size_t)row * 512 + pn * 256 + bj * 128 + wc * 32 + fq * 8) = pack8(v0, v1); }
                    s += __shfl_xor(s, 16); s += __shfl_xor(s, 32);
                    if (fq == 0) SSQ[(size_t)(pn * 4 + wc) * T + row] = s;
                } else if (pn == 2) {
#pragma unroll
                    for (int bj = 0; bj < 2; ++bj) *(u32x4*)(KVC + (size_t)row * KVW + bj * 128 + wc * 32 + fq * 8) = pack8(acc[ai][bj][m][0], acc[ai][bj][m][1]);
                } else if (pn == 3) {
                    float* p = SMALL + (size_t)row * 128 + wc * 32 + fq * 8;
                    *(f32x4*)p = acc[ai][0][m][0]; *(f32x4*)(p + 4) = acc[ai][0][m][1];
                } else if (pn < 8 || pn >= 20) {
                    h16* dst = (pn < 8 ? SGA + (pn - 4) * 256 : SGB + (pn - 20) * 256) + (size_t)row * 1024 + wc * 32 + fq * 8;
#pragma unroll
                    for (int bj = 0; bj < 2; ++bj) { f32x4 v0 = acc[ai][bj][m][0], v1 = acc[ai][bj][m][1];
#pragma unroll
                        for (int e = 0; e < 4; ++e) { v0[e] = siluf(v0[e]); v1[e] = siluf(v1[e]); }
                        *(u32x4*)(dst + bj * 128) = pack8(v0, v1); }
                } else if (pn >= 16) {
                    h16* dst = VB + (size_t)row * 1024 + (pn - 16) * 256 + wc * 32 + fq * 8;
#pragma unroll
                    for (int bj = 0; bj < 2; ++bj) *(u32x4*)(dst + bj * 128) = pack8(acc[ai][bj][m][0], acc[ai][bj][m][1]);
                } else {
                    const bool isq = pn < 12; const float sc = isq ? SCQ : 1.0f;
                    h16* dst = (isq ? QB + (pn - 8) * 256 : KB + (pn - 12) * 256) + (size_t)row * 1024 + wc * 32 + fq * 8;
                    const int pos = row & (SEQ - 1);
#pragma unroll
                    for (int bj = 0; bj < 2; ++bj) { f32x4 v0 = acc[ai][bj][m][0], v1 = acc[ai][bj][m][1];
                        if (wc == 0) {
                            const float* cs = rope32 + ((size_t)pos * 16 + 8 * (fq & 1)) * 2;
                            const float sg = (fq < 2) ? -1.f : 1.f;
#pragma unroll
                            for (int e = 0; e < 4; ++e) { const float p0 = __shfl_xor(v0[e], 32), p1 = __shfl_xor(v1[e], 32);
                                const f32x2 c0 = *(const f32x2*)(cs + 2 * e), c1 = *(const f32x2*)(cs + 2 * (4 + e));
                                v0[e] = v0[e] * c0.x + sg * p0 * c0.y; v1[e] = v1[e] * c1.x + sg * p1 * c1.y; }
                        }
                        v0 = v0 * sc; v1 = v1 * sc;
                        *(u32x4*)(dst + bj * 128) = pack8(v0, v1); }
                }
            }
    }
};

struct EpiQ {
    h16 *QA, *QIDX; const float *SSQ, *rope32, *rope16;
    __device__ __forceinline__ void operator()(const f32x4 (&acc)[2][2][4][2], const Unit& u, int wr, int wc, int fr_in, int fq_in) const {
        int fr = fr_in, fq = fq_in; asm volatile("" : "+v"(fr), "+v"(fq));
        const int pn = u.pn;
#pragma unroll
        for (int ai = 0; ai < 2; ++ai)
#pragma unroll
            for (int m = 0; m < 4; ++m) {
                const int row = u.pm * 256 + ai * 128 + wr * 64 + m * 16 + fr;
                float ss = 0.f;
#pragma unroll
                for (int p = 0; p < 8; ++p) ss += SSQ[(size_t)p * T + row];
                const float rstd = 1.0f / sqrtf(ss * (1.0f / 512.0f) + EPS);
                const int pos = row & (SEQ - 1);
#pragma unroll
                for (int bj = 0; bj < 2; ++bj) { f32x4 v0 = acc[ai][bj][m][0] * rstd, v1 = acc[ai][bj][m][1] * rstd;
                    if (pn == 0) {
                        const float* cs = rope32 + ((size_t)pos * 16 + 8 * (fq & 1)) * 2;
                        const float sg = (fq < 2) ? -1.f : 1.f;
#pragma unroll
                        for (int e = 0; e < 4; ++e) { const float p0 = __shfl_xor(v0[e], 32), p1 = __shfl_xor(v1[e], 32);
                            const f32x2 c0 = *(const f32x2*)(cs + 2 * e), c1 = *(const f32x2*)(cs + 2 * (4 + e));
                            v0[e] = v0[e] * c0.x + sg * p0 * c0.y; v1[e] = v1[e] * c1.x + sg * p1 * c1.y; }
                        v0 = v0 * SCQ; v1 = v1 * SCQ;
                        *(u32x4*)(QA + ((size_t)row * 8 + (4 * bj + wc)) * KVW + 256 + fq * 8) = pack8(v0, v1);
                    } else if (pn < 9) {
                        v0 = v0 * SCQ; v1 = v1 * SCQ;
                        *(u32x4*)(QA + ((size_t)row * 8 + (pn - 1)) * KVW + bj * 128 + wc * 32 + fq * 8) = pack8(v0, v1);
                    } else {
                        if ((wc & 1) == 0) {
                            const float* cs = rope16 + (size_t)pos * 16;
                            const float sg = (fq == 0) ? -1.f : 1.f;
#pragma unroll
                            for (int e = 0; e < 4; ++e) { const float p0 = __shfl_xor(v0[e], 16), p1 = __shfl_xor(v1[e], 16);
                                const f32x2 c0 = *(const f32x2*)(cs + 2 * e), c1 = *(const f32x2*)(cs + 2 * (4 + e));
                                if (fq < 2) { v0[e] = v0[e] * c0.x + sg * p0 * c0.y; v1[e] = v1[e] * c1.x + sg * p1 * c1.y; } }
                        }
                        *(u32x4*)(QIDX + (size_t)row * 1024 + (pn - 9) * 256 + bj * 128 + wc * 32 + fq * 8) = pack8(v0, v1);
                    } }
                asm volatile("" ::: "memory");
            }
    }
};

struct EpiOA {
    h16* OAB; const h16* SGA;
    __device__ __forceinline__ void operator()(const f32x4 (&acc)[2][2][4][2], const Unit& u, int wr, int wc, int fr_in, int fq_in) const {
        int fr = fr_in, fq = fq_in; asm volatile("" : "+v"(fr), "+v"(fq));
#pragma unroll
        for (int ai = 0; ai < 2; ++ai)
#pragma unroll
            for (int m = 0; m < 4; ++m) {
                const int row = u.pm * 256 + ai * 128 + wr * 64 + m * 16 + fr;
#pragma unroll
                for (int bj = 0; bj < 2; ++bj) { const int col = u.pn * 256 + bj * 128 + wc * 32 + fq * 8;
                    const h16x8 g = *(const h16x8*)(SGA + (size_t)row * 1024 + col);
                    f32x4 v0 = acc[ai][bj][m][0], v1 = acc[ai][bj][m][1];
#pragma unroll
                    for (int e = 0; e < 4; ++e) { v0[e] *= (float)g[e]; v1[e] *= (float)g[4 + e]; }
                    *(u32x4*)(OAB + (size_t)row * 2048 + col) = pack8(v0, v1); }
            }
    }
};

struct EpiY {
    h16* Y; float* SSY;
    __device__ __forceinline__ void operator()(const f32x4 (&acc)[2][2][4][2], const Unit& u, int wr, int wc, int fr_in, int fq_in) const {
        int fr = fr_in, fq = fq_in; asm volatile("" : "+v"(fr), "+v"(fq));
#pragma unroll
        for (int ai = 0; ai < 2; ++ai)
#pragma unroll
            for (int m = 0; m < 4; ++m) {
                const int row = u.pm * 256 + ai * 128 + wr * 64 + m * 16 + fr;
                float s = 0.f;
#pragma unroll
                for (int bj = 0; bj < 2; ++bj) { const f32x4 v0 = acc[ai][bj][m][0], v1 = acc[ai][bj][m][1];
                    s += (v0[0] * v0[0] + v0[1] * v0[1]) + (v0[2] * v0[2] + v0[3] * v0[3]) + (v1[0] * v1[0] + v1[1] * v1[1]) + (v1[2] * v1[2] + v1[3] * v1[3]);
                    *(u32x4*)(Y + (size_t)row * 2048 + u.pn * 256 + bj * 128 + wc * 32 + fq * 8) = pack8(v0, v1); }
                s += __shfl_xor(s, 16); s += __shfl_xor(s, 32);
                if (fq == 0) SSY[(size_t)(u.pn * 4 + wc) * T + row] = s;
            }
    }
};

constexpr int NTHR = 512, NWAVE = 8;
constexpr int LDS_SCR = 147456;
constexpr int LDS_BYTES = LDS_SCR + 4096;

__device__ __forceinline__ void p0_mod_unit(const Params& P, int unit, LAS unsigned char* lds) {
    const int tid = threadIdx.x, lane = tid & 63, w = tid >> 6, kc = unit >> 5, cc = unit & 31;
    LAS float* sc = (LAS float*)lds;
    LAS float* red = (LAS float*)(lds + 4096);
    for (int i = tid; i < 1024; i += NTHR) { const int b = i >> 8, kk = i & 255; sc[i] = siluf(P.c[b * DM + kc * 256 + kk]); }
    __syncthreads();
    f32x4 acc[4];
#pragma unroll
    for (int b = 0; b < 4; ++b) acc[b] = (f32x4){0.f, 0.f, 0.f, 0.f};
    if (lane < 48) {
        const float* wp = P.w_ada + (size_t)(kc * 256 + w * 32) * 6144 + cc * 192 + 4 * lane;
#pragma unroll 8
        for (int i = 0; i < 32; ++i) { const f32x4 wv = *(const f32x4*)(wp + (size_t)i * 6144);
#pragma unroll
            for (int b = 0; b < 4; ++b) acc[b] += wv * sc[b * 256 + w * 32 + i]; }
#pragma unroll
        for (int b = 0; b < 4; ++b) *(LAS f32x4*)(red + (w * 4 + b) * 192 + 4 * lane) = acc[b];
    }
    __syncthreads();
    float* MODP = (float*)(P.ws + WS_MODP);
    for (int o = tid; o < 768; o += NTHR) { const int b = o / 192, j = o % 192; float s = 0.f;
#pragma unroll
        for (int ww = 0; ww < 8; ++ww) s += red[(ww * 4 + b) * 192 + j];
        MODP[(size_t)(kc * 4 + b) * 6144 + cc * 192 + j] = s; }
    __syncthreads();
}
template <class SrcCol>
__device__ __forceinline__ void transpose_item(const float* W, int ldw, const float* kscale, h16* WT, int ldt, int k0, int n0, SrcCol srccol, LAS float* scr, int lane) {
    const int s = srccol(n0 + (lane & 31));
#pragma unroll 8
    for (int i = 0; i < 32; ++i) { const int kk = 2 * i + (lane >> 5); float v = (s >= 0) ? W[(size_t)(k0 + kk) * ldw + s] : 0.f; if (kscale) v *= kscale[k0 + kk]; scr[kk * 33 + (lane & 31)] = v; }
    asm volatile("s_waitcnt lgkmcnt(0)" ::: "memory");
    const int c = lane & 7;
#pragma unroll
    for (int j = 0; j < 4; ++j) { const int n = (lane >> 3) + 8 * j; const LAS float* sp = scr + (8 * c) * 33 + n;
        u32x4 o; o.x = pk2h(sp[0 * 33], sp[1 * 33]); o.y = pk2h(sp[2 * 33], sp[3 * 33]); o.z = pk2h(sp[4 * 33], sp[5 * 33]); o.w = pk2h(sp[6 * 33], sp[7 * 33]);
        *(u32x4*)(WT + (size_t)(n0 + n) * ldt + k0 + 8 * c) = o; }
    asm volatile("s_waitcnt lgkmcnt(0)" ::: "memory");
}
struct SrcW1 { __device__ int operator()(int n) const { return n < 880 ? n : (n < 1024 ? -1 : n - 144); } };
struct SrcId { __device__ int operator()(int n) const { return n; } };
struct SrcQRope { __device__ int operator()(int n) const { return (n >> 5) * 128 + (n & 31); } };

__device__ __forceinline__ void p0_fold_unit(const Params& P, int unit, LAS unsigned char* lds) {
    const int tid = threadIdx.x, h = unit >> 3, kb = unit & 7;
    LAS float* wuk = (LAS float*)lds;
    LAS float* wuq = (LAS float*)(lds + 98304);
    for (int i = tid; i < 96 * 256; i += NTHR) wuk[i] = P.w_uk[(size_t)h * 96 * 256 + i];
    for (int i = tid; i < 64 * 96; i += NTHR) { const int k = i / 96, nn = i % 96; wuq[i] = P.w_uq[(size_t)(kb * 64 + k) * 1024 + h * 128 + 32 + nn]; }
    __syncthreads();
    const int r = tid & 255, kh = tid >> 8;
    float acc[32];
#pragma unroll
    for (int i = 0; i < 32; ++i) acc[i] = 0.f;
    for (int nn = 0; nn < 96; ++nn) { const float b = wuk[nn * 256 + r];
#pragma unroll
        for (int i = 0; i < 32; ++i) acc[i] += wuq[(kh * 32 + i) * 96 + nn] * b; }
    h16* dst = (h16*)(P.ws + WS_WQT) + (size_t)(256 + h * 256 + r) * 512 + kb * 64 + kh * 32;
    const float* gq = P.g_q + kb * 64 + kh * 32;
#pragma unroll
    for (int i = 0; i < 32; i += 8) { u32x4 o; o.x = pk2h(acc[i] * gq[i], acc[i + 1] * gq[i + 1]); o.y = pk2h(acc[i + 2] * gq[i + 2], acc[i + 3] * gq[i + 3]);
        o.z = pk2h(acc[i + 4] * gq[i + 4], acc[i + 5] * gq[i + 5]); o.w = pk2h(acc[i + 6] * gq[i + 6], acc[i + 7] * gq[i + 7]); *(u32x4*)(dst + i) = o; }
    __syncthreads();
}
__device__ __forceinline__ void phase_prologue(const Params& P, LAS unsigned char* lds) {
    const int tid = threadIdx.x, lane = tid & 63, w = tid >> 6, G = gridDim.x, bid = blockIdx.x;
    for (int u = bid; u < 256; u += G) p0_mod_unit(P, u, lds);
    for (int u = bid; u < 64; u += G) p0_fold_unit(P, u, lds);
    {
        float* r32 = (float*)(P.ws + WS_ROPE32); float* r16 = (float*)(P.ws + WS_ROPE16);
        for (int e = bid * NTHR + tid; e < SEQ * 24; e += G * NTHR) {
            const int pos = e / 24, i = e % 24;
            const float inv = (i < 16) ? (float)pow(500000.0, -(double)i / 16.0) : (float)pow(500000.0, -(double)(i - 16) / 8.0);
            const float ang = (float)pos * inv;
            const float cv = (float)cos((double)ang), sv = (float)sin((double)ang);
            if (i < 16) { r32[((size_t)pos * 16 + i) * 2] = cv; r32[((size_t)pos * 16 + i) * 2 + 1] = sv; }
            else { r16[((size_t)pos * 8 + (i - 16)) * 2] = cv; r16[((size_t)pos * 8 + (i - 16)) * 2 + 1] = sv; }
        }
    }
    {
        h16* WUVT = (h16*)(P.ws + WS_WUVT);
        for (int e = bid * NTHR + tid; e < 1024 * 32; e += G * NTHR) { const int n = e >> 5, c8 = e & 31, hh = n >> 7; const int k = ((hh & 1) ? 0 : 256) + c8 * 8;
            *(u32x4*)(WUVT + (size_t)n * 512 + k) = (u32x4){0u, 0u, 0u, 0u}; }
    }
    LAS float* scr = (LAS float*)(lds + w * 16384);
    const int gw = bid * NWAVE + w, NGW = G * NWAVE;
    constexpr int I_W1 = 32 * 192, I_QR = 8 * 8, I_QI = 8 * 32, I_UV = 8 * 4 * 4, I_WO = 32 * 64;
    for (int it = gw; it < I_W1 + I_QR + I_QI + I_UV + I_WO; it += NGW) {
        int r = it;
        if (r < I_W1) { transpose_item(P.w_in, 6000, nullptr, (h16*)(P.ws + WS_W1T), 2048, (r / 192) * 64, (r % 192) * 32, SrcW1(), scr, lane); continue; } r -= I_W1;
        if (r < I_QR) { transpose_item(P.w_uq, 1024, P.g_q, (h16*)(P.ws + WS_WQT), 512, (r / 8) * 64, (r % 8) * 32, SrcQRope(), scr, lane); continue; } r -= I_QR;
        if (r < I_QI) { transpose_item(P.w_uq_idx, 1024, P.g_q, (h16*)(P.ws + WS_WQT) + (size_t)2304 * 512, 512, (r / 32) * 64, (r % 32) * 32, SrcId(), scr, lane); continue; } r -= I_QI;
        if (r < I_UV) { const int hh = r >> 4, kb = (r >> 2) & 3, nb = r & 3;
            transpose_item(P.w_uv + (size_t)hh * 256 * 128, 128, nullptr, (h16*)(P.ws + WS_WUVT) + (size_t)(hh * 128) * 512 + 256 * (hh & 1), 512, kb * 64, nb * 32, SrcId(), scr, lane); continue; } r -= I_UV;
        transpose_item(P.w_out, 2048, nullptr, (h16*)(P.ws + WS_WOT), 2048, (r / 64) * 64, (r % 64) * 32, SrcId(), scr, lane);
    }
}

__device__ __forceinline__ void load_mod(const Params& P, int b, int off, LAS float* dst, bool plus1) {
    const float* MODP = (const float*)(P.ws + WS_MODP);
    for (int j = threadIdx.x; j < 2048; j += NTHR) { float s = P.b_ada[off + j];
#pragma unroll
        for (int kc = 0; kc < 8; ++kc) s += MODP[(size_t)(kc * 4 + b) * 6144 + off + j];
        dst[j] = plus1 ? 1.0f + s : s; }
}
__device__ __forceinline__ void phase_h(const Params& P, LAS unsigned char* lds) {
    const int tid = threadIdx.x, lane = tid & 63, w = tid >> 6;
    LAS float* shift = (LAS float*)lds; LAS float* scale1 = (LAS float*)(lds + 8192);
    h16* H = (h16*)(P.ws + WS_H);
    for (int ch = blockIdx.x; ch < 256; ch += gridDim.x) {
        const int b = ch >> 6;
        __syncthreads();
        load_mod(P, b, 0, shift, false); load_mod(P, b, 2048, scale1, true);
        __syncthreads();
        for (int i = 0; i < 8; ++i) {
            const int row = ch * 64 + w * 8 + i;
            const float* xr = P.x + (size_t)row * DM + 4 * lane;
            f32x4 v[8]; float ss = 0.f;
#pragma unroll
            for (int j = 0; j < 8; ++j) { v[j] = *(const f32x4*)(xr + 256 * j); ss += (v[j][0] * v[j][0] + v[j][1] * v[j][1]) + (v[j][2] * v[j][2] + v[j][3] * v[j][3]); }
            const float rstd = 1.0f / sqrtf(wave_sum(ss) * (1.0f / DM) + EPS);
#pragma unroll
            for (int j = 0; j < 8; ++j) { const int col = 4 * lane + 256 * j; const f32x4 g = *(const f32x4*)(P.g_pre + col);
                const f32x4 s1 = *(const LAS f32x4*)(scale1 + col), sh = *(const LAS f32x4*)(shift + col);
                const f32x4 o = v[j] * rstd * g * s1 + sh; u32x2 pk; pk.x = pk2h(o[0], o[1]); pk.y = pk2h(o[2], o[3]);
                *(u32x2*)(H + (size_t)row * DM + col) = pk; }
        }
    }
}
__device__ __forceinline__ void phase_rowops(const Params& P) {
    const int tid = threadIdx.x, lane = tid & 63, w = tid >> 6;
    h16* KVC = (h16*)(P.ws + WS_KVC); h16* KIDX = (h16*)(P.ws + WS_KIDX); float* WIDX = (float*)(P.ws + WS_WIDX);
    const float* SMALL = (const float*)(P.ws + WS_SMALL); const float* r32 = (const float*)(P.ws + WS_ROPE32); const float* r16 = (const float*)(P.ws + WS_ROPE16);
    for (int row = blockIdx.x * NWAVE + w; row < T; row += gridDim.x * NWAVE) {
        const int pos = row & (SEQ - 1);
        h16* kr = KVC + (size_t)row * KVW;
        const h16x4 raw = *(const h16x4*)(kr + 4 * lane);
        float v[4]; float ss = 0.f;
#pragma unroll
        for (int e = 0; e < 4; ++e) { v[e] = (float)raw[e]; ss += v[e] * v[e]; }
        const float rstd = 1.0f / sqrtf(wave_sum(ss) * (1.0f / 256.0f) + EPS);
        const f32x4 g = *(const f32x4*)(P.g_kv + 4 * lane);
        u32x2 pk; pk.x = pk2h(v[0] * rstd * g[0], v[1] * rstd * g[1]); pk.y = pk2h(v[2] * rstd * g[2], v[3] * rstd * g[3]);
        *(u32x2*)(kr + 4 * lane) = pk;
        const float* sm = SMALL + (size_t)row * 128;
        if (lane < 32) {
            const int i = lane & 15; const float x1 = sm[i], x2 = sm[i + 16]; const float cv = r32[((size_t)pos * 16 + i) * 2], sv = r32[((size_t)pos * 16 + i) * 2 + 1];
            kr[256 + lane] = (h16)(lane < 16 ? x1 * cv - x2 * sv : x2 * cv + x1 * sv);
        }
        {
            float o = sm[32 + lane];
            if (lane < 16) { const int i = lane & 7; const float x1 = sm[32 + i], x2 = sm[32 + i + 8]; const float cv = r16[((size_t)pos * 8 + i) * 2], sv = r16[((size_t)pos * 8 + i) * 2 + 1];
                o = lane < 8 ? x1 * cv - x2 * sv : x2 * cv + x1 * sv; }
            KIDX[(size_t)row * 64 + lane] = (h16)o;
        }
        if (lane < 16) WIDX[(size_t)row * 16 + lane] = sm[96 + lane] * (1.0f / 32.0f);
    }
}
__device__ __forceinline__ void phase_final(const Params& P, LAS unsigned char* lds) {
    const int tid = threadIdx.x, lane = tid & 63, w = tid >> 6;
    LAS float* gate = (LAS float*)lds;
    const h16* Y = (const h16*)(P.ws + WS_Y); const float* SSY = (const float*)(P.ws + WS_SSY);
    for (int ch = blockIdx.x; ch < 256; ch += gridDim.x) {
        const int b = ch >> 6;
        __syncthreads();
        load_mod(P, b, 4096, gate, false);
        __syncthreads();
        for (int i = 0; i < 8; ++i) {
            const int row = ch * 64 + w * 8 + i;
            float ss = (lane < 32) ? SSY[(size_t)lane * T + row] : 0.f;
            const float rstd = 1.0f / sqrtf(wave_sum(ss) * (1.0f / DM) + EPS);
#pragma unroll
            for (int j = 0; j < 8; ++j) { const int col = 4 * lane + 256 * j;
                const f32x4 xv = *(const f32x4*)(P.x + (size_t)row * DM + col); const h16x4 yv = *(const h16x4*)(Y + (size_t)row * DM + col);
                const f32x4 g = *(const f32x4*)(P.g_post + col), gt = *(const LAS f32x4*)(gate + col);
                f32x4 o;
#pragma unroll
                for (int e = 0; e < 4; ++e) o[e] = xv[e] + gt[e] * ((float)yv[e] * rstd * g[e]);
                *(f32x4*)(P.out + (size_t)row * DM + col) = o; }
        }
    }
}


__device__ __forceinline__ void phase_dilated_naive(const Params& P, LAS unsigned char* lds) {
    const int tid = threadIdx.x, lane = tid & 63, w = tid >> 6;
    LAS float* qs = (LAS float*)(lds + w * 2560); LAS float* ps = qs + 128;
    const h16* QB = (const h16*)(P.ws + WS_QB); const h16* KB = (const h16*)(P.ws + WS_KB); const h16* VB = (const h16*)(P.ws + WS_VB); const h16* SGB = (const h16*)(P.ws + WS_SGB);
    h16* OAB = (h16*)(P.ws + WS_OAB);
    for (int item = blockIdx.x * NWAVE + w; item < T * 8; item += gridDim.x * NWAVE) {
        const int row = item >> 3, h = item & 7, b = row >> 12, t = row & (SEQ - 1);
        { const h16x2 q2 = *(const h16x2*)(QB + (size_t)row * 1024 + h * 128 + 2 * lane); qs[2 * lane] = (float)q2[0]; qs[2 * lane + 1] = (float)q2[1]; }
        float sv[7]; float mx = -INFINITY;
#pragma unroll
        for (int i = 0; i < 7; ++i) {
            const int e = lane + 64 * i; sv[i] = -INFINITY;
            if (e < 387) { const int c = e / 129, j = e % 129, dil = c == 0 ? 1 : (c == 1 ? 4 : 16), kt = t - j * dil;
                if (kt >= 0) { const h16* kr = KB + (size_t)(b * SEQ + kt) * 1024 + h * 128; float s = 0.f;
                    for (int d = 0; d < 128; d += 8) { const h16x8 kv = *(const h16x8*)(kr + d);
#pragma unroll
                        for (int x = 0; x < 8; ++x) s += qs[d + x] * (float)kv[x]; }
                    sv[i] = s; } }
            mx = fmaxf(mx, sv[i]);
        }
        mx = wave_max(mx);
        float sum = 0.f;
#pragma unroll
        for (int i = 0; i < 7; ++i) { const int e = lane + 64 * i; const float p = (sv[i] == -INFINITY) ? 0.f : exp2f(sv[i] - mx); sum += p; if (e < 392) ps[e] = p; }
        sum = wave_sum(sum);
        float a0 = 0.f, a1 = 0.f;
        for (int e = 0; e < 387; ++e) { const int c = e / 129, j = e % 129, dil = c == 0 ? 1 : (c == 1 ? 4 : 16), kt = t - j * dil;
            if (kt >= 0) { const float p = ps[e]; const h16x2 v2 = *(const h16x2*)(VB + (size_t)(b * SEQ + kt) * 1024 + h * 128 + 2 * lane); a0 += p * (float)v2[0]; a1 += p * (float)v2[1]; } }
        const float inv = 1.0f / sum;
        const h16x2 g2 = *(const h16x2*)(SGB + (size_t)row * 1024 + h * 128 + 2 * lane);
        const h16x2 o2 = {(h16)(a0 * inv * (float)g2[0]), (h16)(a1 * inv * (float)g2[1])};
        *(h16x2*)(OAB + (size_t)row * 2048 + 1024 + h * 128 + 2 * lane) = o2;
    }
}

__device__ __forceinline__ void phase_dsa_naive(const Params& P, LAS unsigned char* lds) {
    const int tid = threadIdx.x, lane = tid & 63, w = tid >> 6;
    LAS float* sc = (LAS float*)lds;
    LAS float* qv = (LAS float*)(lds + 131072);
    LAS float* wv = qv + 1024;
    const h16* QIDX = (const h16*)(P.ws + WS_QIDX); const h16* KIDX = (const h16*)(P.ws + WS_KIDX); const float* WIDX = (const float*)(P.ws + WS_WIDX);
    const h16* QA = (const h16*)(P.ws + WS_QA); const h16* KVC = (const h16*)(P.ws + WS_KVC); h16* OLAT = (h16*)(P.ws + WS_OLAT);
    for (int item = blockIdx.x; item < T / 8; item += gridDim.x) {
        const int row0 = item * 8, b = row0 >> 12;
        for (int qi = 0; qi < 8; ++qi) {
            const int row = row0 + qi, t = row & (SEQ - 1);
            __syncthreads();
            for (int i = tid; i < 1024; i += NTHR) qv[i] = (float)QIDX[(size_t)row * 1024 + i];
            if (tid < 16) wv[tid] = WIDX[(size_t)row * 16 + tid];
            __syncthreads();
            for (int k = tid; k <= t; k += NTHR) {
                float kf[64];
                const h16* kr = KIDX + (size_t)(b * SEQ + k) * 64;
#pragma unroll
                for (int d = 0; d < 64; d += 8) { const h16x8 kv = *(const h16x8*)(kr + d);
#pragma unroll
                    for (int x = 0; x < 8; ++x) kf[d + x] = (float)kv[x]; }
                float acc = 0.f;
                for (int h = 0; h < 16; ++h) { float dt = 0.f;
#pragma unroll
                    for (int d = 0; d < 64; ++d) dt += qv[h * 64 + d] * kf[d];
                    acc += wv[h] * fmaxf(dt, 0.f); }
                sc[qi * SEQ + k] = acc + 0.0f;
            }
        }
        __syncthreads();
        {
            const int row = row0 + w, t = row & (SEQ - 1), n = t + 1;
            LAS float* myrow = sc + w * SEQ;
            LAS int* idxs = (LAS int*)(lds + 139264) + w * 256;
            LAS float* ps = myrow;
            LAS float* qs = myrow + 256;
            if (n <= 256) {
#pragma unroll
                for (int i = 0; i < 4; ++i) { const int k = lane + 64 * i; idxs[k] = (k < n) ? k : -1; }
            } else {
                const LAS unsigned* ur = (const LAS unsigned*)myrow;
                const int ni = (n + 63) >> 6;
                auto key = [&](int i) -> unsigned { const int k = 64 * i + lane; const unsigned bits = ur[k]; const unsigned u = (bits & 0x80000000u) ? ~bits : (bits | 0x80000000u); return (k < n) ? u : 0u; };
                unsigned thr = 0u;
                for (int bit = 31; bit >= 0; --bit) {
                    const unsigned cand = thr | (1u << bit); int cnt = 0;
#pragma unroll 4
                    for (int i = 0; i < ni; ++i) cnt += __popcll(__ballot(key(i) >= cand));
                    if (cnt >= 256) thr = cand;
                }
                int cgt = 0;
#pragma unroll 4
                for (int i = 0; i < ni; ++i) cgt += __popcll(__ballot(key(i) > thr));
                const int need_eq = 256 - cgt;
                int base = 0, eqb = 0;
                for (int i = 0; i < ni; ++i) { const unsigned u = key(i); const bool eq = u == thr; const unsigned long long me = __ballot(eq);
                    const int eqr = eqb + __popcll(me & ((1ull << lane) - 1ull));
                    const bool sel = u > thr || (eq && eqr < need_eq); const unsigned long long mk = __ballot(sel);
                    const int pos = base + __popcll(mk & ((1ull << lane) - 1ull));
                    if (sel && pos < 256) idxs[pos] = 64 * i + lane;
                    base += __popcll(mk); eqb += __popcll(me); }
            }
            for (int h = 0; h < 8; ++h) {
                const h16* qr = QA + ((size_t)row * 8 + h) * KVW;
                for (int d = lane; d < KVW; d += 64) qs[d] = (float)qr[d];
                float sv[4]; float mx = -INFINITY;
#pragma unroll
                for (int i = 0; i < 4; ++i) { const int id = idxs[lane + 64 * i]; sv[i] = -INFINITY;
                    if (id >= 0) { const h16* kr = KVC + (size_t)(b * SEQ + id) * KVW; float s = 0.f;
                        for (int d = 0; d < KVW; d += 8) { const h16x8 kv = *(const h16x8*)(kr + d);
#pragma unroll
                            for (int x = 0; x < 8; ++x) s += qs[d + x] * (float)kv[x]; }
                        sv[i] = s; }
                    mx = fmaxf(mx, sv[i]); }
                mx = wave_max(mx);
                float sum = 0.f;
#pragma unroll
                for (int i = 0; i < 4; ++i) { const float p = (sv[i] == -INFINITY) ? 0.f : exp2f(sv[i] - mx); sum += p; ps[lane + 64 * i] = p; }
                sum = wave_sum(sum);
                float a[4] = {0.f, 0.f, 0.f, 0.f};
                for (int j = 0; j < 256; ++j) { const int id = idxs[j];
                    if (id >= 0) { const float p = ps[j]; const h16x4 v4 = *(const h16x4*)(KVC + (size_t)(b * SEQ + id) * KVW + 4 * lane);
#pragma unroll
                        for (int e = 0; e < 4; ++e) a[e] += p * (float)v4[e]; } }
                const float inv = 1.0f / sum;
                u32x2 pk; pk.x = pk2h(a[0] * inv, a[1] * inv); pk.y = pk2h(a[2] * inv, a[3] * inv);
                *(u32x2*)(OLAT + ((size_t)row * 8 + h) * 256 + 4 * lane) = pk;
            }
        }
        __syncthreads();
    }
}

#define XB_TMO      128
#define XB_XCNT(j)  (256  + 64 * (j))
#define XB_XSUB(j)  (1280 + 64 * (j))
#define XB_XGEN(j)  (2304 + 64 * (j))
#define XB_TOP      3328
#define XB_TOPGEN   3392
#define XCD_BAR_WORDS 3456
#define XB_SPIN_CAP (1u << 22)
__device__ __forceinline__ unsigned xb_ld(unsigned* p)              { return __hip_atomic_load(p, __ATOMIC_RELAXED, __HIP_MEMORY_SCOPE_AGENT); }
__device__ __forceinline__ unsigned xb_add(unsigned* p, unsigned v) { return __hip_atomic_fetch_add(p, v, __ATOMIC_RELAXED, __HIP_MEMORY_SCOPE_AGENT); }
__device__ __forceinline__ unsigned xb_xcc_id() { return (unsigned)__builtin_amdgcn_s_getreg((3 << 11) | 20) & 0xFu; }
#define XB_SPIN(cond, bar) do { unsigned _sp = 0; while (cond) { __builtin_amdgcn_s_sleep(1); \
    if ((++_sp & 255u) == 0u) { if (xb_ld(&(bar)[XB_TMO])) break; if (_sp > XB_SPIN_CAP) { atomicAdd(&(bar)[XB_TMO], 1u); break; } } } } while (0)
struct XcdBarrier { unsigned* bar; unsigned x; volatile LAS unsigned* st; };
__device__ __forceinline__ XcdBarrier xcd_barrier_post(unsigned* bar, volatile LAS unsigned* st) {
    XcdBarrier b; b.bar = bar; b.x = xb_xcc_id(); b.st = st;
    if (threadIdx.x == 0) (void)xb_add(&bar[XB_XCNT(b.x)], 1u);
    return b;
}
__device__ __forceinline__ void xcd_barrier_complete(unsigned* bar, unsigned x, unsigned& nloc, unsigned& nx) {
    const unsigned G = gridDim.x * gridDim.y * gridDim.z;
    unsigned sum, cnt, mine, sp = 0u;
    for (;;) {
        sum = 0u; cnt = 0u; mine = 0u;
#pragma unroll
        for (unsigned j = 0; j < 16; ++j) { const unsigned c = xb_ld(&bar[XB_XCNT(j)]); sum += c; cnt += (c > 0u) ? 1u : 0u; mine = (j == x) ? c : mine; }
        if (sum == G) break;
        __builtin_amdgcn_s_sleep(1);
        if ((++sp & 255u) == 0u) { if (xb_ld(&bar[XB_TMO])) break; if (sp > XB_SPIN_CAP) { atomicAdd(&bar[XB_TMO], 1u); break; } }
    }
    nloc = mine > 0u ? mine : 1u; nx = cnt > 0u ? cnt : 1u;
}
__device__ __forceinline__ void xcd_barrier(const XcdBarrier& b) {
    asm volatile("s_waitcnt vmcnt(0)" ::: "memory");
    __syncthreads();
    if (threadIdx.x == 0) {
        unsigned* bar = b.bar;
        __builtin_amdgcn_s_waitcnt(0);
        unsigned nloc = b.st[0], nx = b.st[1];
        if (nloc == 0u) { xcd_barrier_complete(bar, b.x, nloc, nx); b.st[0] = nloc; b.st[1] = nx; }
        const unsigned old = xb_add(&bar[XB_XSUB(b.x)], 1u);
        const unsigned gen = old / nloc;
        if (old + 1u == (gen + 1u) * nloc) {
            __builtin_amdgcn_fence(__ATOMIC_RELEASE, "agent");
            asm volatile("s_waitcnt vmcnt(0)" ::: "memory");
            const unsigned og = xb_add(&bar[XB_TOP], 1u);
            const unsigned tg = og / nx;
            if (og + 1u == (tg + 1u) * nx) xb_add(&bar[XB_TOPGEN], 1u);
            else XB_SPIN(xb_ld(&bar[XB_TOPGEN]) == tg, bar);
            __builtin_amdgcn_fence(__ATOMIC_ACQUIRE, "agent");
            xb_add(&bar[XB_XGEN(b.x)], 1u);
            asm volatile("s_waitcnt vmcnt(0)" ::: "memory");
        } else {
            XB_SPIN(xb_ld(&bar[XB_XGEN(b.x)]) == gen, bar);
            __builtin_amdgcn_fence(__ATOMIC_ACQUIRE, "agent");
            asm volatile("s_waitcnt vmcnt(0)" ::: "memory");
        }
    }
    __syncthreads();
}

#ifndef MK_N_LAUNCHES
#define MK_N_LAUNCHES 1
#endif
constexpr int N_PHASES = 8;
extern __shared__ __attribute__((aligned(16))) unsigned char dyn_lds[];
__global__ void __launch_bounds__(NTHR, 2) hybrid_fwd(Params P) {
    LAS unsigned char* lds = (LAS unsigned char*)dyn_lds;
    volatile LAS unsigned* MISC = (volatile LAS unsigned*)(lds + LDS_SCR);
    for (int u = threadIdx.x; u < (LDS_BYTES - LDS_SCR) / 4; u += NTHR) MISC[u] = 0u;
    __syncthreads();
    XcdBarrier bar = xcd_barrier_post((unsigned*)(P.ws + WS_CTL) + 4096 + P.ph_lo * XCD_BAR_WORDS, MISC + 8);
    const int lo = P.ph_lo, hi = P.ph_hi;
#ifndef PHASE_MASK
#define PHASE_MASK 0xFF
#endif
#define IN(k) (((PHASE_MASK >> (k)) & 1) && lo <= (k) && (k) < hi)
#define SEAM(k) do { if (IN(k) && IN((k) + 1)) xcd_barrier(bar); } while (0)
    if (IN(0)) phase_prologue(P, lds);
    SEAM(0);
    if (IN(1)) phase_h(P, lds);
    SEAM(1);
    if (IN(2)) {
        pg8::Gemm g{(const h16*)(P.ws + WS_H), (const h16*)(P.ws + WS_W1T), T, NW1, DM, DM, DM, 0}; pg8::StaticOrder S; S.init(T, NW1, gridDim.x, blockIdx.x);
        EpiProj E{(h16*)(P.ws + WS_CQ), (h16*)(P.ws + WS_KVC), (h16*)(P.ws + WS_SGA), (h16*)(P.ws + WS_QB), (h16*)(P.ws + WS_KB), (h16*)(P.ws + WS_VB), (h16*)(P.ws + WS_SGB),
                  (float*)(P.ws + WS_SMALL), (float*)(P.ws + WS_SSQ), (const float*)(P.ws + WS_ROPE32)};
        pg8::gemm_phase(lds, g, S, E);
    }
    SEAM(2);
    if (IN(3)) {
        phase_rowops(P);
        { pg8::Gemm g{(const h16*)(P.ws + WS_CQ), (const h16*)(P.ws + WS_WQT), T, NQ, 512, 512, 512, 0}; pg8::StaticOrder S; S.init(T, NQ, gridDim.x, blockIdx.x);
          EpiQ E{(h16*)(P.ws + WS_QA), (h16*)(P.ws + WS_QIDX), (const float*)(P.ws + WS_SSQ), (const float*)(P.ws + WS_ROPE32), (const float*)(P.ws + WS_ROPE16)};
          pg8::gemm_phase(lds, g, S, E); }
        __syncthreads();
        phase_dilated_naive(P, lds);
    }
    SEAM(3);
    if (IN(4)) phase_dsa_naive(P, lds);
    SEAM(4);
    if (IN(5)) {
        pg8::Gemm g{(const h16*)(P.ws + WS_OLAT), (const h16*)(P.ws + WS_WUVT), T, 1024, 512, 2048, 512, 512}; pg8::StaticOrder S; S.init(T, 1024, gridDim.x, blockIdx.x);
        EpiOA E{(h16*)(P.ws + WS_OAB), (const h16*)(P.ws + WS_SGA)};
        pg8::gemm_phase(lds, g, S, E);
    }
    SEAM(5);
    if (IN(6)) {
        pg8::Gemm g{(const h16*)(P.ws + WS_OAB), (const h16*)(P.ws + WS_WOT), T, DM, DM, DM, DM, 0}; pg8::StaticOrder S; S.init(T, DM, gridDim.x, blockIdx.x);
        EpiY E{(h16*)(P.ws + WS_Y), (float*)(P.ws + WS_SSY)};
        pg8::gemm_phase(lds, g, S, E);
    }
    SEAM(6);
    if (IN(7)) phase_final(P, lds);
#undef IN
#undef SEAM
}

extern "C" void kernel_launch(void* const* d_in, const int* in_sizes, int n_in, void* d_out, int out_size, void* d_ws, size_t ws_size, hipStream_t stream) {
    static int grid = 0;
    if (grid == 0) {
        if (n_in != 14 || in_sizes[0] != T * DM || out_size != T * DM || ws_size < WS_END) { fprintf(stderr, "kernel_launch: unexpected shapes (n_in %d, in0 %d, out %d, ws %zu)\n", n_in, n_in > 0 ? in_sizes[0] : -1, out_size, ws_size); grid = -1; return; }
        int dev = 0, cus = 0, per_cu = 0;
        if (hipGetDevice(&dev) != hipSuccess || hipDeviceGetAttribute(&cus, hipDeviceAttributeMultiprocessorCount, dev) != hipSuccess) { grid = -1; return; }
        if (hipFuncSetAttribute((const void*)hybrid_fwd, hipFuncAttributeMaxDynamicSharedMemorySize, LDS_BYTES) != hipSuccess) { fprintf(stderr, "kernel_launch: hipFuncSetAttribute failed\n"); grid = -1; return; }
        if (hipOccupancyMaxActiveBlocksPerMultiprocessor(&per_cu, (const void*)hybrid_fwd, NTHR, LDS_BYTES) != hipSuccess || per_cu < 1) { fprintf(stderr, "kernel_launch: occupancy query says %d blocks per CU\n", per_cu); }
        (void)hipGetLastError();
        grid = cus;
    }
    if (grid < 0) return;
    (void)hipMemsetAsync((char*)d_ws + WS_CTL, 0, 1 * MiB, stream);
    Params P{};
    P.x = (const float*)d_in[0]; P.c = (const float*)d_in[1]; P.w_ada = (const float*)d_in[2]; P.b_ada = (const float*)d_in[3]; P.g_pre = (const float*)d_in[4]; P.g_post = (const float*)d_in[5];
    P.w_in = (const float*)d_in[6]; P.g_q = (const float*)d_in[7]; P.g_kv = (const float*)d_in[8]; P.w_uq = (const float*)d_in[9]; P.w_uq_idx = (const float*)d_in[10]; P.w_uk = (const float*)d_in[11];
    P.w_uv = (const float*)d_in[12]; P.w_out = (const float*)d_in[13]; P.out = (float*)d_out; P.ws = (unsigned char*)d_ws;
#if MK_N_LAUNCHES == 1
    P.ph_lo = 0; P.ph_hi = N_PHASES;
    hipLaunchKernelGGL(hybrid_fwd, dim3(grid), dim3(NTHR), LDS_BYTES, stream, P);
#else
    for (int k = 0; k < N_PHASES; ++k) { P.ph_lo = k; P.ph_hi = k + 1; hipLaunchKernelGGL(hybrid_fwd, dim3(grid), dim3(NTHR), LDS_BYTES, stream, P); }
#endif
}
```

```cpp
#include <hip/hip_runtime.h>
#include <cstdint>
#include <cstdio>
#include <cmath>

#define LAS __attribute__((address_space(3)))
typedef _Float16 h16;
typedef _Float16 h16x2 __attribute__((ext_vector_type(2)));
typedef _Float16 h16x4 __attribute__((ext_vector_type(4)));
typedef _Float16 h16x8 __attribute__((ext_vector_type(8)));
typedef float f32x2 __attribute__((ext_vector_type(2)));
typedef float f32x4 __attribute__((ext_vector_type(4)));
typedef unsigned u32x2 __attribute__((ext_vector_type(2)));
typedef unsigned u32x4 __attribute__((ext_vector_type(4)));

constexpr int NB = 4, SEQ = 4096, T = NB * SEQ, DM = 2048;
constexpr int NW1 = 6144;
constexpr int NQ = 3328;
constexpr int KVW = 288;
constexpr float EPS = 1e-6f;
constexpr float SCQ = 0.08838834764831845f * 1.4426950408889634f;

constexpr size_t MiB = 1u << 20;
constexpr size_t WS_CTL = 0;
constexpr size_t WS_MODP = 1 * MiB;
constexpr size_t WS_ROPE32 = 2 * MiB;
constexpr size_t WS_ROPE16 = 2 * MiB + 512 * 1024;
constexpr size_t WS_SSQ = 3 * MiB;
constexpr size_t WS_SSY = 4 * MiB;
constexpr size_t WS_W1T = 8 * MiB;
constexpr size_t WS_WQT = 32 * MiB;
constexpr size_t WS_WUVT = 36 * MiB;
constexpr size_t WS_WOT = 38 * MiB;
constexpr size_t WS_KVC = 46 * MiB;
constexpr size_t WS_KIDX = 55 * MiB;
constexpr size_t WS_WIDX = 57 * MiB;
constexpr size_t WS_SMALL = 58 * MiB;
constexpr size_t WS_CQ = 66 * MiB;
constexpr size_t WS_SGA = 82 * MiB;
constexpr size_t WS_OAB = 114 * MiB;
constexpr size_t WS_QLAT = 178 * MiB;
constexpr size_t WS_QROPE = 242 * MiB;
constexpr size_t WS_QIDX = 250 * MiB;
constexpr size_t WS_H = 282 * MiB;
constexpr size_t WS_OP4 = 282 * MiB;
constexpr size_t WS_OP16 = 314 * MiB;
constexpr size_t WS_QB = 346 * MiB;
constexpr size_t WS_KB = 378 * MiB;
constexpr size_t WS_VB = 410 * MiB;
constexpr size_t WS_SGB = 442 * MiB;
constexpr size_t WS_END = 474 * MiB;
constexpr size_t WS_LSEP = 6 * MiB;
constexpr size_t WS_OLAT = WS_QLAT;
constexpr size_t WS_Y = 178 * MiB;

struct Params {
    const float *x, *c, *w_ada, *b_ada, *g_pre, *g_post, *w_in, *g_q, *g_kv, *w_uq, *w_uq_idx, *w_uk, *w_uv, *w_out;
    float* out; unsigned char* ws;
    int ph_lo, ph_hi;
};

__device__ __forceinline__ unsigned pk2h(float a, float b) { h16x2 t = {(h16)a, (h16)b}; return __builtin_bit_cast(unsigned, t); }
__device__ __forceinline__ float siluf(float v) { return v / (1.0f + __expf(-v)); }
__device__ __forceinline__ float wave_sum(float v) {
#pragma unroll
    for (int o = 1; o < 64; o <<= 1) v += __shfl_xor(v, o);
    return v;
}
__device__ __forceinline__ float wave_max(float v) {
#pragma unroll
    for (int o = 1; o < 64; o <<= 1) v = fmaxf(v, __shfl_xor(v, o));
    return v;
}

namespace pg8 {
constexpr int BM = 256, BK = 64, HALF = 128, HTB = HALF * BK * 2, STAGE_BYTES = 8 * HTB, NXCD = 8, WGM = 8;
__host__ __device__ __forceinline__ int lds_byte(int r, int c) { const int st = (r >> 4) * 2 + (c >> 5), rr = r & 15, cc = c & 31, ob = rr * 64 + cc * 2; return st * 1024 + (ob ^ (((ob >> 9) & 1) << 5)); }
__host__ __device__ __forceinline__ void stage_rc(int b, int& R, int& C) { const int st = b / 1024, sb = b % 1024, swz = sb ^ (((sb >> 9) & 1) << 5); R = (st >> 1) * 16 + swz / 64; C = (st & 1) * 32 + (swz % 64) / 2; }
__host__ __device__ __forceinline__ int perm32(int rho) { const int n = rho >> 4, i = rho & 15; return 8 * (i >> 2) + 4 * n + (i & 3); }

struct Unit { int pm, pn; };
struct Gemm { const h16* A; const h16* Bt; int M, N, K, lda, ldb, a_pn_off; };

struct StaticOrder {
    int nM, nN, nwg, G, c;
    __device__ void init(int M, int N, int G_, int c_) { nM = M / BM; nN = N / BM; nwg = nM * nN; G = __builtin_amdgcn_readfirstlane(G_); c = __builtin_amdgcn_readfirstlane(c_); }
    __device__ bool next(int i, Unit& u) const {
        const int L = __builtin_amdgcn_readfirstlane(i * G + c); if (L >= nwg) return false;
        int wgid = L; { const int q = nwg / NXCD, r = nwg % NXCD, xcd = wgid % NXCD, off = wgid / NXCD; wgid = (xcd < r ? xcd * (q + 1) : r * (q + 1) + (xcd - r) * q) + off; }
        const int nig = WGM * nN, gid = wgid / nig, fm = gid * WGM, gsz = (nM - fm) < WGM ? (nM - fm) : WGM;
        u.pm = __builtin_amdgcn_readfirstlane(fm + ((wgid % nig) % gsz)); u.pn = __builtin_amdgcn_readfirstlane((wgid % nig) / gsz); return true;
    }
};

template <class Epi>
__device__ __forceinline__ void gemm_phase(LAS unsigned char* lds, const Gemm g, const StaticOrder& S, const Epi& E) {
    const int tid = threadIdx.x, wid = __builtin_amdgcn_readfirstlane(tid >> 6), lane = tid & 63, wr = wid >> 2, wc = wid & 3, fr = lane & 15, fq = lane >> 4;
    const int K = g.K, nt = K / BK;
    unsigned voffA[2], voffB[2];
#pragma unroll
    for (int i = 0; i < 2; ++i) { int R, C; stage_rc(tid * 16 + i * 8192, R, C); const int Rb = (R & ~31) + perm32(R & 31);
        voffA[i] = (unsigned)(R * g.lda + C) * 2u; voffB[i] = (unsigned)(Rb * g.ldb + C) * 2u; }
    const size_t kstep = (size_t)(BK * 2);
    const size_t hstepA = (size_t)HALF * g.lda * 2, hstepB = (size_t)HALF * g.ldb * 2;
    const size_t tstepA = 2 * hstepA, tstepB = 2 * hstepB;
    const unsigned ldsw = (unsigned)wid * 1024u;
    const int aoff = lds_byte(wr * 64 + fr, fq * 8), boff = lds_byte(wc * 32 + fr, fq * 8);
#define PG8_SA(b, h) (((b) * 2 + (h)) * HTB)
#define PG8_SB(b, h) ((4 + (b) * 2 + (h)) * HTB)
#define PG8_STAGE(bufoff, gbase, voff) do { _Pragma("unroll") for (int _i = 0; _i < 2; ++_i) \
        __builtin_amdgcn_global_load_lds((const unsigned*)((const char*)(gbase) + (voff)[_i]), (LAS unsigned*)(lds + (bufoff) + ldsw + _i * 8192), 16, 0, 0); } while (0)
#define PG8_LDA(dst, b, h) do { _Pragma("unroll") for (int m = 0; m < 4; ++m) _Pragma("unroll") for (int k = 0; k < 2; ++k) dst[m][k] = *(const LAS h16x8*)(lds + PG8_SA(b, h) + aoff + m * 2048 + k * 1024); } while (0)
#define PG8_LDB(dst, b, h) do { _Pragma("unroll") for (int n = 0; n < 2; ++n) _Pragma("unroll") for (int k = 0; k < 2; ++k) dst[n][k] = *(const LAS h16x8*)(lds + PG8_SB(b, h) + boff + n * 2048 + k * 1024); } while (0)
#define PG8_MMA(ai, bj, At, Bt) do { __builtin_amdgcn_s_setprio(1); _Pragma("unroll") for (int m = 0; m < 4; ++m) _Pragma("unroll") for (int n = 0; n < 2; ++n) _Pragma("unroll") for (int k = 0; k < 2; ++k) \
        acc[ai][bj][m][n] = __builtin_amdgcn_mfma_f32_16x16x32_f16(Bt[n][k], At[m][k], acc[ai][bj][m][n], 0, 0, 0); __builtin_amdgcn_s_setprio(0); } while (0)
#define PG8_WAIT_V(n) asm volatile("s_waitcnt vmcnt(" #n ")" ::: "memory")
#define PG8_WAIT_L(n) asm volatile("s_waitcnt lgkmcnt(" #n ")" ::: "memory")
#define PG8_BAR __builtin_amdgcn_s_barrier()
#define PG8_SCHED __builtin_amdgcn_sched_barrier(0)
    Unit cur, nxt; int ui = 0;
    if (!S.next(0, cur)) return;
    f32x4 acc[2][2][4][2];
#pragma unroll
    for (int a = 0; a < 2; ++a)
#pragma unroll
        for (int b = 0; b < 2; ++b)
#pragma unroll
            for (int m = 0; m < 4; ++m)
#pragma unroll
                for (int n = 0; n < 2; ++n) acc[a][b][m][n] = (f32x4){0.f, 0.f, 0.f, 0.f};
    h16x8 At[4][2], B0[2][2], B1[2][2];
    const char* cA = (const char*)g.A + (size_t)cur.pm * tstepA + (size_t)cur.pn * g.a_pn_off * 2; const char* cB = (const char*)g.Bt + (size_t)cur.pn * tstepB;
    PG8_STAGE(PG8_SB(0, 0), cB, voffB); PG8_STAGE(PG8_SB(0, 1), cB + hstepB, voffB); PG8_STAGE(PG8_SA(0, 0), cA, voffA); PG8_STAGE(PG8_SA(0, 1), cA + hstepA, voffA);
    if (wr == 1) PG8_BAR;
    PG8_WAIT_V(2); PG8_BAR;
    PG8_STAGE(PG8_SB(1, 0), cB + kstep, voffB); PG8_STAGE(PG8_SA(1, 0), cA + kstep, voffA); PG8_STAGE(PG8_SB(1, 1), cB + hstepB + kstep, voffB);
    PG8_WAIT_V(6); PG8_BAR;
    for (;;) {
        const bool has_next = S.next(ui + 1, nxt);
        const char* nA = has_next ? (const char*)g.A + (size_t)nxt.pm * tstepA + (size_t)nxt.pn * g.a_pn_off * 2 : cA; const char* nB = has_next ? (const char*)g.Bt + (size_t)nxt.pn * tstepB : cB;
        for (int t = 0; t < nt; t += 2) {
            const bool last = (t == nt - 2);
            const char* a1 = cA + (size_t)(t + 1) * kstep;
            const char* a2 = last ? nA : cA + (size_t)(t + 2) * kstep; const char* b2 = last ? nB : cB + (size_t)(t + 2) * kstep;
            const char* a3 = a2 + kstep; const char* b3 = b2 + kstep;
            PG8_LDB(B0, 0, 0); PG8_LDB(B1, 0, 1); PG8_SCHED; PG8_LDA(At, 0, 0); PG8_STAGE(PG8_SA(1, 1), a1 + hstepA, voffA);
            PG8_WAIT_V(8); PG8_WAIT_L(0); PG8_BAR; PG8_MMA(0, 0, At, B0); PG8_MMA(0, 1, At, B1); PG8_BAR; PG8_SCHED;
            PG8_LDA(At, 0, 1); PG8_STAGE(PG8_SB(0, 0), b2, voffB); PG8_STAGE(PG8_SB(0, 1), b2 + hstepB, voffB); PG8_STAGE(PG8_SA(0, 0), a2, voffA);
            PG8_WAIT_V(8); PG8_WAIT_L(0); PG8_BAR; PG8_MMA(1, 0, At, B0); PG8_MMA(1, 1, At, B1); PG8_BAR; PG8_SCHED;
            PG8_LDB(B0, 1, 0); PG8_LDB(B1, 1, 1); PG8_SCHED; PG8_LDA(At, 1, 0); PG8_STAGE(PG8_SA(0, 1), a2 + hstepA, voffA);
            PG8_WAIT_V(8); PG8_WAIT_L(0); PG8_BAR; PG8_MMA(0, 0, At, B0); PG8_MMA(0, 1, At, B1); PG8_BAR; PG8_SCHED;
            PG8_LDA(At, 1, 1); PG8_STAGE(PG8_SB(1, 0), b3, voffB); PG8_STAGE(PG8_SB(1, 1), b3 + hstepB, voffB); PG8_STAGE(PG8_SA(1, 0), a3, voffA);
            PG8_WAIT_V(8); PG8_WAIT_L(0); PG8_BAR; PG8_MMA(1, 0, At, B0); PG8_MMA(1, 1, At, B1); PG8_BAR; PG8_SCHED;
        }
        if (wr == 0) PG8_BAR;
        E(acc, cur, wr, wc, fr, fq);
        if (!has_next) break;
#pragma unroll
        for (int a = 0; a < 2; ++a)
#pragma unroll
            for (int b = 0; b < 2; ++b)
#pragma unroll
                for (int m = 0; m < 4; ++m)
#pragma unroll
                    for (int n = 0; n < 2; ++n) acc[a][b][m][n] = (f32x4){0.f, 0.f, 0.f, 0.f};
        cur = nxt; cA = nA; cB = nB; ++ui;
        if (wr == 1) PG8_BAR;
    }
    PG8_WAIT_V(0);
    PG8_BAR;
#undef PG8_SA
#undef PG8_SB
#undef PG8_STAGE
#undef PG8_LDA
#undef PG8_LDB
#undef PG8_MMA
#undef PG8_WAIT_V
#undef PG8_WAIT_L
#undef PG8_BAR
#undef PG8_SCHED
}
}

using pg8::Unit;
__device__ __forceinline__ u32x4 pack8(const f32x4 a, const f32x4 b) { u32x4 w; w.x = pk2h(a[0], a[1]); w.y = pk2h(a[2], a[3]); w.z = pk2h(b[0], b[1]); w.w = pk2h(b[2], b[3]); return w; }

struct EpiProj {
    h16 *CQ, *KVC, *SGA, *QB, *KB, *VB, *SGB; float *SMALL, *SSQ; const float* rope32;
    __device__ __forceinline__ void operator()(const f32x4 (&acc)[2][2][4][2], const Unit& u, int wr, int wc, int fr_in, int fq_in) const {
        int fr = fr_in, fq = fq_in; asm volatile("" : "+v"(fr), "+v"(fq));
        const int pn = u.pn;
#pragma unroll
        for (int ai = 0; ai < 2; ++ai)
#pragma unroll
            for (int m = 0; m < 4; ++m) {
                const int row = u.pm * 256 + ai * 128 + wr * 64 + m * 16 + fr;
                if (pn < 2) {
                    float s = 0.f;
#pragma unroll
                    for (int bj = 0; bj < 2; ++bj) { const f32x4 v0 = acc[ai][bj][m][0], v1 = acc[ai][bj][m][1];
                        s += (v0[0] * v0[0] + v0[1] * v0[1]) + (v0[2] * v0[2] + v0[3] * v0[3]) + (v1[0] * v1[0] + v1[1] * v1[1]) + (v1[2] * v1[2] + v1[3] * v1[3]);
                        *(u32x4*)(CQ + (size_t)row * 512 + pn * 256 + bj * 128 + wc * 32 + fq * 8) = pack8(v0, v1); }
                    s += __shfl_xor(s, 16); s += __shfl_xor(s, 32);
                    if (fq == 0) SSQ[(size_t)(pn * 4 + wc) * T + row] = s;
                } else if (pn == 2) {
#pragma unroll
                    for (int bj = 0; bj < 2; ++bj) *(u32x4*)(KVC + (size_t)row * KVW + bj * 128 + wc * 32 + fq * 8) = pack8(acc[ai][bj][m][0], acc[ai][bj][m][1]);
                } else if (pn == 3) {
                    float* p = SMALL + (size_t)row * 128 + wc * 32 + fq * 8;
                    *(f32x4*)p = acc[ai][0][m][0]; *(f32x4*)(p + 4) = acc[ai][0][m][1];
                } else if (pn < 8 || pn >= 20) {
                    h16* dst = (pn < 8 ? SGA + (pn - 4) * 256 : SGB + (pn - 20) * 256) + (size_t)row * 1024 + wc * 32 + fq * 8;
#pragma unroll
                    for (int bj = 0; bj < 2; ++bj) { f32x4 v0 = acc[ai][bj][m][0], v1 = acc[ai][bj][m][1];
#pragma unroll
                        for (int e = 0; e < 4; ++e) { v0[e] = siluf(v0[e]); v1[e] = siluf(v1[e]); }
                        *(u32x4*)(dst + bj * 128) = pack8(v0, v1); }
                } else if (pn >= 16) {
                    h16* dst = VB + (size_t)row * 1024 + (pn - 16) * 256 + wc * 32 + fq * 8;
#pragma unroll
                    for (int bj = 0; bj < 2; ++bj) *(u32x4*)(dst + bj * 128) = pack8(acc[ai][bj][m][0], acc[ai][bj][m][1]);
                } else {
                    const bool isq = pn < 12; const float sc = isq ? SCQ : 1.0f;
                    h16* dst = (isq ? QB + (pn - 8) * 256 : KB + (pn - 12) * 256) + (size_t)row * 1024 + wc * 32 + fq * 8;
                    const int pos = row & (SEQ - 1);
#pragma unroll
                    for (int bj = 0; bj < 2; ++bj) { f32x4 v0 = acc[ai][bj][m][0], v1 = acc[ai][bj][m][1];
                        if (wc == 0) {
                            const float* cs = rope32 + ((size_t)pos * 16 + 8 * (fq & 1)) * 2;
                            const float sg = (fq < 2) ? -1.f : 1.f;
#pragma unroll
                            for (int e = 0; e < 4; ++e) { const float p0 = __shfl_xor(v0[e], 32), p1 = __shfl_xor(v1[e], 32);
                                const f32x2 c0 = *(const f32x2*)(cs + 2 * e), c1 = *(const f32x2*)(cs + 2 * (4 + e));
                                v0[e] = v0[e] * c0.x + sg * p0 * c0.y; v1[e] = v1[e] * c1.x + sg * p1 * c1.y; }
                        }
                        v0 = v0 * sc; v1 = v1 * sc;
                        *(u32x4*)(dst + bj * 128) = pack8(v0, v1); }
                }
            }
    }
};

struct EpiQ {
    h16 *QLAT, *QROPE, *QIDX; const float *SSQ, *rope32, *rope16;
    __device__ __forceinline__ void operator()(const f32x4 (&acc)[2][2][4][2], const Unit& u, int wr, int wc, int fr_in, int fq_in) const {
        int fr = fr_in, fq = fq_in; asm volatile("" : "+v"(fr), "+v"(fq));
        const int pn = u.pn;
#pragma unroll
        for (int ai = 0; ai < 2; ++ai)
#pragma unroll
            for (int m = 0; m < 4; ++m) {
                const int row = u.pm * 256 + ai * 128 + wr * 64 + m * 16 + fr;
                float ss = 0.f;
#pragma unroll
                for (int p = 0; p < 8; ++p) ss += SSQ[(size_t)p * T + row];
                const float rstd = 1.0f / sqrtf(ss * (1.0f / 512.0f) + EPS);
                const int pos = row & (SEQ - 1);
#pragma unroll
                for (int bj = 0; bj < 2; ++bj) { f32x4 v0 = acc[ai][bj][m][0] * rstd, v1 = acc[ai][bj][m][1] * rstd;
                    if (pn == 0) {
                        const float* cs = rope32 + ((size_t)pos * 16 + 8 * (fq & 1)) * 2;
                        const float sg = (fq < 2) ? -1.f : 1.f;
#pragma unroll
                        for (int e = 0; e < 4; ++e) { const float p0 = __shfl_xor(v0[e], 32), p1 = __shfl_xor(v1[e], 32);
                            const f32x2 c0 = *(const f32x2*)(cs + 2 * e), c1 = *(const f32x2*)(cs + 2 * (4 + e));
                            v0[e] = v0[e] * c0.x + sg * p0 * c0.y; v1[e] = v1[e] * c1.x + sg * p1 * c1.y; }
                        v0 = v0 * SCQ; v1 = v1 * SCQ;
                        *(u32x4*)(QROPE + ((size_t)row * 8 + (4 * bj + wc)) * 32 + fq * 8) = pack8(v0, v1);
                    } else if (pn < 9) {
                        v0 = v0 * SCQ; v1 = v1 * SCQ;
                        *(u32x4*)(QLAT + ((size_t)row * 8 + (pn - 1)) * 256 + bj * 128 + wc * 32 + fq * 8) = pack8(v0, v1);
                    } else {
                        if ((wc & 1) == 0) {
                            const float* cs = rope16 + (size_t)pos * 16;
                            const float sg = (fq == 0) ? -1.f : 1.f;
#pragma unroll
                            for (int e = 0; e < 4; ++e) { const float p0 = __shfl_xor(v0[e], 16), p1 = __shfl_xor(v1[e], 16);
                                const f32x2 c0 = *(const f32x2*)(cs + 2 * e), c1 = *(const f32x2*)(cs + 2 * (4 + e));
                                if (fq < 2) { v0[e] = v0[e] * c0.x + sg * p0 * c0.y; v1[e] = v1[e] * c1.x + sg * p1 * c1.y; } }
                        }
                        *(u32x4*)(QIDX + (size_t)row * 1024 + (pn - 9) * 256 + bj * 128 + wc * 32 + fq * 8) = pack8(v0, v1);
                    } }
                asm volatile("" ::: "memory");
            }
    }
};

struct EpiOA {
    h16* OAB; const h16* SGA;
    __device__ __forceinline__ void operator()(const f32x4 (&acc)[2][2][4][2], const Unit& u, int wr, int wc, int fr_in, int fq_in) const {
        int fr = fr_in, fq = fq_in; asm volatile("" : "+v"(fr), "+v"(fq));
#pragma unroll
        for (int ai = 0; ai < 2; ++ai)
#pragma unroll
            for (int m = 0; m < 4; ++m) {
                const int row = u.pm * 256 + ai * 128 + wr * 64 + m * 16 + fr;
#pragma unroll
                for (int bj = 0; bj < 2; ++bj) { const int col = u.pn * 256 + bj * 128 + wc * 32 + fq * 8;
                    const h16x8 g = *(const h16x8*)(SGA + (size_t)row * 1024 + col);
                    f32x4 v0 = acc[ai][bj][m][0], v1 = acc[ai][bj][m][1];
#pragma unroll
                    for (int e = 0; e < 4; ++e) { v0[e] *= (float)g[e]; v1[e] *= (float)g[4 + e]; }
                    *(u32x4*)(OAB + (size_t)row * 2048 + col) = pack8(v0, v1); }
            }
    }
};

struct EpiY {
    h16* Y; float* SSY;
    __device__ __forceinline__ void operator()(const f32x4 (&acc)[2][2][4][2], const Unit& u, int wr, int wc, int fr_in, int fq_in) const {
        int fr = fr_in, fq = fq_in; asm volatile("" : "+v"(fr), "+v"(fq));
#pragma unroll
        for (int ai = 0; ai < 2; ++ai)
#pragma unroll
            for (int m = 0; m < 4; ++m) {
                const int row = u.pm * 256 + ai * 128 + wr * 64 + m * 16 + fr;
                float s = 0.f;
#pragma unroll
                for (int bj = 0; bj < 2; ++bj) { const f32x4 v0 = acc[ai][bj][m][0], v1 = acc[ai][bj][m][1];
                    s += (v0[0] * v0[0] + v0[1] * v0[1]) + (v0[2] * v0[2] + v0[3] * v0[3]) + (v1[0] * v1[0] + v1[1] * v1[1]) + (v1[2] * v1[2] + v1[3] * v1[3]);
                    *(u32x4*)(Y + (size_t)row * 2048 + u.pn * 256 + bj * 128 + wc * 32 + fq * 8) = pack8(v0, v1); }
                s += __shfl_xor(s, 16); s += __shfl_xor(s, 32);
                if (fq == 0) SSY[(size_t)(u.pn * 4 + wc) * T + row] = s;
            }
    }
};

constexpr int NTHR = 512, NWAVE = 8;
constexpr int LDS_SCR = 155648;
constexpr int LDS_BYTES = LDS_SCR + 4096;

__device__ __forceinline__ void p0_mod_unit(const Params& P, int unit, LAS unsigned char* lds) {
    const int tid = threadIdx.x, lane = tid & 63, w = tid >> 6, kc = unit >> 5, cc = unit & 31;
    LAS float* sc = (LAS float*)lds;
    LAS float* red = (LAS float*)(lds + 4096);
    for (int i = tid; i < 1024; i += NTHR) { const int b = i >> 8, kk = i & 255; sc[i] = siluf(P.c[b * DM + kc * 256 + kk]); }
    __syncthreads();
    f32x4 acc[4];
#pragma unroll
    for (int b = 0; b < 4; ++b) acc[b] = (f32x4){0.f, 0.f, 0.f, 0.f};
    if (lane < 48) {
        const float* wp = P.w_ada + (size_t)(kc * 256 + w * 32) * 6144 + cc * 192 + 4 * lane;
#pragma unroll 8
        for (int i = 0; i < 32; ++i) { const f32x4 wv = *(const f32x4*)(wp + (size_t)i * 6144);
#pragma unroll
            for (int b = 0; b < 4; ++b) acc[b] += wv * sc[b * 256 + w * 32 + i]; }
#pragma unroll
        for (int b = 0; b < 4; ++b) *(LAS f32x4*)(red + (w * 4 + b) * 192 + 4 * lane) = acc[b];
    }
    __syncthreads();
    float* MODP = (float*)(P.ws + WS_MODP);
    for (int o = tid; o < 768; o += NTHR) { const int b = o / 192, j = o % 192; float s = 0.f;
#pragma unroll
        for (int ww = 0; ww < 8; ++ww) s += red[(ww * 4 + b) * 192 + j];
        MODP[(size_t)(kc * 4 + b) * 6144 + cc * 192 + j] = s; }
    __syncthreads();
}
template <class SrcCol>
__device__ __forceinline__ void transpose_item(const float* W, int ldw, const float* kscale, h16* WT, int ldt, int k0, int n0, SrcCol srccol, LAS float* scr, int lane) {
    const int s = srccol(n0 + (lane & 31));
#pragma unroll 8
    for (int i = 0; i < 32; ++i) { const int kk = 2 * i + (lane >> 5); float v = (s >= 0) ? W[(size_t)(k0 + kk) * ldw + s] : 0.f; if (kscale) v *= kscale[k0 + kk]; scr[kk * 33 + (lane & 31)] = v; }
    asm volatile("s_waitcnt lgkmcnt(0)" ::: "memory");
    const int c = lane & 7;
#pragma unroll
    for (int j = 0; j < 4; ++j) { const int n = (lane >> 3) + 8 * j; const LAS float* sp = scr + (8 * c) * 33 + n;
        u32x4 o; o.x = pk2h(sp[0 * 33], sp[1 * 33]); o.y = pk2h(sp[2 * 33], sp[3 * 33]); o.z = pk2h(sp[4 * 33], sp[5 * 33]); o.w = pk2h(sp[6 * 33], sp[7 * 33]);
        *(u32x4*)(WT + (size_t)(n0 + n) * ldt + k0 + 8 * c) = o; }
    asm volatile("s_waitcnt lgkmcnt(0)" ::: "memory");
}
struct SrcW1 { __device__ int operator()(int n) const { return n < 880 ? n : (n < 1024 ? -1 : n - 144); } };
struct SrcId { __device__ int operator()(int n) const { return n; } };
struct SrcQRope { __device__ int operator()(int n) const { return (n >> 5) * 128 + (n & 31); } };

__device__ __forceinline__ void p0_fold_unit(const Params& P, int unit, LAS unsigned char* lds) {
    const int tid = threadIdx.x, h = unit >> 3, kb = unit & 7;
    LAS float* wuk = (LAS float*)lds;
    LAS float* wuq = (LAS float*)(lds + 98304);
    for (int i = tid; i < 96 * 256; i += NTHR) wuk[i] = P.w_uk[(size_t)h * 96 * 256 + i];
    for (int i = tid; i < 64 * 96; i += NTHR) { const int k = i / 96, nn = i % 96; wuq[i] = P.w_uq[(size_t)(kb * 64 + k) * 1024 + h * 128 + 32 + nn]; }
    __syncthreads();
    const int r = tid & 255, kh = tid >> 8;
    float acc[32];
#pragma unroll
    for (int i = 0; i < 32; ++i) acc[i] = 0.f;
    for (int nn = 0; nn < 96; ++nn) { const float b = wuk[nn * 256 + r];
#pragma unroll
        for (int i = 0; i < 32; ++i) acc[i] += wuq[(kh * 32 + i) * 96 + nn] * b; }
    h16* dst = (h16*)(P.ws + WS_WQT) + (size_t)(256 + h * 256 + r) * 512 + kb * 64 + kh * 32;
    const float* gq = P.g_q + kb * 64 + kh * 32;
#pragma unroll
    for (int i = 0; i < 32; i += 8) { u32x4 o; o.x = pk2h(acc[i] * gq[i], acc[i + 1] * gq[i + 1]); o.y = pk2h(acc[i + 2] * gq[i + 2], acc[i + 3] * gq[i + 3]);
        o.z = pk2h(acc[i + 4] * gq[i + 4], acc[i + 5] * gq[i + 5]); o.w = pk2h(acc[i + 6] * gq[i + 6], acc[i + 7] * gq[i + 7]); *(u32x4*)(dst + i) = o; }
    __syncthreads();
}
__device__ __forceinline__ void phase_prologue(const Params& P, LAS unsigned char* lds) {
    const int tid = threadIdx.x, lane = tid & 63, w = tid >> 6, G = gridDim.x, bid = blockIdx.x;
    for (int u = bid; u < 256; u += G) p0_mod_unit(P, u, lds);
    for (int u = bid; u < 64; u += G) p0_fold_unit(P, u, lds);
    {
        float* r32 = (float*)(P.ws + WS_ROPE32); float* r16 = (float*)(P.ws + WS_ROPE16);
        for (int e = bid * NTHR + tid; e < SEQ * 24; e += G * NTHR) {
            const int pos = e / 24, i = e % 24;
            const float inv = (i < 16) ? (float)pow(500000.0, -(double)i / 16.0) : (float)pow(500000.0, -(double)(i - 16) / 8.0);
            const float ang = (float)pos * inv;
            const float cv = (float)cos((double)ang), sv = (float)sin((double)ang);
            if (i < 16) { r32[((size_t)pos * 16 + i) * 2] = cv; r32[((size_t)pos * 16 + i) * 2 + 1] = sv; }
            else { r16[((size_t)pos * 8 + (i - 16)) * 2] = cv; r16[((size_t)pos * 8 + (i - 16)) * 2 + 1] = sv; }
        }
    }
    {
        h16* WUVT = (h16*)(P.ws + WS_WUVT);
        for (int e = bid * NTHR + tid; e < 1024 * 32; e += G * NTHR) { const int n = e >> 5, c8 = e & 31, hh = n >> 7; const int k = ((hh & 1) ? 0 : 256) + c8 * 8;
            *(u32x4*)(WUVT + (size_t)n * 512 + k) = (u32x4){0u, 0u, 0u, 0u}; }
    }
    LAS float* scr = (LAS float*)(lds + w * 16384);
    const int gw = bid * NWAVE + w, NGW = G * NWAVE;
    constexpr int I_W1 = 32 * 192, I_QR = 8 * 8, I_QI = 8 * 32, I_UV = 8 * 4 * 4, I_WO = 32 * 64;
    for (int it = gw; it < I_W1 + I_QR + I_QI + I_UV + I_WO; it += NGW) {
        int r = it;
        if (r < I_W1) { transpose_item(P.w_in, 6000, nullptr, (h16*)(P.ws + WS_W1T), 2048, (r / 192) * 64, (r % 192) * 32, SrcW1(), scr, lane); continue; } r -= I_W1;
        if (r < I_QR) { transpose_item(P.w_uq, 1024, P.g_q, (h16*)(P.ws + WS_WQT), 512, (r / 8) * 64, (r % 8) * 32, SrcQRope(), scr, lane); continue; } r -= I_QR;
        if (r < I_QI) { transpose_item(P.w_uq_idx, 1024, P.g_q, (h16*)(P.ws + WS_WQT) + (size_t)2304 * 512, 512, (r / 32) * 64, (r % 32) * 32, SrcId(), scr, lane); continue; } r -= I_QI;
        if (r < I_UV) { const int hh = r >> 4, kb = (r >> 2) & 3, nb = r & 3;
            transpose_item(P.w_uv + (size_t)hh * 256 * 128, 128, nullptr, (h16*)(P.ws + WS_WUVT) + (size_t)(hh * 128) * 512 + 256 * (hh & 1), 512, kb * 64, nb * 32, SrcId(), scr, lane); continue; } r -= I_UV;
        transpose_item(P.w_out, 2048, nullptr, (h16*)(P.ws + WS_WOT), 2048, (r / 64) * 64, (r % 64) * 32, SrcId(), scr, lane);
    }
}

__device__ __forceinline__ void load_mod(const Params& P, int b, int off, LAS float* dst, bool plus1) {
    const float* MODP = (const float*)(P.ws + WS_MODP);
    for (int j = threadIdx.x; j < 2048; j += NTHR) { float s = P.b_ada[off + j];
#pragma unroll
        for (int kc = 0; kc < 8; ++kc) s += MODP[(size_t)(kc * 4 + b) * 6144 + off + j];
        dst[j] = plus1 ? 1.0f + s : s; }
}
__device__ __forceinline__ void phase_h(const Params& P, LAS unsigned char* lds) {
    const int tid = threadIdx.x, lane = tid & 63, w = tid >> 6;
    LAS float* shift = (LAS float*)lds; LAS float* scale1 = (LAS float*)(lds + 8192);
    h16* H = (h16*)(P.ws + WS_H);
    for (int ch = blockIdx.x; ch < 256; ch += gridDim.x) {
        const int b = ch >> 6;
        __syncthreads();
        load_mod(P, b, 0, shift, false); load_mod(P, b, 2048, scale1, true);
        __syncthreads();
        for (int i = 0; i < 8; ++i) {
            const int row = ch * 64 + w * 8 + i;
            const float* xr = P.x + (size_t)row * DM + 4 * lane;
            f32x4 v[8]; float ss = 0.f;
#pragma unroll
            for (int j = 0; j < 8; ++j) { v[j] = *(const f32x4*)(xr + 256 * j); ss += (v[j][0] * v[j][0] + v[j][1] * v[j][1]) + (v[j][2] * v[j][2] + v[j][3] * v[j][3]); }
            const float rstd = 1.0f / sqrtf(wave_sum(ss) * (1.0f / DM) + EPS);
#pragma unroll
            for (int j = 0; j < 8; ++j) { const int col = 4 * lane + 256 * j; const f32x4 g = *(const f32x4*)(P.g_pre + col);
                const f32x4 s1 = *(const LAS f32x4*)(scale1 + col), sh = *(const LAS f32x4*)(shift + col);
                const f32x4 o = v[j] * rstd * g * s1 + sh; u32x2 pk; pk.x = pk2h(o[0], o[1]); pk.y = pk2h(o[2], o[3]);
                *(u32x2*)(H + (size_t)row * DM + col) = pk; }
        }
    }
}
__device__ __forceinline__ void phase_rowops(const Params& P) {
    const int tid = threadIdx.x, lane = tid & 63, w = tid >> 6;
    h16* KVC = (h16*)(P.ws + WS_KVC); h16* KIDX = (h16*)(P.ws + WS_KIDX); float* WIDX = (float*)(P.ws + WS_WIDX);
    const float* SMALL = (const float*)(P.ws + WS_SMALL); const float* r32 = (const float*)(P.ws + WS_ROPE32); const float* r16 = (const float*)(P.ws + WS_ROPE16);
    for (int row = blockIdx.x * NWAVE + w; row < T; row += gridDim.x * NWAVE) {
        const int pos = row & (SEQ - 1);
        h16* kr = KVC + (size_t)row * KVW;
        const h16x4 raw = *(const h16x4*)(kr + 4 * lane);
        float v[4]; float ss = 0.f;
#pragma unroll
        for (int e = 0; e < 4; ++e) { v[e] = (float)raw[e]; ss += v[e] * v[e]; }
        const float rstd = 1.0f / sqrtf(wave_sum(ss) * (1.0f / 256.0f) + EPS);
        const f32x4 g = *(const f32x4*)(P.g_kv + 4 * lane);
        u32x2 pk; pk.x = pk2h(v[0] * rstd * g[0], v[1] * rstd * g[1]); pk.y = pk2h(v[2] * rstd * g[2], v[3] * rstd * g[3]);
        *(u32x2*)(kr + 4 * lane) = pk;
        const float* sm = SMALL + (size_t)row * 128;
        if (lane < 32) {
            const int i = lane & 15; const float x1 = sm[i], x2 = sm[i + 16]; const float cv = r32[((size_t)pos * 16 + i) * 2], sv = r32[((size_t)pos * 16 + i) * 2 + 1];
            kr[256 + lane] = (h16)(lane < 16 ? x1 * cv - x2 * sv : x2 * cv + x1 * sv);
        }
        {
            float o = sm[32 + lane];
            if (lane < 16) { const int i = lane & 7; const float x1 = sm[32 + i], x2 = sm[32 + i + 8]; const float cv = r16[((size_t)pos * 8 + i) * 2], sv = r16[((size_t)pos * 8 + i) * 2 + 1];
                o = lane < 8 ? x1 * cv - x2 * sv : x2 * cv + x1 * sv; }
            KIDX[(size_t)row * 64 + lane] = (h16)o;
        }
        if (lane < 16) WIDX[(size_t)row * 16 + lane] = sm[96 + lane] * (1.0f / 32.0f);
    }
}
__device__ __forceinline__ void phase_final(const Params& P, LAS unsigned char* lds) {
    const int tid = threadIdx.x, lane = tid & 63, w = tid >> 6;
    LAS float* gate = (LAS float*)lds;
    const h16* Y = (const h16*)(P.ws + WS_Y); const float* SSY = (const float*)(P.ws + WS_SSY);
    for (int ch = blockIdx.x; ch < 256; ch += gridDim.x) {
        const int b = ch >> 6;
        __syncthreads();
        load_mod(P, b, 4096, gate, false);
        __syncthreads();
        for (int i = 0; i < 8; ++i) {
            const int row = ch * 64 + w * 8 + i;
            float ss = (lane < 32) ? SSY[(size_t)lane * T + row] : 0.f;
            const float rstd = 1.0f / sqrtf(wave_sum(ss) * (1.0f / DM) + EPS);
#pragma unroll
            for (int j = 0; j < 8; ++j) { const int col = 4 * lane + 256 * j;
                const f32x4 xv = *(const f32x4*)(P.x + (size_t)row * DM + col); const h16x4 yv = *(const h16x4*)(Y + (size_t)row * DM + col);
                const f32x4 g = *(const f32x4*)(P.g_post + col), gt = *(const LAS f32x4*)(gate + col);
                f32x4 o;
#pragma unroll
                for (int e = 0; e < 4; ++e) o[e] = xv[e] + gt[e] * ((float)yv[e] * rstd * g[e]);
                *(f32x4*)(P.out + (size_t)row * DM + col) = o; }
        }
    }
}


__device__ __forceinline__ void phase_dilated_naive(const Params& P, LAS unsigned char* lds) {
    const int tid = threadIdx.x, lane = tid & 63, w = tid >> 6;
    LAS float* qs = (LAS float*)(lds + w * 2560); LAS float* ps = qs + 128;
    const h16* QB = (const h16*)(P.ws + WS_QB); const h16* KB = (const h16*)(P.ws + WS_KB); const h16* VB = (const h16*)(P.ws + WS_VB); const h16* SGB = (const h16*)(P.ws + WS_SGB);
    h16* OAB = (h16*)(P.ws + WS_OAB);
    for (int item = blockIdx.x * NWAVE + w; item < T * 8; item += gridDim.x * NWAVE) {
        const int row = item >> 3, h = item & 7, b = row >> 12, t = row & (SEQ - 1);
        { const h16x2 q2 = *(const h16x2*)(QB + (size_t)row * 1024 + h * 128 + 2 * lane); qs[2 * lane] = (float)q2[0]; qs[2 * lane + 1] = (float)q2[1]; }
        float sv[7]; float mx = -INFINITY;
#pragma unroll
        for (int i = 0; i < 7; ++i) {
            const int e = lane + 64 * i; sv[i] = -INFINITY;
            if (e < 387) { const int c = e / 129, j = e % 129, dil = c == 0 ? 1 : (c == 1 ? 4 : 16), kt = t - j * dil;
                if (kt >= 0) { const h16* kr = KB + (size_t)(b * SEQ + kt) * 1024 + h * 128; float s = 0.f;
                    for (int d = 0; d < 128; d += 8) { const h16x8 kv = *(const h16x8*)(kr + d);
#pragma unroll
                        for (int x = 0; x < 8; ++x) s += qs[d + x] * (float)kv[x]; }
                    sv[i] = s; } }
            mx = fmaxf(mx, sv[i]);
        }
        mx = wave_max(mx);
        float sum = 0.f;
#pragma unroll
        for (int i = 0; i < 7; ++i) { const int e = lane + 64 * i; const float p = (sv[i] == -INFINITY) ? 0.f : exp2f(sv[i] - mx); sum += p; if (e < 392) ps[e] = p; }
        sum = wave_sum(sum);
        float a0 = 0.f, a1 = 0.f;
        for (int e = 0; e < 387; ++e) { const int c = e / 129, j = e % 129, dil = c == 0 ? 1 : (c == 1 ? 4 : 16), kt = t - j * dil;
            if (kt >= 0) { const float p = ps[e]; const h16x2 v2 = *(const h16x2*)(VB + (size_t)(b * SEQ + kt) * 1024 + h * 128 + 2 * lane); a0 += p * (float)v2[0]; a1 += p * (float)v2[1]; } }
        const float inv = 1.0f / sum;
        const h16x2 g2 = *(const h16x2*)(SGB + (size_t)row * 1024 + h * 128 + 2 * lane);
        const h16x2 o2 = {(h16)(a0 * inv * (float)g2[0]), (h16)(a1 * inv * (float)g2[1])};
        *(h16x2*)(OAB + (size_t)row * 2048 + 1024 + h * 128 + 2 * lane) = o2;
    }
}

constexpr int SP_BUF = 18432;
constexpr int SP_LIST = 8 * SP_BUF;
__device__ __forceinline__ void sparse_attn_query(const Params& P, LAS unsigned char* lds, int wid, int lane, int b, int row, int kvalid, const LAS unsigned short* list);
__device__ __forceinline__ void phase_dsa_naive(const Params& P, LAS unsigned char* lds) {
    const int tid = threadIdx.x, lane = tid & 63, w = tid >> 6;
    LAS float* sc = (LAS float*)lds;
    LAS float* qv = (LAS float*)(lds + 131072);
    LAS float* wv = qv + 1024;
    const h16* QIDX = (const h16*)(P.ws + WS_QIDX); const h16* KIDX = (const h16*)(P.ws + WS_KIDX); const float* WIDX = (const float*)(P.ws + WS_WIDX);
    const h16* QLAT = (const h16*)(P.ws + WS_QLAT); const h16* QROPE = (const h16*)(P.ws + WS_QROPE); const h16* KVC = (const h16*)(P.ws + WS_KVC); h16* OLAT = (h16*)(P.ws + WS_OLAT);
    for (int item = blockIdx.x; item < T / 8; item += gridDim.x) {
        const int row0 = item * 8, b = row0 >> 12;
        for (int qi = 0; qi < 8; ++qi) {
            const int row = row0 + qi, t = row & (SEQ - 1);
            __syncthreads();
            for (int i = tid; i < 1024; i += NTHR) qv[i] = (float)QIDX[(size_t)row * 1024 + i];
            if (tid < 16) wv[tid] = WIDX[(size_t)row * 16 + tid];
            __syncthreads();
            for (int k = tid; k <= t; k += NTHR) {
                float kf[64];
                const h16* kr = KIDX + (size_t)(b * SEQ + k) * 64;
#pragma unroll
                for (int d = 0; d < 64; d += 8) { const h16x8 kv = *(const h16x8*)(kr + d);
#pragma unroll
                    for (int x = 0; x < 8; ++x) kf[d + x] = (float)kv[x]; }
                float acc = 0.f;
                for (int h = 0; h < 16; ++h) { float dt = 0.f;
#pragma unroll
                    for (int d = 0; d < 64; ++d) dt += qv[h * 64 + d] * kf[d];
                    acc += wv[h] * fmaxf(dt, 0.f); }
                sc[qi * SEQ + k] = acc + 0.0f;
            }
        }
        __syncthreads();
        {
            const int row = row0 + w, t = row & (SEQ - 1), n = t + 1;
            LAS float* myrow = sc + w * SEQ;
            LAS unsigned short* idxs = (LAS unsigned short*)(lds + SP_LIST) + w * 256;
            if (n <= 256) {
#pragma unroll
                for (int i = 0; i < 4; ++i) { const int k = lane + 64 * i; idxs[k] = (k < n) ? (unsigned short)k : (unsigned short)0xFFFFu; }
            } else {
                const LAS unsigned* ur = (const LAS unsigned*)myrow;
                const int ni = (n + 63) >> 6;
                auto key = [&](int i) -> unsigned { const int k = 64 * i + lane; const unsigned bits = ur[k]; const unsigned u = (bits & 0x80000000u) ? ~bits : (bits | 0x80000000u); return (k < n) ? u : 0u; };
                unsigned thr = 0u;
                for (int bit = 31; bit >= 0; --bit) {
                    const unsigned cand = thr | (1u << bit); int cnt = 0;
                    for (int i = 0; i < ni; ++i) cnt += __popcll(__ballot(key(i) >= cand));
                    if (cnt >= 256) thr = cand;
                }
                int cgt = 0;
                for (int i = 0; i < ni; ++i) cgt += __popcll(__ballot(key(i) > thr));
                const int need_eq = 256 - cgt;
                int base = 0, eqb = 0;
                for (int i = 0; i < ni; ++i) { const unsigned u = key(i); const bool eq = u == thr; const unsigned long long me = __ballot(eq);
                    const int eqr = eqb + __popcll(me & ((1ull << lane) - 1ull));
                    const bool sel = u > thr || (eq && eqr < need_eq); const unsigned long long mk = __ballot(sel);
                    const int pos = base + __popcll(mk & ((1ull << lane) - 1ull));
                    if (sel && pos < 256) idxs[pos] = (unsigned short)(64 * i + lane);
                    base += __popcll(mk); eqb += __popcll(me); }
            }
        }
        __syncthreads();
        { const int row = row0 + w, t = row & (SEQ - 1); sparse_attn_query(P, lds, w, lane, b, row, (t + 1 < 256) ? t + 1 : 256, (const LAS unsigned short*)(lds + SP_LIST) + w * 256); }
        __syncthreads();
    }
}

typedef float f32x16 __attribute__((ext_vector_type(16)));
typedef short s16x4 __attribute__((ext_vector_type(4)));
__device__ __forceinline__ unsigned imgb_off(unsigned row, unsigned ch) { return 256u * row + 16u * (ch ^ (((row & 3u) << 2) | ((row >> 2) & 3u))); }
constexpr int DIL_STG = 98304, DIL_LSE = DIL_STG + 8 * 4608;
__device__ __forceinline__ void dil_stage(LAS unsigned char* lds, const h16* src_bh, int m0, int dil, int res, int tid, int wid) {
#pragma unroll
    for (int p = 0; p < 12; ++p) {
        const int kk = p * 32 + (tid >> 4); int j = m0 - 128 + kk; j = j < 0 ? 0 : j;
        const unsigned sw = (unsigned)(((kk & 3) << 2) | ((kk >> 2) & 3));
        const h16* g = src_bh + (size_t)(j * dil + res) * 1024 + 8 * ((unsigned)(tid & 15) ^ sw);
        __builtin_amdgcn_global_load_lds((const unsigned*)g, (LAS unsigned*)(lds + p * 8192 + wid * 1024), 16, 0, 0);
    }
}
template <bool LAST>
__device__ __forceinline__ void dilated_unit(const Params& P, LAS unsigned char* lds, int dil, int pslot, int b, int h, int res, int blk) {
    const int tid = threadIdx.x, lane = tid & 63, wid = __builtin_amdgcn_readfirstlane(tid >> 6), n = lane & 31, hi = lane >> 5;
    const int m0 = blk * 256;
    const size_t bh = (size_t)b * SEQ * 1024 + h * 128;
    const h16* QBp = (const h16*)(P.ws + WS_QB) + bh; const h16* KBp = (const h16*)(P.ws + WS_KB) + bh; const h16* VBp = (const h16*)(P.ws + WS_VB) + bh;
    dil_stage(lds, KBp, m0, dil, res, tid, wid);
    h16x8 qf[8];
    { const h16* qp = QBp + (size_t)((m0 + 32 * wid + n) * dil + res) * 1024 + 8 * hi;
#pragma unroll
      for (int ks = 0; ks < 8; ++ks) qf[ks] = *(const h16x8*)(qp + 16 * ks); }
    asm volatile("s_waitcnt vmcnt(0)" ::: "memory");
    __syncthreads();
    f32x16 sa[5];
#pragma unroll
    for (int ti = 0; ti < 5; ++ti) {
#pragma unroll
        for (int r = 0; r < 16; ++r) sa[ti][r] = 0.f;
#pragma unroll
        for (int ks = 0; ks < 8; ++ks) { const h16x8 kf = *(const LAS h16x8*)(lds + imgb_off(32 * (wid + ti) + n, 2 * ks + hi));
            sa[ti] = __builtin_amdgcn_mfma_f32_32x32x16_f16(kf, qf[ks], sa[ti], 0, 0, 0); }
    }
    const int jmin = 128 - m0;
    float mx = -INFINITY;
#pragma unroll
    for (int ti = 0; ti < 5; ++ti)
#pragma unroll
        for (int r = 0; r < 16; ++r) { const int kin = (r & 3) + 8 * (r >> 2) + 4 * hi; bool ok = (32 * (wid + ti) + kin) >= jmin;
            if (ti == 0) ok = ok && (kin >= n); if (ti == 4) ok = ok && (kin <= n);
            const float s = ok ? sa[ti][r] : -INFINITY; sa[ti][r] = s; mx = fmaxf(mx, s); }
    mx = fmaxf(mx, __shfl_xor(mx, 32));
    float l = 0.f;
#pragma unroll
    for (int ti = 0; ti < 5; ++ti)
#pragma unroll
        for (int r = 0; r < 16; ++r) { const float p = __builtin_amdgcn_exp2f(sa[ti][r] - mx); sa[ti][r] = p; l += p; }
    l += __shfl_xor(l, 32);
    h16x8 pf[5][2];
#pragma unroll
    for (int ti = 0; ti < 5; ++ti)
#pragma unroll
        for (int s = 0; s < 2; ++s)
#pragma unroll
            for (int jj = 0; jj < 8; ++jj) pf[ti][s][jj] = (h16)sa[ti][8 * s + jj];
    __syncthreads();
    dil_stage(lds, VBp, m0, dil, res, tid, wid);
    asm volatile("s_waitcnt vmcnt(0)" ::: "memory");
    __syncthreads();
    f32x16 oa[4];
#pragma unroll
    for (int c = 0; c < 4; ++c)
#pragma unroll
        for (int r = 0; r < 16; ++r) oa[c][r] = 0.f;
    const int dgrp = (lane >> 4) & 1, q4 = (lane & 15) >> 2, p4 = lane & 3;
#pragma unroll
    for (int ti = 0; ti < 5; ++ti)
#pragma unroll
        for (int s = 0; s < 2; ++s) {
#pragma unroll
            for (int c = 0; c < 4; ++c) {
                const unsigned row0 = 32 * (wid + ti) + 16 * s + 4 * hi + q4, ch = 4 * c + 2 * dgrp + (p4 >> 1);
                const s16x4 t0 = __builtin_amdgcn_ds_read_tr16_b64_v4i16((LAS s16x4*)(lds + imgb_off(row0, ch) + 8 * (p4 & 1)));
                const s16x4 t1 = __builtin_amdgcn_ds_read_tr16_b64_v4i16((LAS s16x4*)(lds + imgb_off(row0 + 8, ch) + 8 * (p4 & 1)));
                typedef short s16x8 __attribute__((ext_vector_type(8)));
                const s16x8 v8 = {t0[0], t0[1], t0[2], t0[3], t1[0], t1[1], t1[2], t1[3]};
                oa[c] = __builtin_amdgcn_mfma_f32_32x32x16_f16(__builtin_bit_cast(h16x8, v8), pf[ti][s], oa[c], 0, 0, 0);
            }
        }
    const float invl = 1.0f / l, lse = mx + __builtin_amdgcn_logf(l);
    LAS unsigned char* stg = lds + DIL_STG + wid * 4608;
    LAS float* lsew = (LAS float*)(lds + DIL_LSE) + wid * 32;
    float* LSEP = (float*)(P.ws + WS_LSEP);
    const int pos_n = (m0 + 32 * wid + n) * dil + res;
    if (LAST) { if (hi == 0) lsew[n] = lse; }
    else if (hi == 0) LSEP[((size_t)pslot * T + (size_t)b * SEQ + pos_n) * 8 + h] = lse;
#pragma unroll
    for (int half = 0; half < 2; ++half) {
#pragma unroll
        for (int cc = 0; cc < 2; ++cc)
#pragma unroll
            for (int rg = 0; rg < 4; ++rg) { const f32x16& o = oa[2 * half + cc]; u32x2 w2; w2.x = pk2h(o[4 * rg] * invl, o[4 * rg + 1] * invl); w2.y = pk2h(o[4 * rg + 2] * invl, o[4 * rg + 3] * invl);
                *(LAS u32x2*)(stg + n * 144 + 2 * (32 * cc + 8 * rg + 4 * hi)) = w2; }
        asm volatile("s_waitcnt lgkmcnt(0)" ::: "memory");
#pragma unroll
        for (int i = 0; i < 4; ++i) {
            const int rowl = (lane >> 3) + 8 * i, ch = lane & 7;
            const u32x4 v = *(const LAS u32x4*)(stg + rowl * 144 + 16 * ch);
            const size_t grow = (size_t)b * SEQ + (size_t)((m0 + 32 * wid + rowl) * dil + res);
            const size_t coff = (size_t)h * 128 + 64 * half + 8 * ch;
            if (!LAST) { *(u32x4*)((h16*)(P.ws + (pslot ? WS_OP16 : WS_OP4)) + grow * 1024 + coff) = v; }
            else {
                const float l1 = lsew[rowl], l4 = LSEP[grow * 8 + h], l16 = LSEP[((size_t)T + grow) * 8 + h];
                const float mm = fmaxf(l1, fmaxf(l4, l16));
                const float w1 = __builtin_amdgcn_exp2f(l1 - mm), w4 = __builtin_amdgcn_exp2f(l4 - mm), w16 = __builtin_amdgcn_exp2f(l16 - mm), iw = 1.0f / (w1 + w4 + w16);
                const h16x8 o1 = __builtin_bit_cast(h16x8, v);
                const h16x8 o4 = *(const h16x8*)((const h16*)(P.ws + WS_OP4) + grow * 1024 + coff), o16 = *(const h16x8*)((const h16*)(P.ws + WS_OP16) + grow * 1024 + coff);
                const h16x8 gt = *(const h16x8*)((const h16*)(P.ws + WS_SGB) + grow * 1024 + coff);
                float r8[8];
#pragma unroll
                for (int e = 0; e < 8; ++e) r8[e] = (w1 * (float)o1[e] + w4 * (float)o4[e] + w16 * (float)o16[e]) * iw * (float)gt[e];
                u32x4 ov; ov.x = pk2h(r8[0], r8[1]); ov.y = pk2h(r8[2], r8[3]); ov.z = pk2h(r8[4], r8[5]); ov.w = pk2h(r8[6], r8[7]);
                *(u32x4*)((h16*)(P.ws + WS_OAB) + grow * 2048 + 1024 + coff) = ov;
            }
        }
        asm volatile("s_waitcnt lgkmcnt(0)" ::: "memory");
    }
    __syncthreads();
}
__device__ __forceinline__ void phase_dilated_part(const Params& P, LAS unsigned char* lds) {
    for (int idx = blockIdx.x; idx < 1024; idx += gridDim.x) {
        const int cfg = idx >> 9, w_ = idx & 511, xcd = w_ & 7, lu = w_ >> 3, bhh = xcd * 4 + (lu >> 4), rb = lu & 15;
        if (cfg == 0) dilated_unit<false>(P, lds, 4, 0, bhh >> 3, bhh & 7, rb & 3, rb >> 2);
        else dilated_unit<false>(P, lds, 16, 1, bhh >> 3, bhh & 7, rb, 0);
    }
}
__device__ __forceinline__ void phase_dilated_last(const Params& P, LAS unsigned char* lds) {
    for (int idx = blockIdx.x; idx < 512; idx += gridDim.x) {
        const int xcd = idx & 7, lu = idx >> 3, bhh = xcd * 4 + (lu >> 4), blk = lu & 15;
        dilated_unit<true>(P, lds, 1, 0, bhh >> 3, bhh & 7, 0, blk);
    }
}

__device__ __forceinline__ void sparse_attn_query(const Params& P, LAS unsigned char* lds, int wid, int lane, int b, int row, int kvalid, const LAS unsigned short* list) {
    LAS unsigned char* buf = lds + wid * SP_BUF;
    const int n = lane & 15, g = lane >> 4, q4 = n >> 2, p4 = n & 3;
    h16x8 qf[9];
    {
        const h16* ql = (const h16*)(P.ws + WS_QLAT) + ((size_t)row * 8 + (n & 7)) * 256 + 8 * g;
        const h16* qr = (const h16*)(P.ws + WS_QROPE) + ((size_t)row * 8 + (n & 7)) * 32 + 8 * g;
        const h16x8 z = {(h16)0.f, (h16)0.f, (h16)0.f, (h16)0.f, (h16)0.f, (h16)0.f, (h16)0.f, (h16)0.f};
#pragma unroll
        for (int ks = 0; ks < 8; ++ks) { const h16x8 v = *(const h16x8*)(ql + 32 * ks); qf[ks] = (n < 8) ? v : z; }
        { const h16x8 v = *(const h16x8*)qr; qf[8] = (n < 8) ? v : z; }
    }
    f32x4 oacc[16];
#pragma unroll
    for (int dt = 0; dt < 16; ++dt) oacc[dt] = (f32x4){0.f, 0.f, 0.f, 0.f};
    float m = -INFINITY, l = 0.f;
    const unsigned char* kvb = P.ws + WS_KVC + (size_t)b * SEQ * (KVW * 2);
    for (int step = 0; step < 8; ++step) {
        int lane_o = lane; asm volatile("" : "+v"(lane_o));
#pragma unroll
        for (int p = 0; p < 18; ++p) {
            const int byte = 1024 * p + 16 * lane_o, r = byte / 576, off = byte - 576 * r;
            unsigned id = list[32 * step + r]; id = (id == 0xFFFFu) ? 0u : id;
            __builtin_amdgcn_global_load_lds((const unsigned*)(kvb + (size_t)id * 576 + off), (LAS unsigned*)(buf + 1024 * p), 16, 0, 0);
        }
        asm volatile("s_waitcnt vmcnt(0)" ::: "memory");
        f32x4 s0 = (f32x4){0.f, 0.f, 0.f, 0.f}, s1 = (f32x4){0.f, 0.f, 0.f, 0.f};
#pragma unroll
        for (int ks = 0; ks < 9; ++ks) {
            const h16x8 a0 = *(const LAS h16x8*)(buf + 576 * n + 64 * ks + 16 * g), a1 = *(const LAS h16x8*)(buf + 576 * (16 + n) + 64 * ks + 16 * g);
            s0 = __builtin_amdgcn_mfma_f32_16x16x32_f16(a0, qf[ks], s0, 0, 0, 0); s1 = __builtin_amdgcn_mfma_f32_16x16x32_f16(a1, qf[ks], s1, 0, 0, 0);
        }
        float mx = -INFINITY;
#pragma unroll
        for (int r = 0; r < 4; ++r) { const int lp = 32 * step + 4 * g + r;
            s0[r] = (lp < kvalid && list[lp] != 0xFFFFu) ? s0[r] : -INFINITY; s1[r] = (lp + 16 < kvalid && list[lp + 16] != 0xFFFFu) ? s1[r] : -INFINITY; mx = fmaxf(mx, fmaxf(s0[r], s1[r])); }
        mx = fmaxf(mx, __shfl_xor(mx, 16)); mx = fmaxf(mx, __shfl_xor(mx, 32));
        const float mnew = fmaxf(m, mx), alpha = __builtin_amdgcn_exp2f(m - mnew);
        m = mnew; l *= alpha;
        h16x8 pf;
#pragma unroll
        for (int r = 0; r < 4; ++r) { const float p0 = __builtin_amdgcn_exp2f(s0[r] - mnew), p1 = __builtin_amdgcn_exp2f(s1[r] - mnew); l += p0 + p1; pf[r] = (h16)p0; pf[4 + r] = (h16)p1; }
#pragma unroll
        for (int dt = 0; dt < 16; ++dt) oacc[dt] = oacc[dt] * alpha;
#pragma unroll
        for (int dt = 0; dt < 16; ++dt) {
            const s16x4 t0 = __builtin_amdgcn_ds_read_tr16_b64_v4i16((LAS s16x4*)(buf + 576 * (4 * g + q4) + 32 * dt + 8 * p4));
            const s16x4 t1 = __builtin_amdgcn_ds_read_tr16_b64_v4i16((LAS s16x4*)(buf + 576 * (16 + 4 * g + q4) + 32 * dt + 8 * p4));
            typedef short s16x8 __attribute__((ext_vector_type(8)));
            const s16x8 v8 = {t0[0], t0[1], t0[2], t0[3], t1[0], t1[1], t1[2], t1[3]};
            oacc[dt] = __builtin_amdgcn_mfma_f32_16x16x32_f16(__builtin_bit_cast(h16x8, v8), pf, oacc[dt], 0, 0, 0);
        }
        asm volatile("s_waitcnt lgkmcnt(0)" ::: "memory");
    }
    l += __shfl_xor(l, 16); l += __shfl_xor(l, 32);
    const float inv = 1.0f / l;
    if (n < 8) {
        h16* op = (h16*)(P.ws + WS_OLAT) + ((size_t)row * 8 + n) * 256 + 4 * g;
#pragma unroll
        for (int dt = 0; dt < 16; ++dt) { u32x2 w2; w2.x = pk2h(oacc[dt][0] * inv, oacc[dt][1] * inv); w2.y = pk2h(oacc[dt][2] * inv, oacc[dt][3] * inv); *(u32x2*)(op + 16 * dt) = w2; }
    }
}

constexpr int DS_QI = 0;
constexpr int DS_WQ = 32768;
constexpr int DS_CNTB = DS_WQ + 1024;
constexpr int DS_CGT = DS_CNTB + 1024;
constexpr int DS_CEQ = DS_CGT + 512;
constexpr int DS_PCNT = DS_CEQ + 512;
constexpr int DS_TCNT = DS_PCNT + 2048;
constexpr int DS_TLIST = DS_TCNT + 64;
constexpr int DS_TSC = DS_TLIST + 2048;
constexpr int DS_LIST = SP_LIST;
constexpr int TIE_CAP = 64;
__device__ __forceinline__ unsigned sortable_hi16(float s) { const unsigned bits = __float_as_uint(s + 0.0f); return ((bits & 0x80000000u) ? ~bits : (bits | 0x80000000u)) >> 16; }
typedef _Float16 h16x2v __attribute__((ext_vector_type(2)));
__device__ __forceinline__ unsigned pk_count_gt(unsigned acc, unsigned v, unsigned cm1pk) {
    unsigned d;
    asm("v_pk_sub_u16 %1, %2, %3 clamp\n\tv_pk_min_u16 %1, %1, %4\n\tv_pk_add_u16 %0, %0, %1" : "+v"(acc), "=&v"(d) : "v"(v), "v"(cm1pk), "v"(0x00010001u));
    return acc;
}

__device__ __forceinline__ void dsa_select_unit(const Params& P, LAS unsigned char* lds, int b, int uq) {
    const int tid = threadIdx.x, lane = tid & 63, w = __builtin_amdgcn_readfirstlane(tid >> 6), q = lane & 15, kq = lane >> 4;
    const int t0 = 16 * uq, row0 = b * SEQ + t0, tq = t0 + q, ntile = uq + 1, Kq = (tq + 1 < 256) ? tq + 1 : 256;
    const h16* QIDX = (const h16*)(P.ws + WS_QIDX); const h16* KIDX = (const h16*)(P.ws + WS_KIDX) + (size_t)b * SEQ * 64; const float* WIDX = (const float*)(P.ws + WS_WIDX);
    LAS float* WQ = (LAS float*)(lds + DS_WQ); LAS unsigned* CNTB = (LAS unsigned*)(lds + DS_CNTB); LAS unsigned* CGT = (LAS unsigned*)(lds + DS_CGT); LAS unsigned* CEQ = (LAS unsigned*)(lds + DS_CEQ);
    LAS unsigned* PCNT = (LAS unsigned*)(lds + DS_PCNT); LAS unsigned* TCNT = (LAS unsigned*)(lds + DS_TCNT); LAS unsigned short* TLIST = (LAS unsigned short*)(lds + DS_TLIST);
    LAS float* TSC = (LAS float*)(lds + DS_TSC); LAS unsigned short* LIST = (LAS unsigned short*)(lds + DS_LIST);
#pragma unroll
    for (int i = 0; i < 4; ++i) { const int pc = 4 * w + i, head = pc >> 1, r = 8 * (pc & 1) + (lane >> 3), c = lane & 7;
        __builtin_amdgcn_global_load_lds((const unsigned*)(QIDX + (size_t)(row0 + r) * 1024 + head * 64 + 8 * (c ^ ((r >> 1) & 7))), (LAS unsigned*)(lds + DS_QI + pc * 1024), 16, 0, 0); }
    if (tid < 256) WQ[tid] = WIDX[(size_t)(row0 + (tid >> 4)) * 16 + (tid & 15)];
    if (tid < 16) TCNT[tid] = 0u;
    *(LAS u32x4*)(lds + DS_LIST + tid * 16) = (u32x4){0xFFFFFFFFu, 0xFFFFFFFFu, 0xFFFFFFFFu, 0xFFFFFFFFu};
    asm volatile("s_waitcnt vmcnt(0)" ::: "memory");
    __syncthreads();
    unsigned cs[64];
#pragma unroll
    for (int i = 0; i < 64; ++i) cs[i] = 0u;
    const unsigned sw = (unsigned)((q >> 1) & 7);
    const f32x4 zero4 = {0.f, 0.f, 0.f, 0.f};
    for (int grp = 0; grp < 8; ++grp) {
        const int tt0 = w + 32 * grp;
        if (tt0 >= ntile) break;
        h16x8 kf[4][2];
#pragma unroll
        for (int j = 0; j < 4; ++j) { const int tt = tt0 + 8 * j, ttc = tt < ntile ? tt : ntile - 1; const h16* kp = KIDX + (size_t)(16 * ttc + q) * 64 + 8 * kq;
            kf[j][0] = *(const h16x8*)kp; kf[j][1] = *(const h16x8*)(kp + 32); }
        f32x4 acc[4] = {zero4, zero4, zero4, zero4};
#pragma unroll 2
        for (int h = 0; h < 16; ++h) {
            const LAS unsigned char* qb = lds + DS_QI + h * 2048 + q * 128;
            const h16x8 q0 = *(const LAS h16x8*)(qb + 16 * ((unsigned)kq ^ sw)), q1 = *(const LAS h16x8*)(qb + 16 * ((unsigned)(4 + kq) ^ sw));
            const float wh = WQ[q * 16 + h];
#pragma unroll
            for (int j = 0; j < 4; ++j) { f32x4 lg = __builtin_amdgcn_mfma_f32_16x16x32_f16(kf[j][0], q0, zero4, 0, 0, 0); lg = __builtin_amdgcn_mfma_f32_16x16x32_f16(kf[j][1], q1, lg, 0, 0, 0);
#pragma unroll
                for (int r = 0; r < 4; ++r) acc[j][r] += wh * fmaxf(lg[r], 0.f); }
        }
        unsigned c8[8];
#pragma unroll
        for (int j = 0; j < 4; ++j) { const int tt = tt0 + 8 * j; unsigned c4[4];
#pragma unroll
            for (int r = 0; r < 4; ++r) { const int k = 16 * tt + 4 * kq + r; c4[r] = (tt < ntile && k <= tq) ? sortable_hi16(acc[j][r]) : 0u; }
            c8[j * 2] = c4[0] | (c4[1] << 16); c8[j * 2 + 1] = c4[2] | (c4[3] << 16); }
#define CS_PUT(G) case G: _Pragma("unroll") for (int i = 0; i < 8; ++i) cs[G * 8 + i] = c8[i]; break;
        switch (grp) { CS_PUT(0) CS_PUT(1) CS_PUT(2) CS_PUT(3) CS_PUT(4) CS_PUT(5) CS_PUT(6) default: _Pragma("unroll") for (int i = 0; i < 8; ++i) cs[56 + i] = c8[i]; break; }
#undef CS_PUT
    }
    unsigned thr = 0u;
    for (int bit = 15; bit >= 0; --bit) {
        const unsigned cand = thr | (1u << bit), cm1 = (cand - 1u) * 0x00010001u; unsigned cp = 0u;
#pragma unroll
        for (int i = 0; i < 64; ++i) cp = pk_count_gt(cp, cs[i], cm1);
        unsigned cnt = (cp & 0xFFFFu) + (cp >> 16);
        cnt += __shfl_xor(cnt, 16); cnt += __shfl_xor(cnt, 32);
        LAS unsigned* cb = CNTB + (bit & 1) * 128;
        if (kq == 0) cb[w * 16 + q] = cnt;
        __syncthreads();
        unsigned tot = 0u;
#pragma unroll
        for (int ww = 0; ww < 8; ++ww) tot += cb[ww * 16 + q];
        if (tot >= (unsigned)Kq) thr = cand;
    }
    unsigned cgt = 0u, ceq = 0u;
    {
        const unsigned t0p = thr * 0x00010001u, t1p = (thr - 1u) * 0x00010001u; unsigned cg = 0u, ce = 0u;
#pragma unroll
        for (int i = 0; i < 64; ++i) { cg = pk_count_gt(cg, cs[i], t0p); ce = pk_count_gt(ce, cs[i], t1p); }
        cgt = (cg & 0xFFFFu) + (cg >> 16); ceq = (ce & 0xFFFFu) + (ce >> 16) - cgt;
    }
    PCNT[w * 64 + lane] = cgt;
    unsigned cgw = cgt, cew = ceq;
    cgw += __shfl_xor(cgw, 16); cgw += __shfl_xor(cgw, 32); cew += __shfl_xor(cew, 16); cew += __shfl_xor(cew, 32);
    if (kq == 0) { CGT[w * 16 + q] = cgw; CEQ[w * 16 + q] = cew; }
    __syncthreads();
    unsigned gt_tot = 0u, eq_tot = 0u, base = 0u;
#pragma unroll
    for (int ww = 0; ww < 8; ++ww) { gt_tot += CGT[ww * 16 + q]; eq_tot += CEQ[ww * 16 + q]; }
    for (int ww = 0; ww < 8; ++ww)
#pragma unroll
        for (int kk = 0; kk < 4; ++kk) { const unsigned v = PCNT[ww * 64 + kk * 16 + q]; base += (ww < w || (ww == w && kk < kq)) ? v : 0u; }
    const unsigned need = (unsigned)Kq - gt_tot;
    const bool all_ties = (eq_tot == need);
    {
        LAS unsigned short* lq = LIST + q * 256; unsigned pos = base;
#pragma unroll
        for (int i = 0; i < 64; ++i) {
#pragma unroll
            for (int hf = 0; hf < 2; ++hf) {
                const unsigned v = hf ? (cs[i] >> 16) : (cs[i] & 0xFFFFu);
                const int grp = i >> 3, j = (i >> 1) & 3, r = 2 * (i & 1) + hf;
                const unsigned key = (unsigned)(16 * (w + 32 * grp + 8 * j) + 4 * kq + r);
                if (v > thr) { lq[pos] = (unsigned short)key; ++pos; }
                if (v == thr && v != 0u) { const unsigned slot = __hip_atomic_fetch_add(&TCNT[q], 1u, __ATOMIC_RELAXED, __HIP_MEMORY_SCOPE_WORKGROUP); if (slot < (unsigned)TIE_CAP) TLIST[q * TIE_CAP + slot] = (unsigned short)key; }
            }
            __builtin_amdgcn_sched_barrier(0);
        }
    }
    __syncthreads();
    for (int qi = 0; qi < 2; ++qi) {
        const int ql = w + 8 * qi;
        unsigned ntie = TCNT[ql]; ntie = ntie < (unsigned)TIE_CAP ? ntie : (unsigned)TIE_CAP;
        const unsigned gtq = __shfl(gt_tot, ql), needq = __shfl(need, ql);
        const int tql = t0 + ql;
        const int hh = lane & 15, jj = lane >> 4;
        const LAS unsigned char* qb = lds + DS_QI + hh * 2048 + ql * 128; const unsigned swq = (unsigned)((ql >> 1) & 7);
        const float wh = WQ[ql * 16 + hh];
        for (unsigned g0 = 0; g0 < ntie; g0 += 4) {
            const unsigned ti = g0 + jj; const unsigned key = (ti < ntie) ? TLIST[ql * TIE_CAP + ti] : 0u;
            const h16* kp = KIDX + (size_t)key * 64;
            float dt = 0.f;
#pragma unroll
            for (int c = 0; c < 8; ++c) { const h16x8 kv = *(const h16x8*)(kp + 8 * c); const h16x8 qv = *(const LAS h16x8*)(qb + 16 * ((unsigned)c ^ swq));
#pragma unroll
                for (int e = 0; e < 8; e += 2) { const h16x2v a = {kv[e], kv[e + 1]}, bq = {qv[e], qv[e + 1]}; dt = __builtin_amdgcn_fdot2(a, bq, dt, false); } }
            float sc = wh * fmaxf(dt, 0.f);
            sc += __shfl_xor(sc, 1); sc += __shfl_xor(sc, 2); sc += __shfl_xor(sc, 4); sc += __shfl_xor(sc, 8);
            if (hh == 0 && ti < ntie) TSC[ql * TIE_CAP + ti] = sc + 0.0f;
        }
        asm volatile("s_waitcnt lgkmcnt(0)" ::: "memory");
        const float mys = (lane < (int)ntie) ? TSC[ql * TIE_CAP + lane] : -INFINITY; const unsigned myk = (lane < (int)ntie) ? TLIST[ql * TIE_CAP + lane] : 0xFFFFu;
        unsigned rank = 0u;
        for (unsigned o = 0; o < ntie; ++o) { const float so = TSC[ql * TIE_CAP + o]; const unsigned ko = TLIST[ql * TIE_CAP + o]; rank += (so > mys || (so == mys && ko < myk)) ? 1u : 0u; }
        if (lane < (int)ntie && rank < needq) LIST[ql * 256 + gtq + rank] = (unsigned short)myk;
        (void)tql;
    }
    (void)all_ties;
    __syncthreads();
}

__device__ __forceinline__ void phase_dsa(const Params& P, LAS unsigned char* lds) {
    const int tid = threadIdx.x, lane = tid & 63, w = __builtin_amdgcn_readfirstlane(tid >> 6);
    for (int g = blockIdx.x; g < 256; g += gridDim.x) {
        const int b = (g & 7) >> 1, j = ((g & 1) << 5) | (g >> 3);
        for (int ui = 0; ui < 4; ++ui) {
            const int uq = (ui == 0) ? j : (ui == 1) ? 127 - j : (ui == 2) ? 128 + j : 255 - j;
            dsa_select_unit(P, lds, b, uq);
            for (int qi = 0; qi < 2; ++qi) { const int ql = w + 8 * qi, t = 16 * uq + ql;
                sparse_attn_query(P, lds, w, lane, b, b * SEQ + t, (t + 1 < 256) ? t + 1 : 256, (const LAS unsigned short*)(lds + DS_LIST) + ql * 256); }
            __syncthreads();
        }
    }
}

#define XB_TMO      128
#define XB_XCNT(j)  (256  + 64 * (j))
#define XB_XSUB(j)  (1280 + 64 * (j))
#define XB_XGEN(j)  (2304 + 64 * (j))
#define XB_TOP      3328
#define XB_TOPGEN   3392
#define XCD_BAR_WORDS 3456
#define XB_SPIN_CAP (1u << 22)
__device__ __forceinline__ unsigned xb_ld(unsigned* p)              { return __hip_atomic_load(p, __ATOMIC_RELAXED, __HIP_MEMORY_SCOPE_AGENT); }
__device__ __forceinline__ unsigned xb_add(unsigned* p, unsigned v) { return __hip_atomic_fetch_add(p, v, __ATOMIC_RELAXED, __HIP_MEMORY_SCOPE_AGENT); }
__device__ __forceinline__ unsigned xb_xcc_id() { return (unsigned)__builtin_amdgcn_s_getreg((3 << 11) | 20) & 0xFu; }
#define XB_SPIN(cond, bar) do { unsigned _sp = 0; while (cond) { __builtin_amdgcn_s_sleep(1); \
    if ((++_sp & 255u) == 0u) { if (xb_ld(&(bar)[XB_TMO])) break; if (_sp > XB_SPIN_CAP) { atomicAdd(&(bar)[XB_TMO], 1u); break; } } } } while (0)
struct XcdBarrier { unsigned* bar; unsigned x; volatile LAS unsigned* st; };
__device__ __forceinline__ XcdBarrier xcd_barrier_post(unsigned* bar, volatile LAS unsigned* st) {
    XcdBarrier b; b.bar = bar; b.x = xb_xcc_id(); b.st = st;
    if (threadIdx.x == 0) (void)xb_add(&bar[XB_XCNT(b.x)], 1u);
    return b;
}
__device__ __forceinline__ void xcd_barrier_complete(unsigned* bar, unsigned x, unsigned& nloc, unsigned& nx) {
    const unsigned G = gridDim.x * gridDim.y * gridDim.z;
    unsigned sum, cnt, mine, sp = 0u;
    for (;;) {
        sum = 0u; cnt = 0u; mine = 0u;
#pragma unroll
        for (unsigned j = 0; j < 16; ++j) { const unsigned c = xb_ld(&bar[XB_XCNT(j)]); sum += c; cnt += (c > 0u) ? 1u : 0u; mine = (j == x) ? c : mine; }
        if (sum == G) break;
        __builtin_amdgcn_s_sleep(1);
        if ((++sp & 255u) == 0u) { if (xb_ld(&bar[XB_TMO])) break; if (sp > XB_SPIN_CAP) { atomicAdd(&bar[XB_TMO], 1u); break; } }
    }
    nloc = mine > 0u ? mine : 1u; nx = cnt > 0u ? cnt : 1u;
}
__device__ __forceinline__ void xcd_barrier(const XcdBarrier& b) {
    asm volatile("s_waitcnt vmcnt(0)" ::: "memory");
    __syncthreads();
    if (threadIdx.x == 0) {
        unsigned* bar = b.bar;
        __builtin_amdgcn_s_waitcnt(0);
        unsigned nloc = b.st[0], nx = b.st[1];
        if (nloc == 0u) { xcd_barrier_complete(bar, b.x, nloc, nx); b.st[0] = nloc; b.st[1] = nx; }
        const unsigned old = xb_add(&bar[XB_XSUB(b.x)], 1u);
        const unsigned gen = old / nloc;
        if (old + 1u == (gen + 1u) * nloc) {
            __builtin_amdgcn_fence(__ATOMIC_RELEASE, "agent");
            asm volatile("s_waitcnt vmcnt(0)" ::: "memory");
            const unsigned og = xb_add(&bar[XB_TOP], 1u);
            const unsigned tg = og / nx;
            if (og + 1u == (tg + 1u) * nx) xb_add(&bar[XB_TOPGEN], 1u);
            else XB_SPIN(xb_ld(&bar[XB_TOPGEN]) == tg, bar);
            __builtin_amdgcn_fence(__ATOMIC_ACQUIRE, "agent");
            xb_add(&bar[XB_XGEN(b.x)], 1u);
            asm volatile("s_waitcnt vmcnt(0)" ::: "memory");
        } else {
            XB_SPIN(xb_ld(&bar[XB_XGEN(b.x)]) == gen, bar);
            __builtin_amdgcn_fence(__ATOMIC_ACQUIRE, "agent");
            asm volatile("s_waitcnt vmcnt(0)" ::: "memory");
        }
    }
    __syncthreads();
}

#ifndef MK_N_LAUNCHES
#define MK_N_LAUNCHES 1
#endif
constexpr int N_PHASES = 8;
extern __shared__ __attribute__((aligned(16))) unsigned char dyn_lds[];
__global__ void __launch_bounds__(NTHR, 2) hybrid_fwd(Params P) {
    LAS unsigned char* lds = (LAS unsigned char*)dyn_lds;
    volatile LAS unsigned* MISC = (volatile LAS unsigned*)(lds + LDS_SCR);
    for (int u = threadIdx.x; u < (LDS_BYTES - LDS_SCR) / 4; u += NTHR) MISC[u] = 0u;
    __syncthreads();
    XcdBarrier bar = xcd_barrier_post((unsigned*)(P.ws + WS_CTL) + 4096 + P.ph_lo * XCD_BAR_WORDS, MISC + 8);
    const int lo = P.ph_lo, hi = P.ph_hi;
#ifndef PHASE_MASK
#define PHASE_MASK 0xFF
#endif
#define IN(k) (((PHASE_MASK >> (k)) & 1) && lo <= (k) && (k) < hi)
#define SEAM(k) do { if (IN(k) && IN((k) + 1)) xcd_barrier(bar); } while (0)
    if (IN(0)) phase_prologue(P, lds);
    SEAM(0);
    if (IN(1)) phase_h(P, lds);
    SEAM(1);
    if (IN(2)) {
        pg8::Gemm g{(const h16*)(P.ws + WS_H), (const h16*)(P.ws + WS_W1T), T, NW1, DM, DM, DM, 0}; pg8::StaticOrder S; S.init(T, NW1, gridDim.x, blockIdx.x);
        EpiProj E{(h16*)(P.ws + WS_CQ), (h16*)(P.ws + WS_KVC), (h16*)(P.ws + WS_SGA), (h16*)(P.ws + WS_QB), (h16*)(P.ws + WS_KB), (h16*)(P.ws + WS_VB), (h16*)(P.ws + WS_SGB),
                  (float*)(P.ws + WS_SMALL), (float*)(P.ws + WS_SSQ), (const float*)(P.ws + WS_ROPE32)};
        pg8::gemm_phase(lds, g, S, E);
    }
    SEAM(2);
    if (IN(3)) {
        phase_rowops(P);
        { pg8::Gemm g{(const h16*)(P.ws + WS_CQ), (const h16*)(P.ws + WS_WQT), T, NQ, 512, 512, 512, 0}; pg8::StaticOrder S; S.init(T, NQ, gridDim.x, blockIdx.x);
          EpiQ E{(h16*)(P.ws + WS_QLAT), (h16*)(P.ws + WS_QROPE), (h16*)(P.ws + WS_QIDX), (const float*)(P.ws + WS_SSQ), (const float*)(P.ws + WS_ROPE32), (const float*)(P.ws + WS_ROPE16)};
          pg8::gemm_phase(lds, g, S, E); }
        __syncthreads();
        phase_dilated_part(P, lds);
    }
    SEAM(3);
    if (IN(4)) { phase_dsa(P, lds); __syncthreads(); phase_dilated_last(P, lds); }
    SEAM(4);
    if (IN(5)) {
        pg8::Gemm g{(const h16*)(P.ws + WS_OLAT), (const h16*)(P.ws + WS_WUVT), T, 1024, 512, 2048, 512, 512}; pg8::StaticOrder S; S.init(T, 1024, gridDim.x, blockIdx.x);
        EpiOA E{(h16*)(P.ws + WS_OAB), (const h16*)(P.ws + WS_SGA)};
        pg8::gemm_phase(lds, g, S, E);
    }
    SEAM(5);
    if (IN(6)) {
        pg8::Gemm g{(const h16*)(P.ws + WS_OAB), (const h16*)(P.ws + WS_WOT), T, DM, DM, DM, DM, 0}; pg8::StaticOrder S; S.init(T, DM, gridDim.x, blockIdx.x);
        EpiY E{(h16*)(P.ws + WS_Y), (float*)(P.ws + WS_SSY)};
        pg8::gemm_phase(lds, g, S, E);
    }
    SEAM(6);
    if (IN(7)) phase_final(P, lds);
#undef IN
#undef SEAM
}

extern "C" void kernel_launch(void* const* d_in, const int* in_sizes, int n_in, void* d_out, int out_size, void* d_ws, size_t ws_size, hipStream_t stream) {
    static int grid = 0;
    if (grid == 0) {
        if (n_in != 14 || in_sizes[0] != T * DM || out_size != T * DM || ws_size < WS_END) { fprintf(stderr, "kernel_launch: unexpected shapes (n_in %d, in0 %d, out %d, ws %zu)\n", n_in, n_in > 0 ? in_sizes[0] : -1, out_size, ws_size); grid = -1; return; }
        int dev = 0, cus = 0, per_cu = 0;
        if (hipGetDevice(&dev) != hipSuccess || hipDeviceGetAttribute(&cus, hipDeviceAttributeMultiprocessorCount, dev) != hipSuccess) { grid = -1; return; }
        if (hipFuncSetAttribute((const void*)hybrid_fwd, hipFuncAttributeMaxDynamicSharedMemorySize, LDS_BYTES) != hipSuccess) { fprintf(stderr, "kernel_launch: hipFuncSetAttribute failed\n"); grid = -1; return; }
        if (hipOccupancyMaxActiveBlocksPerMultiprocessor(&per_cu, (const void*)hybrid_fwd, NTHR, LDS_BYTES) != hipSuccess || per_cu < 1) { fprintf(stderr, "kernel_launch: occupancy query says %d blocks per CU\n", per_cu); }
        (void)hipGetLastError();
        grid = cus;
    }
    if (grid < 0) return;
    (void)hipMemsetAsync((char*)d_ws + WS_CTL, 0, 1 * MiB, stream);
    Params P{};
    P.x = (const float*)d_in[0]; P.c = (const float*)d_in[1]; P.w_ada = (const float*)d_in[2]; P.b_ada = (const float*)d_in[3]; P.g_pre = (const float*)d_in[4]; P.g_post = (const float*)d_in[5];
    P.w_in = (const float*)d_in[6]; P.g_q = (const float*)d_in[7]; P.g_kv = (const float*)d_in[8]; P.w_uq = (const float*)d_in[9]; P.w_uq_idx = (const float*)d_in[10]; P.w_uk = (const float*)d_in[11];
    P.w_uv = (const float*)d_in[12]; P.w_out = (const float*)d_in[13]; P.out = (float*)d_out; P.ws = (unsigned char*)d_ws;
#if MK_N_LAUNCHES == 1
    P.ph_lo = 0; P.ph_hi = N_PHASES;
    hipLaunchKernelGGL(hybrid_fwd, dim3(grid), dim3(NTHR), LDS_BYTES, stream, P);
#else
    for (int k = 0; k < N_PHASES; ++k) { P.ph_lo = k; P.ph_hi = k + 1; hipLaunchKernelGGL(hybrid_fwd, dim3(grid), dim3(NTHR), LDS_BYTES, stream, P); }
#endif
}
```

```cpp
#include <hip/hip_runtime.h>
#include <cstdint>
#include <cstdio>
#include <cmath>

#define LAS __attribute__((address_space(3)))
typedef _Float16 h16;
typedef _Float16 h16x2 __attribute__((ext_vector_type(2)));
typedef _Float16 h16x4 __attribute__((ext_vector_type(4)));
typedef _Float16 h16x8 __attribute__((ext_vector_type(8)));
typedef float f32x2 __attribute__((ext_vector_type(2)));
typedef float f32x4 __attribute__((ext_vector_type(4)));
typedef unsigned u32x2 __attribute__((ext_vector_type(2)));
typedef unsigned u32x4 __attribute__((ext_vector_type(4)));

constexpr int NB = 4, SEQ = 4096, T = NB * SEQ, DM = 2048;
constexpr int NW1 = 6144;
constexpr int NQ = 3328;
constexpr int KVW = 288;
constexpr float EPS = 1e-6f;
constexpr float SCQ = 0.08838834764831845f * 1.4426950408889634f;

constexpr size_t MiB = 1u << 20;
constexpr size_t WS_CTL = 0;
constexpr size_t WS_MODP = 1 * MiB;
constexpr size_t WS_ROPE32 = 2 * MiB;
constexpr size_t WS_ROPE16 = 2 * MiB + 512 * 1024;
constexpr size_t WS_SSQ = 3 * MiB;
constexpr size_t WS_SSY = 4 * MiB;
constexpr size_t WS_W1T = 8 * MiB;
constexpr size_t WS_WQT = 32 * MiB;
constexpr size_t WS_WUVT = 36 * MiB;
constexpr size_t WS_WOT = 38 * MiB;
constexpr size_t WS_KVC = 46 * MiB;
constexpr size_t WS_KIDX = 55 * MiB;
constexpr size_t WS_WIDX = 57 * MiB;
constexpr size_t WS_SMALL = 58 * MiB;
constexpr size_t WS_CQ = 66 * MiB;
constexpr size_t WS_SGA = 82 * MiB;
constexpr size_t WS_OAB = 114 * MiB;
constexpr size_t WS_QLAT = 178 * MiB;
constexpr size_t WS_QROPE = 242 * MiB;
constexpr size_t WS_QIDX = 250 * MiB;
constexpr size_t WS_H = 282 * MiB;
constexpr size_t WS_OP4 = 282 * MiB;
constexpr size_t WS_OP16 = 314 * MiB;
constexpr size_t WS_QB = 346 * MiB;
constexpr size_t WS_KB = 378 * MiB;
constexpr size_t WS_VB = 410 * MiB;
constexpr size_t WS_SGB = 442 * MiB;
constexpr size_t WS_END = 474 * MiB;
constexpr size_t WS_LSEP = 6 * MiB;
#ifndef DSA_PROBE
#define DSA_PROBE 0
#endif
constexpr size_t WS_OLAT = DSA_PROBE ? 346 * MiB : 178 * MiB;
constexpr size_t WS_Y = 178 * MiB;

struct Params {
    const float *x, *c, *w_ada, *b_ada, *g_pre, *g_post, *w_in, *g_q, *g_kv, *w_uq, *w_uq_idx, *w_uk, *w_uv, *w_out;
    float* out; unsigned char* ws;
    int ph_lo, ph_hi;
};

__device__ __forceinline__ unsigned pk2h(float a, float b) { h16x2 t = {(h16)a, (h16)b}; return __builtin_bit_cast(unsigned, t); }
__device__ __forceinline__ float siluf(float v) { return v / (1.0f + __expf(-v)); }
__device__ __forceinline__ float wave_sum(float v) {
#pragma unroll
    for (int o = 1; o < 64; o <<= 1) v += __shfl_xor(v, o);
    return v;
}
__device__ __forceinline__ float wave_max(float v) {
#pragma unroll
    for (int o = 1; o < 64; o <<= 1) v = fmaxf(v, __shfl_xor(v, o));
    return v;
}

namespace pg8 {
constexpr int BM = 256, BK = 64, HALF = 128, HTB = HALF * BK * 2, STAGE_BYTES = 8 * HTB, NXCD = 8, WGM = 8;
__host__ __device__ __forceinline__ int lds_byte(int r, int c) { const int st = (r >> 4) * 2 + (c >> 5), rr = r & 15, cc = c & 31, ob = rr * 64 + cc * 2; return st * 1024 + (ob ^ (((ob >> 9) & 1) << 5)); }
__host__ __device__ __forceinline__ void stage_rc(int b, int& R, int& C) { const int st = b / 1024, sb = b % 1024, swz = sb ^ (((sb >> 9) & 1) << 5); R = (st >> 1) * 16 + swz / 64; C = (st & 1) * 32 + (swz % 64) / 2; }
__host__ __device__ __forceinline__ int perm32(int rho) { const int n = rho >> 4, i = rho & 15; return 8 * (i >> 2) + 4 * n + (i & 3); }

struct Unit { int pm, pn; };
struct Gemm { const h16* A; const h16* Bt; int M, N, K, lda, ldb, a_pn_off; };

struct StaticOrder {
    int nM, nN, nwg, G, c;
    __device__ void init(int M, int N, int G_, int c_) { nM = M / BM; nN = N / BM; nwg = nM * nN; G = __builtin_amdgcn_readfirstlane(G_); c = __builtin_amdgcn_readfirstlane(c_); }
    __device__ bool next(int i, Unit& u) const {
        const int L = __builtin_amdgcn_readfirstlane(i * G + c); if (L >= nwg) return false;
        int wgid = L; { const int q = nwg / NXCD, r = nwg % NXCD, xcd = wgid % NXCD, off = wgid / NXCD; wgid = (xcd < r ? xcd * (q + 1) : r * (q + 1) + (xcd - r) * q) + off; }
        const int nig = WGM * nN, gid = wgid / nig, fm = gid * WGM, gsz = (nM - fm) < WGM ? (nM - fm) : WGM;
        u.pm = __builtin_amdgcn_readfirstlane(fm + ((wgid % nig) % gsz)); u.pn = __builtin_amdgcn_readfirstlane((wgid % nig) / gsz); return true;
    }
};

template <class Epi>
__device__ __forceinline__ void gemm_phase(LAS unsigned char* lds, const Gemm g, const StaticOrder& S, const Epi& E) {
    const int tid = threadIdx.x, wid = __builtin_amdgcn_readfirstlane(tid >> 6), lane = tid & 63, wr = wid >> 2, wc = wid & 3, fr = lane & 15, fq = lane >> 4;
    const int K = g.K, nt = K / BK;
    unsigned voffA[2], voffB[2];
#pragma unroll
    for (int i = 0; i < 2; ++i) { int R, C; stage_rc(tid * 16 + i * 8192, R, C); const int Rb = (R & ~31) + perm32(R & 31);
        voffA[i] = (unsigned)(R * g.lda + C) * 2u; voffB[i] = (unsigned)(Rb * g.ldb + C) * 2u; }
    const size_t kstep = (size_t)(BK * 2);
    const size_t hstepA = (size_t)HALF * g.lda * 2, hstepB = (size_t)HALF * g.ldb * 2;
    const size_t tstepA = 2 * hstepA, tstepB = 2 * hstepB;
    const unsigned ldsw = (unsigned)wid * 1024u;
    const int aoff = lds_byte(wr * 64 + fr, fq * 8), boff = lds_byte(wc * 32 + fr, fq * 8);
#define PG8_SA(b, h) (((b) * 2 + (h)) * HTB)
#define PG8_SB(b, h) ((4 + (b) * 2 + (h)) * HTB)
#define PG8_STAGE(bufoff, gbase, voff) do { _Pragma("unroll") for (int _i = 0; _i < 2; ++_i) \
        __builtin_amdgcn_global_load_lds((const unsigned*)((const char*)(gbase) + (voff)[_i]), (LAS unsigned*)(lds + (bufoff) + ldsw + _i * 8192), 16, 0, 0); } while (0)
#define PG8_LDA(dst, b, h) do { _Pragma("unroll") for (int m = 0; m < 4; ++m) _Pragma("unroll") for (int k = 0; k < 2; ++k) dst[m][k] = *(const LAS h16x8*)(lds + PG8_SA(b, h) + aoff + m * 2048 + k * 1024); } while (0)
#define PG8_LDB(dst, b, h) do { _Pragma("unroll") for (int n = 0; n < 2; ++n) _Pragma("unroll") for (int k = 0; k < 2; ++k) dst[n][k] = *(const LAS h16x8*)(lds + PG8_SB(b, h) + boff + n * 2048 + k * 1024); } while (0)
#define PG8_MMA(ai, bj, At, Bt) do { __builtin_amdgcn_s_setprio(1); _Pragma("unroll") for (int m = 0; m < 4; ++m) _Pragma("unroll") for (int n = 0; n < 2; ++n) _Pragma("unroll") for (int k = 0; k < 2; ++k) \
        acc[ai][bj][m][n] = __builtin_amdgcn_mfma_f32_16x16x32_f16(Bt[n][k], At[m][k], acc[ai][bj][m][n], 0, 0, 0); __builtin_amdgcn_s_setprio(0); } while (0)
#define PG8_WAIT_V(n) asm volatile("s_waitcnt vmcnt(" #n ")" ::: "memory")
#define PG8_WAIT_L(n) asm volatile("s_waitcnt lgkmcnt(" #n ")" ::: "memory")
#define PG8_BAR __builtin_amdgcn_s_barrier()
#define PG8_SCHED __builtin_amdgcn_sched_barrier(0)
    Unit cur, nxt; int ui = 0;
    if (!S.next(0, cur)) return;
    f32x4 acc[2][2][4][2];
#pragma unroll
    for (int a = 0; a < 2; ++a)
#pragma unroll
        for (int b = 0; b < 2; ++b)
#pragma unroll
            for (int m = 0; m < 4; ++m)
#pragma unroll
                for (int n = 0; n < 2; ++n) acc[a][b][m][n] = (f32x4){0.f, 0.f, 0.f, 0.f};
    h16x8 At[4][2], B0[2][2], B1[2][2];
    const char* cA = (const char*)g.A + (size_t)cur.pm * tstepA + (size_t)cur.pn * g.a_pn_off * 2; const char* cB = (const char*)g.Bt + (size_t)cur.pn * tstepB;
    PG8_STAGE(PG8_SB(0, 0), cB, voffB); PG8_STAGE(PG8_SB(0, 1), cB + hstepB, voffB); PG8_STAGE(PG8_SA(0, 0), cA, voffA); PG8_STAGE(PG8_SA(0, 1), cA + hstepA, voffA);
    if (wr == 1) PG8_BAR;
    PG8_WAIT_V(2); PG8_BAR;
    PG8_STAGE(PG8_SB(1, 0), cB + kstep, voffB); PG8_STAGE(PG8_SA(1, 0), cA + kstep, voffA); PG8_STAGE(PG8_SB(1, 1), cB + hstepB + kstep, voffB);
    PG8_WAIT_V(6); PG8_BAR;
    for (;;) {
        const bool has_next = S.next(ui + 1, nxt);
        const char* nA = has_next ? (const char*)g.A + (size_t)nxt.pm * tstepA + (size_t)nxt.pn * g.a_pn_off * 2 : cA; const char* nB = has_next ? (const char*)g.Bt + (size_t)nxt.pn * tstepB : cB;
        for (int t = 0; t < nt; t += 2) {
            const bool last = (t == nt - 2);
            const char* a1 = cA + (size_t)(t + 1) * kstep;
            const char* a2 = last ? nA : cA + (size_t)(t + 2) * kstep; const char* b2 = last ? nB : cB + (size_t)(t + 2) * kstep;
            const char* a3 = a2 + kstep; const char* b3 = b2 + kstep;
            PG8_LDB(B0, 0, 0); PG8_LDB(B1, 0, 1); PG8_SCHED; PG8_LDA(At, 0, 0); PG8_STAGE(PG8_SA(1, 1), a1 + hstepA, voffA);
            PG8_WAIT_V(8); PG8_WAIT_L(0); PG8_BAR; PG8_MMA(0, 0, At, B0); PG8_MMA(0, 1, At, B1); PG8_BAR; PG8_SCHED;
            PG8_LDA(At, 0, 1); PG8_STAGE(PG8_SB(0, 0), b2, voffB); PG8_STAGE(PG8_SB(0, 1), b2 + hstepB, voffB); PG8_STAGE(PG8_SA(0, 0), a2, voffA);
            PG8_WAIT_V(8); PG8_WAIT_L(0); PG8_BAR; PG8_MMA(1, 0, At, B0); PG8_MMA(1, 1, At, B1); PG8_BAR; PG8_SCHED;
            PG8_LDB(B0, 1, 0); PG8_LDB(B1, 1, 1); PG8_SCHED; PG8_LDA(At, 1, 0); PG8_STAGE(PG8_SA(0, 1), a2 + hstepA, voffA);
            PG8_WAIT_V(8); PG8_WAIT_L(0); PG8_BAR; PG8_MMA(0, 0, At, B0); PG8_MMA(0, 1, At, B1); PG8_BAR; PG8_SCHED;
            PG8_LDA(At, 1, 1); PG8_STAGE(PG8_SB(1, 0), b3, voffB); PG8_STAGE(PG8_SB(1, 1), b3 + hstepB, voffB); PG8_STAGE(PG8_SA(1, 0), a3, voffA);
            PG8_WAIT_V(8); PG8_WAIT_L(0); PG8_BAR; PG8_MMA(1, 0, At, B0); PG8_MMA(1, 1, At, B1); PG8_BAR; PG8_SCHED;
        }
        if (wr == 0) PG8_BAR;
        E(acc, cur, wr, wc, fr, fq);
        if (!has_next) break;
#pragma unroll
        for (int a = 0; a < 2; ++a)
#pragma unroll
            for (int b = 0; b < 2; ++b)
#pragma unroll
                for (int m = 0; m < 4; ++m)
#pragma unroll
                    for (int n = 0; n < 2; ++n) acc[a][b][m][n] = (f32x4){0.f, 0.f, 0.f, 0.f};
        cur = nxt; cA = nA; cB = nB; ++ui;
        if (wr == 1) PG8_BAR;
    }
    PG8_WAIT_V(0);
    PG8_BAR;
#undef PG8_SA
#undef PG8_SB
#undef PG8_STAGE
#undef PG8_LDA
#undef PG8_LDB
#undef PG8_MMA
#undef PG8_WAIT_V
#undef PG8_WAIT_L
#undef PG8_BAR
#undef PG8_SCHED
}
}

using pg8::Unit;
__device__ __forceinline__ u32x4 pack8(const f32x4 a, const f32x4 b) { u32x4 w; w.x = pk2h(a[0], a[1]); w.y = pk2h(a[2], a[3]); w.z = pk2h(b[0], b[1]); w.w = pk2h(b[2], b[3]); return w; }

struct EpiProj {
    h16 *CQ, *KVC, *SGA, *QB, *KB, *VB, *SGB; float *SMALL, *SSQ; const float* rope32;
    __device__ __forceinline__ void operator()(const f32x4 (&acc)[2][2][4][2], const Unit& u, int wr, int wc, int fr_in, int fq_in) const {
        int fr = fr_in, fq = fq_in; asm volatile("" : "+v"(fr), "+v"(fq));
        const int pn = u.pn;
#pragma unroll
        for (int ai = 0; ai < 2; ++ai)
#pragma unroll
            for (int m = 0; m < 4; ++m) {
                const int row = u.pm * 256 + ai * 128 + wr * 64 + m * 16 + fr;
                if (pn < 2) {
                    float s = 0.f;
#pragma unroll
                    for (int bj = 0; bj < 2; ++bj) { const f32x4 v0 = acc[ai][bj][m][0], v1 = acc[ai][bj][m][1];
                        s += (v0[0] * v0[0] + v0[1] * v0[1]) + (v0[2] * v0[2] + v0[3] * v0[3]) + (v1[0] * v1[0] + v1[1] * v1[1]) + (v1[2] * v1[2] + v1[3] * v1[3]);
                        *(u32x4*)(CQ + (size_t)row * 512 + pn * 256 + bj * 128 + wc * 32 + fq * 8) = pack8(v0, v1); }
                    s += __shfl_xor(s, 16); s += __shfl_xor(s, 32);
                    if (fq == 0) SSQ[(size_t)(pn * 4 + wc) * T + row] = s;
                } else if (pn == 2) {
#pragma unroll
                    for (int bj = 0; bj < 2; ++bj) *(u32x4*)(KVC + (size_t)row * KVW + bj * 128 + wc * 32 + fq * 8) = pack8(acc[ai][bj][m][0], acc[ai][bj][m][1]);
                } else if (pn == 3) {
                    float* p = SMALL + (size_t)row * 128 + wc * 32 + fq * 8;
                    *(f32x4*)p = acc[ai][0][m][0]; *(f32x4*)(p + 4) = acc[ai][0][m][1];
                } else if (pn < 8 || pn >= 20) {
                    h16* dst = (pn < 8 ? SGA + (pn - 4) * 256 : SGB + (pn - 20) * 256) + (size_t)row * 1024 + wc * 32 + fq * 8;
#pragma unroll
                    for (int bj = 0; bj < 2; ++bj) { f32x4 v0 = acc[ai][bj][m][0], v1 = acc[ai][bj][m][1];
#pragma unroll
                        for (int e = 0; e < 4; ++e) { v0[e] = siluf(v0[e]); v1[e] = siluf(v1[e]); }
                        *(u32x4*)(dst + bj * 128) = pack8(v0, v1); }
                } else if (pn >= 16) {
                    h16* dst = VB + (size_t)row * 1024 + (pn - 16) * 256 + wc * 32 + fq * 8;
#pragma unroll
                    for (int bj = 0; bj < 2; ++bj) *(u32x4*)(dst + bj * 128) = pack8(acc[ai][bj][m][0], acc[ai][bj][m][1]);
                } else {
                    const bool isq = pn < 12; const float sc = isq ? SCQ : 1.0f;
                    h16* dst = (isq ? QB + (pn - 8) * 256 : KB + (pn - 12) * 256) + (size_t)row * 1024 + wc * 32 + fq * 8;
                    const int pos = row & (SEQ - 1);
#pragma unroll
                    for (int bj = 0; bj < 2; ++bj) { f32x4 v0 = acc[ai][bj][m][0], v1 = acc[ai][bj][m][1];
                        if (wc == 0) {
                            const float* cs = rope32 + ((size_t)pos * 16 + 8 * (fq & 1)) * 2;
                            const float sg = (fq < 2) ? -1.f : 1.f;
#pragma unroll
                            for (int e = 0; e < 4; ++e) { const float p0 = __shfl_xor(v0[e], 32), p1 = __shfl_xor(v1[e], 32);
                                const f32x2 c0 = *(const f32x2*)(cs + 2 * e), c1 = *(const f32x2*)(cs + 2 * (4 + e));
                                v0[e] = v0[e] * c0.x + sg * p0 * c0.y; v1[e] = v1[e] * c1.x + sg * p1 * c1.y; }
                        }
                        v0 = v0 * sc; v1 = v1 * sc;
                        *(u32x4*)(dst + bj * 128) = pack8(v0, v1); }
                }
            }
    }
};

struct EpiQ {
    h16 *QLAT, *QROPE, *QIDX; const float *SSQ, *rope32, *rope16;
    __device__ __forceinline__ void operator()(const f32x4 (&acc)[2][2][4][2], const Unit& u, int wr, int wc, int fr_in, int fq_in) const {
        int fr = fr_in, fq = fq_in; asm volatile("" : "+v"(fr), "+v"(fq));
        const int pn = u.pn;
#pragma unroll
        for (int ai = 0; ai < 2; ++ai)
#pragma unroll
            for (int m = 0; m < 4; ++m) {
                const int row = u.pm * 256 + ai * 128 + wr * 64 + m * 16 + fr;
                float ss = 0.f;
#pragma unroll
                for (int p = 0; p < 8; ++p) ss += SSQ[(size_t)p * T + row];
                const float rstd = 1.0f / sqrtf(ss * (1.0f / 512.0f) + EPS);
                const int pos = row & (SEQ - 1);
#pragma unroll
                for (int bj = 0; bj < 2; ++bj) { f32x4 v0 = acc[ai][bj][m][0] * rstd, v1 = acc[ai][bj][m][1] * rstd;
                    if (pn == 0) {
                        const float* cs = rope32 + ((size_t)pos * 16 + 8 * (fq & 1)) * 2;
                        const float sg = (fq < 2) ? -1.f : 1.f;
#pragma unroll
                        for (int e = 0; e < 4; ++e) { const float p0 = __shfl_xor(v0[e], 32), p1 = __shfl_xor(v1[e], 32);
                            const f32x2 c0 = *(const f32x2*)(cs + 2 * e), c1 = *(const f32x2*)(cs + 2 * (4 + e));
                            v0[e] = v0[e] * c0.x + sg * p0 * c0.y; v1[e] = v1[e] * c1.x + sg * p1 * c1.y; }
                        v0 = v0 * SCQ; v1 = v1 * SCQ;
                        *(u32x4*)(QROPE + ((size_t)row * 8 + (4 * bj + wc)) * 32 + fq * 8) = pack8(v0, v1);
                    } else if (pn < 9) {
                        v0 = v0 * SCQ; v1 = v1 * SCQ;
                        *(u32x4*)(QLAT + ((size_t)row * 8 + (pn - 1)) * 256 + bj * 128 + wc * 32 + fq * 8) = pack8(v0, v1);
                    } else {
                        if ((wc & 1) == 0) {
                            const float* cs = rope16 + (size_t)pos * 16;
                            const float sg = (fq == 0) ? -1.f : 1.f;
#pragma unroll
                            for (int e = 0; e < 4; ++e) { const float p0 = __shfl_xor(v0[e], 16), p1 = __shfl_xor(v1[e], 16);
                                const f32x2 c0 = *(const f32x2*)(cs + 2 * e), c1 = *(const f32x2*)(cs + 2 * (4 + e));
                                if (fq < 2) { v0[e] = v0[e] * c0.x + sg * p0 * c0.y; v1[e] = v1[e] * c1.x + sg * p1 * c1.y; } }
                        }
                        *(u32x4*)(QIDX + (size_t)row * 1024 + (pn - 9) * 256 + bj * 128 + wc * 32 + fq * 8) = pack8(v0, v1);
                    } }
                asm volatile("" ::: "memory");
            }
    }
};

struct EpiOA {
    h16* OAB; const h16* SGA;
    __device__ __forceinline__ void operator()(const f32x4 (&acc)[2][2][4][2], const Unit& u, int wr, int wc, int fr_in, int fq_in) const {
        int fr = fr_in, fq = fq_in; asm volatile("" : "+v"(fr), "+v"(fq));
#pragma unroll
        for (int ai = 0; ai < 2; ++ai)
#pragma unroll
            for (int m = 0; m < 4; ++m) {
                const int row = u.pm * 256 + ai * 128 + wr * 64 + m * 16 + fr;
#pragma unroll
                for (int bj = 0; bj < 2; ++bj) { const int col = u.pn * 256 + bj * 128 + wc * 32 + fq * 8;
                    const h16x8 g = *(const h16x8*)(SGA + (size_t)row * 1024 + col);
                    f32x4 v0 = acc[ai][bj][m][0], v1 = acc[ai][bj][m][1];
#pragma unroll
                    for (int e = 0; e < 4; ++e) { v0[e] *= (float)g[e]; v1[e] *= (float)g[4 + e]; }
                    *(u32x4*)(OAB + (size_t)row * 2048 + col) = pack8(v0, v1); }
            }
    }
};

struct EpiY {
    h16* Y; float* SSY;
    __device__ __forceinline__ void operator()(const f32x4 (&acc)[2][2][4][2], const Unit& u, int wr, int wc, int fr_in, int fq_in) const {
        int fr = fr_in, fq = fq_in; asm volatile("" : "+v"(fr), "+v"(fq));
#pragma unroll
        for (int ai = 0; ai < 2; ++ai)
#pragma unroll
            for (int m = 0; m < 4; ++m) {
                const int row = u.pm * 256 + ai * 128 + wr * 64 + m * 16 + fr;
                float s = 0.f;
#pragma unroll
                for (int bj = 0; bj < 2; ++bj) { const f32x4 v0 = acc[ai][bj][m][0], v1 = acc[ai][bj][m][1];
                    s += (v0[0] * v0[0] + v0[1] * v0[1]) + (v0[2] * v0[2] + v0[3] * v0[3]) + (v1[0] * v1[0] + v1[1] * v1[1]) + (v1[2] * v1[2] + v1[3] * v1[3]);
                    *(u32x4*)(Y + (size_t)row * 2048 + u.pn * 256 + bj * 128 + wc * 32 + fq * 8) = pack8(v0, v1); }
                s += __shfl_xor(s, 16); s += __shfl_xor(s, 32);
                if (fq == 0) SSY[(size_t)(u.pn * 4 + wc) * T + row] = s;
            }
    }
};

constexpr int NTHR = 512, NWAVE = 8;
constexpr int LDS_SCR = 159744;
constexpr int LDS_BYTES = LDS_SCR + 4096;

__device__ __forceinline__ void p0_mod_unit(const Params& P, int unit, LAS unsigned char* lds) {
    const int tid = threadIdx.x, lane = tid & 63, w = tid >> 6, kc = unit >> 5, cc = unit & 31;
    LAS float* sc = (LAS float*)lds;
    LAS float* red = (LAS float*)(lds + 4096);
    for (int i = tid; i < 1024; i += NTHR) { const int b = i >> 8, kk = i & 255; sc[i] = siluf(P.c[b * DM + kc * 256 + kk]); }
    __syncthreads();
    f32x4 acc[4];
#pragma unroll
    for (int b = 0; b < 4; ++b) acc[b] = (f32x4){0.f, 0.f, 0.f, 0.f};
    if (lane < 48) {
        const float* wp = P.w_ada + (size_t)(kc * 256 + w * 32) * 6144 + cc * 192 + 4 * lane;
#pragma unroll 8
        for (int i = 0; i < 32; ++i) { const f32x4 wv = *(const f32x4*)(wp + (size_t)i * 6144);
#pragma unroll
            for (int b = 0; b < 4; ++b) acc[b] += wv * sc[b * 256 + w * 32 + i]; }
#pragma unroll
        for (int b = 0; b < 4; ++b) *(LAS f32x4*)(red + (w * 4 + b) * 192 + 4 * lane) = acc[b];
    }
    __syncthreads();
    float* MODP = (float*)(P.ws + WS_MODP);
    for (int o = tid; o < 768; o += NTHR) { const int b = o / 192, j = o % 192; float s = 0.f;
#pragma unroll
        for (int ww = 0; ww < 8; ++ww) s += red[(ww * 4 + b) * 192 + j];
        MODP[(size_t)(kc * 4 + b) * 6144 + cc * 192 + j] = s; }
    __syncthreads();
}
template <class SrcCol>
__device__ __forceinline__ void transpose_item(const float* W, int ldw, const float* kscale, h16* WT, int ldt, int k0, int n0, SrcCol srccol, LAS float* scr, int lane) {
    const int n4 = 4 * (lane & 15), s = srccol(n0 + n4);
#pragma unroll 8
    for (int i = 0; i < 16; ++i) { const int k = 4 * i + (lane >> 4);
        f32x4 v = (s >= 0) ? *(const f32x4*)(W + (size_t)(k0 + k) * ldw + s) : (f32x4){0.f, 0.f, 0.f, 0.f};
        if (kscale) v = v * kscale[k0 + k];
        *(LAS f32x4*)(scr + k * 64 + (n4 ^ (((k >> 3) & 7) << 2))) = v; }
    asm volatile("s_waitcnt lgkmcnt(0)" ::: "memory");
    const int c = lane & 7;
#pragma unroll
    for (int j = 0; j < 8; ++j) { const int n = (lane >> 3) + 8 * j; const LAS float* sp = scr + (8 * c) * 64 + (n ^ (c << 2));
        u32x4 o; o.x = pk2h(sp[0 * 64], sp[1 * 64]); o.y = pk2h(sp[2 * 64], sp[3 * 64]); o.z = pk2h(sp[4 * 64], sp[5 * 64]); o.w = pk2h(sp[6 * 64], sp[7 * 64]);
        *(u32x4*)(WT + (size_t)(n0 + n) * ldt + k0 + 8 * c) = o; }
    asm volatile("s_waitcnt lgkmcnt(0)" ::: "memory");
}
struct SrcW1 { __device__ int operator()(int n) const { return n < 880 ? n : (n < 1024 ? -1 : n - 144); } };
struct SrcId { __device__ int operator()(int n) const { return n; } };
struct SrcQRope { __device__ int operator()(int n) const { return (n >> 5) * 128 + (n & 31); } };

__device__ __forceinline__ void p0_fold_unit(const Params& P, int unit, LAS unsigned char* lds) {
    const int tid = threadIdx.x, h = unit >> 5, kb = (unit >> 2) & 7, rq = unit & 3;
    LAS float* wuk = (LAS float*)lds;
    LAS float* wuq = (LAS float*)(lds + 24576);
    for (int i = tid; i < 96 * 64; i += NTHR) { const int nn = i >> 6, r = i & 63; wuk[i] = P.w_uk[((size_t)h * 96 + nn) * 256 + rq * 64 + r]; }
    for (int i = tid; i < 64 * 96; i += NTHR) { const int k = i / 96, nn = i % 96; wuq[i] = P.w_uq[(size_t)(kb * 64 + k) * 1024 + h * 128 + 32 + nn]; }
    __syncthreads();
    const int r = tid & 63, kg = __builtin_amdgcn_readfirstlane(tid >> 6);
    float acc[8];
#pragma unroll
    for (int i = 0; i < 8; ++i) acc[i] = 0.f;
#pragma unroll 4
    for (int nn = 0; nn < 96; ++nn) { const float bv = wuk[nn * 64 + r];
#pragma unroll
        for (int i = 0; i < 8; ++i) acc[i] += wuq[(kg * 8 + i) * 96 + nn] * bv; }
    h16* dst = (h16*)(P.ws + WS_WQT) + (size_t)(256 + h * 256 + rq * 64 + r) * 512 + kb * 64 + kg * 8;
    const float* gq = P.g_q + kb * 64 + kg * 8;
    u32x4 o; o.x = pk2h(acc[0] * gq[0], acc[1] * gq[1]); o.y = pk2h(acc[2] * gq[2], acc[3] * gq[3]); o.z = pk2h(acc[4] * gq[4], acc[5] * gq[5]); o.w = pk2h(acc[6] * gq[6], acc[7] * gq[7]);
    *(u32x4*)dst = o;
    __syncthreads();
}
__device__ __forceinline__ void phase_prologue(const Params& P, LAS unsigned char* lds) {
    const int tid = threadIdx.x, lane = tid & 63, w = tid >> 6, G = gridDim.x, bid = blockIdx.x;
    for (int u = bid; u < 256; u += G) p0_mod_unit(P, u, lds);
    for (int u = bid; u < 256; u += G) p0_fold_unit(P, u, lds);
    {
        float* r32 = (float*)(P.ws + WS_ROPE32); float* r16 = (float*)(P.ws + WS_ROPE16);
        for (int e = bid * NTHR + tid; e < SEQ * 24; e += G * NTHR) {
            const int pos = e / 24, i = e % 24;
            const float inv = (i < 16) ? (float)pow(500000.0, -(double)i / 16.0) : (float)pow(500000.0, -(double)(i - 16) / 8.0);
            const float ang = (float)pos * inv;
            const float cv = (float)cos((double)ang), sv = (float)sin((double)ang);
            if (i < 16) { r32[((size_t)pos * 16 + i) * 2] = cv; r32[((size_t)pos * 16 + i) * 2 + 1] = sv; }
            else { r16[((size_t)pos * 8 + (i - 16)) * 2] = cv; r16[((size_t)pos * 8 + (i - 16)) * 2 + 1] = sv; }
        }
    }
    {
        h16* WUVT = (h16*)(P.ws + WS_WUVT);
        for (int e = bid * NTHR + tid; e < 1024 * 32; e += G * NTHR) { const int n = e >> 5, c8 = e & 31, hh = n >> 7; const int k = ((hh & 1) ? 0 : 256) + c8 * 8;
            *(u32x4*)(WUVT + (size_t)n * 512 + k) = (u32x4){0u, 0u, 0u, 0u}; }
    }
    LAS float* scr = (LAS float*)(lds + w * 16384);
    const int gw = bid * NWAVE + w, NGW = G * NWAVE;
    constexpr int I_W1 = 32 * 96, I_QR = 8 * 4, I_QI = 8 * 16, I_UV = 8 * 4 * 2, I_WO = 32 * 32;
    for (int it = gw; it < I_W1 + I_QR + I_QI + I_UV + I_WO; it += NGW) {
        int r = it;
        if (r < I_W1) { transpose_item(P.w_in, 6000, nullptr, (h16*)(P.ws + WS_W1T), 2048, (r / 96) * 64, (r % 96) * 64, SrcW1(), scr, lane); continue; } r -= I_W1;
        if (r < I_QR) { transpose_item(P.w_uq, 1024, P.g_q, (h16*)(P.ws + WS_WQT), 512, (r / 4) * 64, (r % 4) * 64, SrcQRope(), scr, lane); continue; } r -= I_QR;
        if (r < I_QI) { transpose_item(P.w_uq_idx, 1024, P.g_q, (h16*)(P.ws + WS_WQT) + (size_t)2304 * 512, 512, (r / 16) * 64, (r % 16) * 64, SrcId(), scr, lane); continue; } r -= I_QI;
        if (r < I_UV) { const int hh = r >> 3, kb = (r >> 1) & 3, nb = r & 1;
            transpose_item(P.w_uv + (size_t)hh * 256 * 128, 128, nullptr, (h16*)(P.ws + WS_WUVT) + (size_t)(hh * 128) * 512 + 256 * (hh & 1), 512, kb * 64, nb * 64, SrcId(), scr, lane); continue; } r -= I_UV;
        transpose_item(P.w_out, 2048, nullptr, (h16*)(P.ws + WS_WOT), 2048, (r / 32) * 64, (r % 32) * 64, SrcId(), scr, lane);
    }
}

__device__ __forceinline__ void load_mod(const Params& P, int b, int off, LAS float* dst, bool plus1) {
    const float* MODP = (const float*)(P.ws + WS_MODP);
    for (int j = threadIdx.x; j < 2048; j += NTHR) { float s = P.b_ada[off + j];
#pragma unroll
        for (int kc = 0; kc < 8; ++kc) s += MODP[(size_t)(kc * 4 + b) * 6144 + off + j];
        dst[j] = plus1 ? 1.0f + s : s; }
}
__device__ __forceinline__ void phase_h(const Params& P, LAS unsigned char* lds) {
    const int tid = threadIdx.x, lane = tid & 63, w = tid >> 6;
    LAS float* shift = (LAS float*)lds; LAS float* scale1 = (LAS float*)(lds + 8192);
    h16* H = (h16*)(P.ws + WS_H);
    for (int ch = blockIdx.x; ch < 256; ch += gridDim.x) {
        const int b = ch >> 6;
        __syncthreads();
        load_mod(P, b, 0, shift, false); load_mod(P, b, 2048, scale1, true);
        __syncthreads();
        for (int i = 0; i < 8; ++i) {
            const int row = ch * 64 + w * 8 + i;
            const float* xr = P.x + (size_t)row * DM + 4 * lane;
            f32x4 v[8]; float ss = 0.f;
#pragma unroll
            for (int j = 0; j < 8; ++j) { v[j] = *(const f32x4*)(xr + 256 * j); ss += (v[j][0] * v[j][0] + v[j][1] * v[j][1]) + (v[j][2] * v[j][2] + v[j][3] * v[j][3]); }
            const float rstd = 1.0f / sqrtf(wave_sum(ss) * (1.0f / DM) + EPS);
#pragma unroll
            for (int j = 0; j < 8; ++j) { const int col = 4 * lane + 256 * j; const f32x4 g = *(const f32x4*)(P.g_pre + col);
                const f32x4 s1 = *(const LAS f32x4*)(scale1 + col), sh = *(const LAS f32x4*)(shift + col);
                const f32x4 o = v[j] * rstd * g * s1 + sh; u32x2 pk; pk.x = pk2h(o[0], o[1]); pk.y = pk2h(o[2], o[3]);
                *(u32x2*)(H + (size_t)row * DM + col) = pk; }
        }
    }
}
__device__ __forceinline__ void phase_rowops(const Params& P) {
    const int tid = threadIdx.x, lane = tid & 63, w = tid >> 6;
    h16* KVC = (h16*)(P.ws + WS_KVC); h16* KIDX = (h16*)(P.ws + WS_KIDX); float* WIDX = (float*)(P.ws + WS_WIDX);
    const float* SMALL = (const float*)(P.ws + WS_SMALL); const float* r32 = (const float*)(P.ws + WS_ROPE32); const float* r16 = (const float*)(P.ws + WS_ROPE16);
    for (int row = blockIdx.x * NWAVE + w; row < T; row += gridDim.x * NWAVE) {
        const int pos = row & (SEQ - 1);
        h16* kr = KVC + (size_t)row * KVW;
        const h16x4 raw = *(const h16x4*)(kr + 4 * lane);
        float v[4]; float ss = 0.f;
#pragma unroll
        for (int e = 0; e < 4; ++e) { v[e] = (float)raw[e]; ss += v[e] * v[e]; }
        const float rstd = 1.0f / sqrtf(wave_sum(ss) * (1.0f / 256.0f) + EPS);
        const f32x4 g = *(const f32x4*)(P.g_kv + 4 * lane);
        u32x2 pk; pk.x = pk2h(v[0] * rstd * g[0], v[1] * rstd * g[1]); pk.y = pk2h(v[2] * rstd * g[2], v[3] * rstd * g[3]);
        *(u32x2*)(kr + 4 * lane) = pk;
        const float* sm = SMALL + (size_t)row * 128;
        if (lane < 32) {
            const int i = lane & 15; const float x1 = sm[i], x2 = sm[i + 16]; const float cv = r32[((size_t)pos * 16 + i) * 2], sv = r32[((size_t)pos * 16 + i) * 2 + 1];
            kr[256 + lane] = (h16)(lane < 16 ? x1 * cv - x2 * sv : x2 * cv + x1 * sv);
        }
        {
            float o = sm[32 + lane];
            if (lane < 16) { const int i = lane & 7; const float x1 = sm[32 + i], x2 = sm[32 + i + 8]; const float cv = r16[((size_t)pos * 8 + i) * 2], sv = r16[((size_t)pos * 8 + i) * 2 + 1];
                o = lane < 8 ? x1 * cv - x2 * sv : x2 * cv + x1 * sv; }
            KIDX[(size_t)row * 64 + lane] = (h16)o;
        }
        if (lane < 16) WIDX[(size_t)row * 16 + lane] = sm[96 + lane] * (1.0f / 32.0f);
    }
}
__device__ __forceinline__ void phase_final(const Params& P, LAS unsigned char* lds) {
    const int tid = threadIdx.x, lane = tid & 63, w = tid >> 6;
    LAS float* gate = (LAS float*)lds;
    const h16* Y = (const h16*)(P.ws + WS_Y); const float* SSY = (const float*)(P.ws + WS_SSY);
    for (int ch = blockIdx.x; ch < 256; ch += gridDim.x) {
        const int b = ch >> 6;
        __syncthreads();
        load_mod(P, b, 4096, gate, false);
        __syncthreads();
        for (int i = 0; i < 8; ++i) {
            const int row = ch * 64 + w * 8 + i;
            float ss = (lane < 32) ? SSY[(size_t)lane * T + row] : 0.f;
            const float rstd = 1.0f / sqrtf(wave_sum(ss) * (1.0f / DM) + EPS);
#pragma unroll
            for (int j = 0; j < 8; ++j) { const int col = 4 * lane + 256 * j;
                const f32x4 xv = *(const f32x4*)(P.x + (size_t)row * DM + col); const h16x4 yv = *(const h16x4*)(Y + (size_t)row * DM + col);
                const f32x4 g = *(const f32x4*)(P.g_post + col), gt = *(const LAS f32x4*)(gate + col);
                f32x4 o;
#pragma unroll
                for (int e = 0; e < 4; ++e) o[e] = xv[e] + gt[e] * ((float)yv[e] * rstd * g[e]);
                *(f32x4*)(P.out + (size_t)row * DM + col) = o; }
        }
    }
}


__device__ __forceinline__ void phase_dilated_naive(const Params& P, LAS unsigned char* lds) {
    const int tid = threadIdx.x, lane = tid & 63, w = tid >> 6;
    LAS float* qs = (LAS float*)(lds + w * 2560); LAS float* ps = qs + 128;
    const h16* QB = (const h16*)(P.ws + WS_QB); const h16* KB = (const h16*)(P.ws + WS_KB); const h16* VB = (const h16*)(P.ws + WS_VB); const h16* SGB = (const h16*)(P.ws + WS_SGB);
    h16* OAB = (h16*)(P.ws + WS_OAB);
    for (int item = blockIdx.x * NWAVE + w; item < T * 8; item += gridDim.x * NWAVE) {
        const int row = item >> 3, h = item & 7, b = row >> 12, t = row & (SEQ - 1);
        { const h16x2 q2 = *(const h16x2*)(QB + (size_t)row * 1024 + h * 128 + 2 * lane); qs[2 * lane] = (float)q2[0]; qs[2 * lane + 1] = (float)q2[1]; }
        float sv[7]; float mx = -INFINITY;
#pragma unroll
        for (int i = 0; i < 7; ++i) {
            const int e = lane + 64 * i; sv[i] = -INFINITY;
            if (e < 387) { const int c = e / 129, j = e % 129, dil = c == 0 ? 1 : (c == 1 ? 4 : 16), kt = t - j * dil;
                if (kt >= 0) { const h16* kr = KB + (size_t)(b * SEQ + kt) * 1024 + h * 128; float s = 0.f;
                    for (int d = 0; d < 128; d += 8) { const h16x8 kv = *(const h16x8*)(kr + d);
#pragma unroll
                        for (int x = 0; x < 8; ++x) s += qs[d + x] * (float)kv[x]; }
                    sv[i] = s; } }
            mx = fmaxf(mx, sv[i]);
        }
        mx = wave_max(mx);
        float sum = 0.f;
#pragma unroll
        for (int i = 0; i < 7; ++i) { const int e = lane + 64 * i; const float p = (sv[i] == -INFINITY) ? 0.f : exp2f(sv[i] - mx); sum += p; if (e < 392) ps[e] = p; }
        sum = wave_sum(sum);
        float a0 = 0.f, a1 = 0.f;
        for (int e = 0; e < 387; ++e) { const int c = e / 129, j = e % 129, dil = c == 0 ? 1 : (c == 1 ? 4 : 16), kt = t - j * dil;
            if (kt >= 0) { const float p = ps[e]; const h16x2 v2 = *(const h16x2*)(VB + (size_t)(b * SEQ + kt) * 1024 + h * 128 + 2 * lane); a0 += p * (float)v2[0]; a1 += p * (float)v2[1]; } }
        const float inv = 1.0f / sum;
        const h16x2 g2 = *(const h16x2*)(SGB + (size_t)row * 1024 + h * 128 + 2 * lane);
        const h16x2 o2 = {(h16)(a0 * inv * (float)g2[0]), (h16)(a1 * inv * (float)g2[1])};
        *(h16x2*)(OAB + (size_t)row * 2048 + 1024 + h * 128 + 2 * lane) = o2;
    }
}

constexpr int SP_PITCH = 592;
constexpr int SP_BUF = 32 * SP_PITCH;
constexpr int SP_LIST = 8 * SP_BUF;
__device__ __forceinline__ void sparse_attn_query(const Params& P, LAS unsigned char* lds, int wid, int lane, int b, int row, int kvalid, const LAS unsigned short* list);
__device__ __forceinline__ void phase_dsa_naive(const Params& P, LAS unsigned char* lds) {
    const int tid = threadIdx.x, lane = tid & 63, w = tid >> 6;
    LAS float* sc = (LAS float*)lds;
    LAS float* qv = (LAS float*)(lds + 131072);
    LAS float* wv = qv + 1024;
    const h16* QIDX = (const h16*)(P.ws + WS_QIDX); const h16* KIDX = (const h16*)(P.ws + WS_KIDX); const float* WIDX = (const float*)(P.ws + WS_WIDX);
    const h16* QLAT = (const h16*)(P.ws + WS_QLAT); const h16* QROPE = (const h16*)(P.ws + WS_QROPE); const h16* KVC = (const h16*)(P.ws + WS_KVC); h16* OLAT = (h16*)(P.ws + WS_OLAT);
    for (int item = blockIdx.x; item < T / 8; item += gridDim.x) {
        const int row0 = item * 8, b = row0 >> 12;
        for (int qi = 0; qi < 8; ++qi) {
            const int row = row0 + qi, t = row & (SEQ - 1);
            __syncthreads();
            for (int i = tid; i < 1024; i += NTHR) qv[i] = (float)QIDX[(size_t)row * 1024 + i];
            if (tid < 16) wv[tid] = WIDX[(size_t)row * 16 + tid];
            __syncthreads();
            for (int k = tid; k <= t; k += NTHR) {
                float kf[64];
                const h16* kr = KIDX + (size_t)(b * SEQ + k) * 64;
#pragma unroll
                for (int d = 0; d < 64; d += 8) { const h16x8 kv = *(const h16x8*)(kr + d);
#pragma unroll
                    for (int x = 0; x < 8; ++x) kf[d + x] = (float)kv[x]; }
                float acc = 0.f;
                for (int h = 0; h < 16; ++h) { float dt = 0.f;
#pragma unroll
                    for (int d = 0; d < 64; ++d) dt += qv[h * 64 + d] * kf[d];
                    acc += wv[h] * fmaxf(dt, 0.f); }
                sc[qi * SEQ + k] = acc + 0.0f;
            }
        }
        __syncthreads();
        {
            const int row = row0 + w, t = row & (SEQ - 1), n = t + 1;
            LAS float* myrow = sc + w * SEQ;
            LAS unsigned short* idxs = (LAS unsigned short*)(lds + SP_LIST) + w * 256;
            if (n <= 256) {
#pragma unroll
                for (int i = 0; i < 4; ++i) { const int k = lane + 64 * i; idxs[k] = (k < n) ? (unsigned short)k : (unsigned short)0xFFFFu; }
            } else {
                const LAS unsigned* ur = (const LAS unsigned*)myrow;
                const int ni = (n + 63) >> 6;
                auto key = [&](int i) -> unsigned { const int k = 64 * i + lane; const unsigned bits = ur[k]; const unsigned u = (bits & 0x80000000u) ? ~bits : (bits | 0x80000000u); return (k < n) ? u : 0u; };
                unsigned thr = 0u;
                for (int bit = 31; bit >= 0; --bit) {
                    const unsigned cand = thr | (1u << bit); int cnt = 0;
                    for (int i = 0; i < ni; ++i) cnt += __popcll(__ballot(key(i) >= cand));
                    if (cnt >= 256) thr = cand;
                }
                int cgt = 0;
                for (int i = 0; i < ni; ++i) cgt += __popcll(__ballot(key(i) > thr));
                const int need_eq = 256 - cgt;
                int base = 0, eqb = 0;
                for (int i = 0; i < ni; ++i) { const unsigned u = key(i); const bool eq = u == thr; const unsigned long long me = __ballot(eq);
                    const int eqr = eqb + __popcll(me & ((1ull << lane) - 1ull));
                    const bool sel = u > thr || (eq && eqr < need_eq); const unsigned long long mk = __ballot(sel);
                    const int pos = base + __popcll(mk & ((1ull << lane) - 1ull));
                    if (sel && pos < 256) idxs[pos] = (unsigned short)(64 * i + lane);
                    base += __popcll(mk); eqb += __popcll(me); }
            }
        }
        __syncthreads();
        { const int row = row0 + w, t = row & (SEQ - 1); sparse_attn_query(P, lds, w, lane, b, row, (t + 1 < 256) ? t + 1 : 256, (const LAS unsigned short*)(lds + SP_LIST) + w * 256); }
        __syncthreads();
    }
}

typedef float f32x16 __attribute__((ext_vector_type(16)));
typedef short s16x4 __attribute__((ext_vector_type(4)));
__device__ __forceinline__ unsigned imgb_off(unsigned row, unsigned ch) { return 256u * row + 16u * (ch ^ (((row & 3u) << 2) | ((row >> 2) & 3u))); }
constexpr int DIL_STG = 98304, DIL_LSE = DIL_STG + 8 * 4608;
__device__ __forceinline__ void dil_stage(LAS unsigned char* lds, const h16* src_bh, int m0, int dil, int res, int tid, int wid) {
#pragma unroll
    for (int p = 0; p < 12; ++p) {
        const int kk = p * 32 + (tid >> 4); int j = m0 - 128 + kk; j = j < 0 ? 0 : j;
        const unsigned sw = (unsigned)(((kk & 3) << 2) | ((kk >> 2) & 3));
        const h16* g = src_bh + (size_t)(j * dil + res) * 1024 + 8 * ((unsigned)(tid & 15) ^ sw);
        __builtin_amdgcn_global_load_lds((const unsigned*)g, (LAS unsigned*)(lds + p * 8192 + wid * 1024), 16, 0, 0);
    }
}
template <bool LAST>
__device__ __forceinline__ void dilated_unit(const Params& P, LAS unsigned char* lds, int dil, int pslot, int b, int h, int res, int blk) {
    const int tid = threadIdx.x, lane = tid & 63, wid = __builtin_amdgcn_readfirstlane(tid >> 6), n = lane & 31, hi = lane >> 5;
    const int m0 = blk * 256;
    const size_t bh = (size_t)b * SEQ * 1024 + h * 128;
    const h16* QBp = (const h16*)(P.ws + WS_QB) + bh; const h16* KBp = (const h16*)(P.ws + WS_KB) + bh; const h16* VBp = (const h16*)(P.ws + WS_VB) + bh;
    dil_stage(lds, KBp, m0, dil, res, tid, wid);
    h16x8 qf[8];
    { const h16* qp = QBp + (size_t)((m0 + 32 * wid + n) * dil + res) * 1024 + 8 * hi;
#pragma unroll
      for (int ks = 0; ks < 8; ++ks) qf[ks] = *(const h16x8*)(qp + 16 * ks); }
    asm volatile("s_waitcnt vmcnt(0)" ::: "memory");
    __syncthreads();
    f32x16 sa[5];
#pragma unroll
    for (int ti = 0; ti < 5; ++ti) {
#pragma unroll
        for (int r = 0; r < 16; ++r) sa[ti][r] = 0.f;
#pragma unroll
        for (int ks = 0; ks < 8; ++ks) { const h16x8 kf = *(const LAS h16x8*)(lds + imgb_off(32 * (wid + ti) + n, 2 * ks + hi));
            sa[ti] = __builtin_amdgcn_mfma_f32_32x32x16_f16(kf, qf[ks], sa[ti], 0, 0, 0); }
    }
    const int jmin = 128 - m0;
    float mx = -INFINITY;
#pragma unroll
    for (int ti = 0; ti < 5; ++ti)
#pragma unroll
        for (int r = 0; r < 16; ++r) { const int kin = (r & 3) + 8 * (r >> 2) + 4 * hi; bool ok = (32 * (wid + ti) + kin) >= jmin;
            if (ti == 0) ok = ok && (kin >= n); if (ti == 4) ok = ok && (kin <= n);
            const float s = ok ? sa[ti][r] : -INFINITY; sa[ti][r] = s; mx = fmaxf(mx, s); }
    mx = fmaxf(mx, __shfl_xor(mx, 32));
    float l = 0.f;
#pragma unroll
    for (int ti = 0; ti < 5; ++ti)
#pragma unroll
        for (int r = 0; r < 16; ++r) { const float p = __builtin_amdgcn_exp2f(sa[ti][r] - mx); sa[ti][r] = p; l += p; }
    l += __shfl_xor(l, 32);
    h16x8 pf[5][2];
#pragma unroll
    for (int ti = 0; ti < 5; ++ti)
#pragma unroll
        for (int s = 0; s < 2; ++s)
#pragma unroll
            for (int jj = 0; jj < 8; ++jj) pf[ti][s][jj] = (h16)sa[ti][8 * s + jj];
    __syncthreads();
    dil_stage(lds, VBp, m0, dil, res, tid, wid);
    asm volatile("s_waitcnt vmcnt(0)" ::: "memory");
    __syncthreads();
    f32x16 oa[4];
#pragma unroll
    for (int c = 0; c < 4; ++c)
#pragma unroll
        for (int r = 0; r < 16; ++r) oa[c][r] = 0.f;
    const int dgrp = (lane >> 4) & 1, q4 = (lane & 15) >> 2, p4 = lane & 3;
#pragma unroll
    for (int ti = 0; ti < 5; ++ti)
#pragma unroll
        for (int s = 0; s < 2; ++s) {
#pragma unroll
            for (int c = 0; c < 4; ++c) {
                const unsigned row0 = 32 * (wid + ti) + 16 * s + 4 * hi + q4, ch = 4 * c + 2 * dgrp + (p4 >> 1);
                const s16x4 t0 = __builtin_amdgcn_ds_read_tr16_b64_v4i16((LAS s16x4*)(lds + imgb_off(row0, ch) + 8 * (p4 & 1)));
                const s16x4 t1 = __builtin_amdgcn_ds_read_tr16_b64_v4i16((LAS s16x4*)(lds + imgb_off(row0 + 8, ch) + 8 * (p4 & 1)));
                typedef short s16x8 __attribute__((ext_vector_type(8)));
                const s16x8 v8 = {t0[0], t0[1], t0[2], t0[3], t1[0], t1[1], t1[2], t1[3]};
                oa[c] = __builtin_amdgcn_mfma_f32_32x32x16_f16(__builtin_bit_cast(h16x8, v8), pf[ti][s], oa[c], 0, 0, 0);
            }
        }
    const float invl = 1.0f / l, lse = mx + __builtin_amdgcn_logf(l);
    LAS unsigned char* stg = lds + DIL_STG + wid * 4608;
    LAS float* lsew = (LAS float*)(lds + DIL_LSE) + wid * 32;
    float* LSEP = (float*)(P.ws + WS_LSEP);
    const int pos_n = (m0 + 32 * wid + n) * dil + res;
    if (LAST) { if (hi == 0) lsew[n] = lse; }
    else if (hi == 0) LSEP[((size_t)pslot * T + (size_t)b * SEQ + pos_n) * 8 + h] = lse;
#pragma unroll
    for (int half = 0; half < 2; ++half) {
#pragma unroll
        for (int cc = 0; cc < 2; ++cc)
#pragma unroll
            for (int rg = 0; rg < 4; ++rg) { const f32x16& o = oa[2 * half + cc]; u32x2 w2; w2.x = pk2h(o[4 * rg] * invl, o[4 * rg + 1] * invl); w2.y = pk2h(o[4 * rg + 2] * invl, o[4 * rg + 3] * invl);
                *(LAS u32x2*)(stg + n * 144 + 2 * (32 * cc + 8 * rg + 4 * hi)) = w2; }
        asm volatile("s_waitcnt lgkmcnt(0)" ::: "memory");
#pragma unroll
        for (int i = 0; i < 4; ++i) {
            const int rowl = (lane >> 3) + 8 * i, ch = lane & 7;
            const u32x4 v = *(const LAS u32x4*)(stg + rowl * 144 + 16 * ch);
            const size_t grow = (size_t)b * SEQ + (size_t)((m0 + 32 * wid + rowl) * dil + res);
            const size_t coff = (size_t)h * 128 + 64 * half + 8 * ch;
            if (!LAST) { *(u32x4*)((h16*)(P.ws + (pslot ? WS_OP16 : WS_OP4)) + grow * 1024 + coff) = v; }
            else {
                const float l1 = lsew[rowl], l4 = LSEP[grow * 8 + h], l16 = LSEP[((size_t)T + grow) * 8 + h];
                const float mm = fmaxf(l1, fmaxf(l4, l16));
                const float w1 = __builtin_amdgcn_exp2f(l1 - mm), w4 = __builtin_amdgcn_exp2f(l4 - mm), w16 = __builtin_amdgcn_exp2f(l16 - mm), iw = 1.0f / (w1 + w4 + w16);
                const h16x8 o1 = __builtin_bit_cast(h16x8, v);
                const h16x8 o4 = *(const h16x8*)((const h16*)(P.ws + WS_OP4) + grow * 1024 + coff), o16 = *(const h16x8*)((const h16*)(P.ws + WS_OP16) + grow * 1024 + coff);
                const h16x8 gt = *(const h16x8*)((const h16*)(P.ws + WS_SGB) + grow * 1024 + coff);
                float r8[8];
#pragma unroll
                for (int e = 0; e < 8; ++e) r8[e] = (w1 * (float)o1[e] + w4 * (float)o4[e] + w16 * (float)o16[e]) * iw * (float)gt[e];
                u32x4 ov; ov.x = pk2h(r8[0], r8[1]); ov.y = pk2h(r8[2], r8[3]); ov.z = pk2h(r8[4], r8[5]); ov.w = pk2h(r8[6], r8[7]);
                *(u32x4*)((h16*)(P.ws + WS_OAB) + grow * 2048 + 1024 + coff) = ov;
            }
        }
        asm volatile("s_waitcnt lgkmcnt(0)" ::: "memory");
    }
    __syncthreads();
}
__device__ __forceinline__ void phase_dilated_part(const Params& P, LAS unsigned char* lds) {
    for (int idx = blockIdx.x; idx < 1024; idx += gridDim.x) {
        const int cfg = idx >> 9, w_ = idx & 511, xcd = w_ & 7, lu = w_ >> 3, bhh = xcd * 4 + (lu >> 4), rb = lu & 15;
        if (cfg == 0) dilated_unit<false>(P, lds, 4, 0, bhh >> 3, bhh & 7, rb & 3, rb >> 2);
        else dilated_unit<false>(P, lds, 16, 1, bhh >> 3, bhh & 7, rb, 0);
    }
}
__device__ __forceinline__ void phase_dilated_last(const Params& P, LAS unsigned char* lds) {
    for (int idx = blockIdx.x; idx < 512; idx += gridDim.x) {
        const int xcd = idx & 7, lu = idx >> 3, bhh = xcd * 4 + (lu >> 4), blk = lu & 15;
        dilated_unit<true>(P, lds, 1, 0, bhh >> 3, bhh & 7, 0, blk);
    }
}

__device__ __forceinline__ void sparse_attn_query(const Params& P, LAS unsigned char* lds, int wid, int lane_in, int b, int row, int kvalid, const LAS unsigned short* list) {
    int lane = lane_in; asm volatile("" : "+v"(lane));
    LAS unsigned char* buf = lds + wid * SP_BUF;
    const int n = lane & 15, g = lane >> 4, q4 = n >> 2, p4 = n & 3, sub = lane >> 2, c4 = lane & 3;
    h16x8 qf[9];
    {
        const h16* ql = (const h16*)(P.ws + WS_QLAT) + ((size_t)row * 8 + (n & 7)) * 256 + 8 * g;
        const h16* qr = (const h16*)(P.ws + WS_QROPE) + ((size_t)row * 8 + (n & 7)) * 32 + 8 * g;
        const h16x8 z = {(h16)0.f, (h16)0.f, (h16)0.f, (h16)0.f, (h16)0.f, (h16)0.f, (h16)0.f, (h16)0.f};
#pragma unroll
        for (int ks = 0; ks < 8; ++ks) { const h16x8 v = *(const h16x8*)(ql + 32 * ks); qf[ks] = (n < 8) ? v : z; }
        { const h16x8 v = *(const h16x8*)qr; qf[8] = (n < 8) ? v : z; }
    }
    f32x4 oacc[16];
#pragma unroll
    for (int dt = 0; dt < 16; ++dt) oacc[dt] = (f32x4){0.f, 0.f, 0.f, 0.f};
    float m = -INFINITY, l = 0.f;
    const unsigned char* kvb = P.ws + WS_KVC + (size_t)b * SEQ * (KVW * 2) + 16 * c4;
    u32x4 stg[18];
#define SP_ISSUE(step_) do { unsigned i0 = list[32 * (step_) + sub], i1 = list[32 * (step_) + 16 + sub]; i0 = (i0 == 0xFFFFu) ? 0u : i0; i1 = (i1 == 0xFFFFu) ? 0u : i1; \
        const unsigned char* r0 = kvb + (size_t)i0 * 576; const unsigned char* r1 = kvb + (size_t)i1 * 576; \
        _Pragma("unroll") for (int cg = 0; cg < 9; ++cg) { stg[2 * cg] = *(const u32x4*)(r0 + 64 * cg); stg[2 * cg + 1] = *(const u32x4*)(r1 + 64 * cg); } } while (0)
    SP_ISSUE(0);
    for (int step = 0; step < 8; ++step) {
#pragma unroll
        for (int cg = 0; cg < 9; ++cg) { *(LAS u32x4*)(buf + SP_PITCH * sub + 64 * cg + 16 * c4) = stg[2 * cg]; *(LAS u32x4*)(buf + SP_PITCH * (16 + sub) + 64 * cg + 16 * c4) = stg[2 * cg + 1]; }
        if (step < 7) SP_ISSUE(step + 1);
        asm volatile("s_waitcnt lgkmcnt(0)" ::: "memory");
        f32x4 s0 = (f32x4){0.f, 0.f, 0.f, 0.f}, s1 = (f32x4){0.f, 0.f, 0.f, 0.f};
#pragma unroll
        for (int ks = 0; ks < 9; ++ks) {
            const h16x8 a0 = *(const LAS h16x8*)(buf + SP_PITCH * n + 64 * ks + 16 * g), a1 = *(const LAS h16x8*)(buf + SP_PITCH * (16 + n) + 64 * ks + 16 * g);
            s0 = __builtin_amdgcn_mfma_f32_16x16x32_f16(a0, qf[ks], s0, 0, 0, 0); s1 = __builtin_amdgcn_mfma_f32_16x16x32_f16(a1, qf[ks], s1, 0, 0, 0);
        }
        float mx = -INFINITY;
#pragma unroll
        for (int r = 0; r < 4; ++r) { const int lp = 32 * step + 4 * g + r;
            s0[r] = (lp < kvalid) ? s0[r] : -INFINITY; s1[r] = (lp + 16 < kvalid) ? s1[r] : -INFINITY; mx = fmaxf(mx, fmaxf(s0[r], s1[r])); }
        mx = fmaxf(mx, __shfl_xor(mx, 16)); mx = fmaxf(mx, __shfl_xor(mx, 32));
        if (__builtin_amdgcn_ballot_w64(mx > m + 8.0f) != 0ull) {
            const float mnew = fmaxf(m, mx), alpha = __builtin_amdgcn_exp2f(m - mnew);
            m = mnew; l *= alpha;
#pragma unroll
            for (int dt = 0; dt < 16; ++dt) oacc[dt] = oacc[dt] * alpha;
        }
        h16x8 pf;
#pragma unroll
        for (int r = 0; r < 4; ++r) { const float p0 = __builtin_amdgcn_exp2f(s0[r] - m), p1 = __builtin_amdgcn_exp2f(s1[r] - m); l += p0 + p1; pf[r] = (h16)p0; pf[4 + r] = (h16)p1; }
#pragma unroll
        for (int dt = 0; dt < 16; ++dt) {
            const s16x4 t0 = __builtin_amdgcn_ds_read_tr16_b64_v4i16((LAS s16x4*)(buf + SP_PITCH * (4 * g + q4) + 32 * dt + 8 * p4));
            const s16x4 t1 = __builtin_amdgcn_ds_read_tr16_b64_v4i16((LAS s16x4*)(buf + SP_PITCH * (16 + 4 * g + q4) + 32 * dt + 8 * p4));
            typedef short s16x8 __attribute__((ext_vector_type(8)));
            const s16x8 v8 = {t0[0], t0[1], t0[2], t0[3], t1[0], t1[1], t1[2], t1[3]};
            oacc[dt] = __builtin_amdgcn_mfma_f32_16x16x32_f16(__builtin_bit_cast(h16x8, v8), pf, oacc[dt], 0, 0, 0);
        }
        asm volatile("s_waitcnt lgkmcnt(0)" ::: "memory");
    }
#undef SP_ISSUE
    l += __shfl_xor(l, 16); l += __shfl_xor(l, 32);
    const float inv = 1.0f / l;
    if (n < 8) {
        h16* op = (h16*)(P.ws + WS_OLAT) + ((size_t)row * 8 + n) * 256 + 4 * g;
#pragma unroll
        for (int dt = 0; dt < 16; ++dt) { u32x2 w2; w2.x = pk2h(oacc[dt][0] * inv, oacc[dt][1] * inv); w2.y = pk2h(oacc[dt][2] * inv, oacc[dt][3] * inv); *(u32x2*)(op + 16 * dt) = w2; }
    }
}

constexpr int DS_QI = 0;
constexpr int DS_WQ = 32768;
constexpr int DS_CNTB = DS_WQ + 1024;
constexpr int DS_CGT = DS_CNTB + 1024;
constexpr int DS_CEQ = DS_CGT + 512;
constexpr int DS_PCNT = DS_CEQ + 512;
constexpr int DS_TCNT = DS_PCNT + 2048;
constexpr int DS_TLIST = DS_TCNT + 64;
constexpr int DS_TSC = DS_TLIST + 2048;
constexpr int DS_LIST = SP_LIST;
constexpr int TIE_CAP = 64;
__device__ __forceinline__ unsigned sortable_hi16(float s) { const unsigned bits = __float_as_uint(s + 0.0f); return ((bits & 0x80000000u) ? ~bits : (bits | 0x80000000u)) >> 16; }
typedef _Float16 h16x2v __attribute__((ext_vector_type(2)));
__device__ __forceinline__ unsigned pk_count_gt(unsigned acc, unsigned v, unsigned cm1pk) {
    unsigned d;
    asm("v_pk_sub_u16 %1, %2, %3 clamp\n\tv_pk_min_u16 %1, %1, %4\n\tv_pk_add_u16 %0, %0, %1" : "+v"(acc), "=&v"(d) : "v"(v), "v"(cm1pk), "v"(0x00010001u));
    return acc;
}

__device__ __forceinline__ void dsa_select_unit(const Params& P, LAS unsigned char* lds, int b, int uq, int stages = 9) {
    int tid = threadIdx.x; asm volatile("" : "+v"(tid));
    const int lane = tid & 63, w = __builtin_amdgcn_readfirstlane(tid >> 6), q = lane & 15, kq = lane >> 4;
    const int t0 = 16 * uq, row0 = b * SEQ + t0, tq = t0 + q, ntile = uq + 1, Kq = (tq + 1 < 256) ? tq + 1 : 256;
    const h16* QIDX = (const h16*)(P.ws + WS_QIDX); const h16* KIDX = (const h16*)(P.ws + WS_KIDX) + (size_t)b * SEQ * 64; const float* WIDX = (const float*)(P.ws + WS_WIDX);
    LAS float* WQ = (LAS float*)(lds + DS_WQ); LAS unsigned* CNTB = (LAS unsigned*)(lds + DS_CNTB); LAS unsigned* CGT = (LAS unsigned*)(lds + DS_CGT); LAS unsigned* CEQ = (LAS unsigned*)(lds + DS_CEQ);
    LAS unsigned* PCNT = (LAS unsigned*)(lds + DS_PCNT); LAS unsigned* TCNT = (LAS unsigned*)(lds + DS_TCNT); LAS unsigned short* TLIST = (LAS unsigned short*)(lds + DS_TLIST);
    LAS float* TSC = (LAS float*)(lds + DS_TSC); LAS unsigned short* LIST = (LAS unsigned short*)(lds + DS_LIST);
#pragma unroll
    for (int i = 0; i < 4; ++i) { const int pc = 4 * w + i, head = pc >> 1, r = 8 * (pc & 1) + (lane >> 3), c = lane & 7;
        __builtin_amdgcn_global_load_lds((const unsigned*)(QIDX + (size_t)(row0 + r) * 1024 + head * 64 + 8 * (c ^ ((r >> 1) & 7))), (LAS unsigned*)(lds + DS_QI + pc * 1024), 16, 0, 0); }
    if (tid < 256) WQ[tid] = WIDX[(size_t)(row0 + (tid >> 4)) * 16 + (tid & 15)];
    if (tid < 16) TCNT[tid] = 0u;
    *(LAS u32x4*)(lds + DS_LIST + tid * 16) = (u32x4){0xFFFFFFFFu, 0xFFFFFFFFu, 0xFFFFFFFFu, 0xFFFFFFFFu};
    asm volatile("s_waitcnt vmcnt(0)" ::: "memory");
    __syncthreads();
    unsigned cs[64];
#pragma unroll
    for (int i = 0; i < 64; ++i) cs[i] = 0u;
    const unsigned sw = (unsigned)((q >> 1) & 7);
    const f32x4 zero4 = {0.f, 0.f, 0.f, 0.f};
    for (int grp = 0; grp < 8; ++grp) {
        const int tt0 = w + 32 * grp;
        if (tt0 >= ntile) break;
        h16x8 kf[4][2];
#pragma unroll
        for (int j = 0; j < 4; ++j) { const int tt = tt0 + 8 * j, ttc = tt < ntile ? tt : ntile - 1; const h16* kp = KIDX + (size_t)(16 * ttc + q) * 64 + 8 * kq;
            kf[j][0] = *(const h16x8*)kp; kf[j][1] = *(const h16x8*)(kp + 32); }
        f32x4 acc[4] = {zero4, zero4, zero4, zero4};
#pragma unroll 2
        for (int h = 0; h < 16; ++h) {
            const LAS unsigned char* qb = lds + DS_QI + h * 2048 + q * 128;
            const h16x8 q0 = *(const LAS h16x8*)(qb + 16 * ((unsigned)kq ^ sw)), q1 = *(const LAS h16x8*)(qb + 16 * ((unsigned)(4 + kq) ^ sw));
            const float wh = WQ[q * 16 + h];
#pragma unroll
            for (int j = 0; j < 4; ++j) { f32x4 lg = __builtin_amdgcn_mfma_f32_16x16x32_f16(kf[j][0], q0, zero4, 0, 0, 0); lg = __builtin_amdgcn_mfma_f32_16x16x32_f16(kf[j][1], q1, lg, 0, 0, 0);
#pragma unroll
                for (int r = 0; r < 4; ++r) acc[j][r] += wh * fmaxf(lg[r], 0.f); }
        }
        unsigned c8[8];
#pragma unroll
        for (int j = 0; j < 4; ++j) { const int tt = tt0 + 8 * j; unsigned c4[4];
#pragma unroll
            for (int r = 0; r < 4; ++r) { const int k = 16 * tt + 4 * kq + r; c4[r] = (tt < ntile && k <= tq) ? sortable_hi16(acc[j][r]) : 0u; }
            c8[j * 2] = c4[0] | (c4[1] << 16); c8[j * 2 + 1] = c4[2] | (c4[3] << 16); }
#define CS_PUT(G) case G: _Pragma("unroll") for (int i = 0; i < 8; ++i) cs[G * 8 + i] = c8[i]; break;
        switch (grp) { CS_PUT(0) CS_PUT(1) CS_PUT(2) CS_PUT(3) CS_PUT(4) CS_PUT(5) CS_PUT(6) default: _Pragma("unroll") for (int i = 0; i < 8; ++i) cs[56 + i] = c8[i]; break; }
#undef CS_PUT
    }
    if (stages < 2) { unsigned x = 0; _Pragma("unroll") for (int i = 0; i < 64; ++i) x ^= cs[i]; asm volatile("" :: "v"(x)); __syncthreads(); return; }
    unsigned thr = 0u;
    for (int bit = 15; bit >= 0; --bit) {
        const unsigned cand = thr | (1u << bit), cm1 = (cand - 1u) * 0x00010001u; unsigned cp = 0u;
#pragma unroll
        for (int i = 0; i < 64; ++i) cp = pk_count_gt(cp, cs[i], cm1);
        unsigned cnt = (cp & 0xFFFFu) + (cp >> 16);
        cnt += __shfl_xor(cnt, 16); cnt += __shfl_xor(cnt, 32);
        LAS unsigned* cb = CNTB + (bit & 1) * 128;
        if (kq == 0) cb[w * 16 + q] = cnt;
        __syncthreads();
        unsigned tot = 0u;
#pragma unroll
        for (int ww = 0; ww < 8; ++ww) tot += cb[ww * 16 + q];
        if (tot >= (unsigned)Kq) thr = cand;
    }
    if (stages < 3) { asm volatile("" :: "v"(thr)); __syncthreads(); return; }
    unsigned cgt = 0u, ceq = 0u;
    {
        const unsigned t0p = thr * 0x00010001u, t1p = (thr - 1u) * 0x00010001u; unsigned cg = 0u, ce = 0u;
#pragma unroll
        for (int i = 0; i < 64; ++i) { cg = pk_count_gt(cg, cs[i], t0p); ce = pk_count_gt(ce, cs[i], t1p); }
        cgt = (cg & 0xFFFFu) + (cg >> 16); ceq = (ce & 0xFFFFu) + (ce >> 16) - cgt;
    }
    PCNT[w * 64 + lane] = cgt;
    unsigned cgw = cgt, cew = ceq;
    cgw += __shfl_xor(cgw, 16); cgw += __shfl_xor(cgw, 32); cew += __shfl_xor(cew, 16); cew += __shfl_xor(cew, 32);
    if (kq == 0) { CGT[w * 16 + q] = cgw; CEQ[w * 16 + q] = cew; }
    __syncthreads();
    unsigned gt_tot = 0u, eq_tot = 0u, base = 0u;
#pragma unroll
    for (int ww = 0; ww < 8; ++ww) { gt_tot += CGT[ww * 16 + q]; eq_tot += CEQ[ww * 16 + q]; }
    for (int ww = 0; ww < 8; ++ww)
#pragma unroll
        for (int kk = 0; kk < 4; ++kk) { const unsigned v = PCNT[ww * 64 + kk * 16 + q]; base += (ww < w || (ww == w && kk < kq)) ? v : 0u; }
    const unsigned need = (unsigned)Kq - gt_tot;
    const bool all_ties = (eq_tot == need);
    {
        LAS unsigned short* lq = LIST + q * 256; unsigned pos = base;
#pragma unroll
        for (int i = 0; i < 64; ++i) {
#pragma unroll
            for (int hf = 0; hf < 2; ++hf) {
                const unsigned v = hf ? (cs[i] >> 16) : (cs[i] & 0xFFFFu);
                const int grp = i >> 3, j = (i >> 1) & 3, r = 2 * (i & 1) + hf;
                const unsigned key = (unsigned)(16 * (w + 32 * grp + 8 * j) + 4 * kq + r);
                if (v > thr) { lq[pos] = (unsigned short)key; ++pos; }
                if (v == thr && v != 0u) { const unsigned slot = __hip_atomic_fetch_add(&TCNT[q], 1u, __ATOMIC_RELAXED, __HIP_MEMORY_SCOPE_WORKGROUP); if (slot < (unsigned)TIE_CAP) TLIST[q * TIE_CAP + slot] = (unsigned short)key; }
            }
            __builtin_amdgcn_sched_barrier(0);
        }
    }
    __syncthreads();
    if (stages < 4) return;
    for (int qi = 0; qi < 2; ++qi) {
        const int ql = w + 8 * qi;
        unsigned ntie = TCNT[ql]; ntie = ntie < (unsigned)TIE_CAP ? ntie : (unsigned)TIE_CAP;
        const unsigned gtq = __shfl(gt_tot, ql), needq = __shfl(need, ql);
        const int tql = t0 + ql;
        const int hh = lane & 15, jj = lane >> 4;
        const LAS unsigned char* qb = lds + DS_QI + hh * 2048 + ql * 128; const unsigned swq = (unsigned)((ql >> 1) & 7);
        const float wh = WQ[ql * 16 + hh];
        for (unsigned g0 = 0; g0 < ntie; g0 += 4) {
            const unsigned ti = g0 + jj; const unsigned key = (ti < ntie) ? TLIST[ql * TIE_CAP + ti] : 0u;
            const h16* kp = KIDX + (size_t)key * 64;
            float dt = 0.f;
#pragma unroll
            for (int c = 0; c < 8; ++c) { const h16x8 kv = *(const h16x8*)(kp + 8 * c); const h16x8 qv = *(const LAS h16x8*)(qb + 16 * ((unsigned)c ^ swq));
#pragma unroll
                for (int e = 0; e < 8; e += 2) { const h16x2v a = {kv[e], kv[e + 1]}, bq = {qv[e], qv[e + 1]}; dt = __builtin_amdgcn_fdot2(a, bq, dt, false); } }
            float sc = wh * fmaxf(dt, 0.f);
            sc += __shfl_xor(sc, 1); sc += __shfl_xor(sc, 2); sc += __shfl_xor(sc, 4); sc += __shfl_xor(sc, 8);
            if (hh == 0 && ti < ntie) TSC[ql * TIE_CAP + ti] = sc + 0.0f;
        }
        asm volatile("s_waitcnt lgkmcnt(0)" ::: "memory");
        const float mys = (lane < (int)ntie) ? TSC[ql * TIE_CAP + lane] : -INFINITY; const unsigned myk = (lane < (int)ntie) ? TLIST[ql * TIE_CAP + lane] : 0xFFFFu;
        unsigned rank = 0u;
        for (unsigned o = 0; o < ntie; ++o) { const float so = TSC[ql * TIE_CAP + o]; const unsigned ko = TLIST[ql * TIE_CAP + o]; rank += (so > mys || (so == mys && ko < myk)) ? 1u : 0u; }
        if (lane < (int)ntie && rank < needq) LIST[ql * 256 + gtq + rank] = (unsigned short)myk;
        if (lane == 0) ((LAS int*)(lds + LDS_SCR + 256))[ql] = (int)(gtq + (needq < ntie ? needq : ntie));
        (void)tql;
    }
    (void)all_ties;
    __syncthreads();
}

__device__ __forceinline__ void phase_dsa(const Params& P, LAS unsigned char* lds, int mode) {
    const int tid = threadIdx.x, lane = tid & 63, w = __builtin_amdgcn_readfirstlane(tid >> 6);
    for (int g = blockIdx.x; g < 256; g += gridDim.x) {
        const int b = (g & 7) >> 1, j = ((g & 1) << 5) | (g >> 3);
        for (int ui = 0; ui < 4; ++ui) {
            const int uq = (ui == 0) ? j : (ui == 1) ? 127 - j : (ui == 2) ? 128 + j : 255 - j;
            if (mode & 1) dsa_select_unit(P, lds, b, uq, mode >> 4);
            if (mode & 2) for (int qi = 0; qi < 2; ++qi) { const int ql = w + 8 * qi, t = 16 * uq + ql;
                sparse_attn_query(P, lds, w, lane, b, b * SEQ + t, ((const LAS int*)(lds + LDS_SCR + 256))[ql], (const LAS unsigned short*)(lds + DS_LIST) + ql * 256); }
            __syncthreads();
        }
    }
}

#define XB_TMO      128
#define XB_XCNT(j)  (256  + 64 * (j))
#define XB_XSUB(j)  (1280 + 64 * (j))
#define XB_XGEN(j)  (2304 + 64 * (j))
#define XB_TOP      3328
#define XB_TOPGEN   3392
#define XCD_BAR_WORDS 3456
#define XB_SPIN_CAP (1u << 22)
__device__ __forceinline__ unsigned xb_ld(unsigned* p)              { return __hip_atomic_load(p, __ATOMIC_RELAXED, __HIP_MEMORY_SCOPE_AGENT); }
__device__ __forceinline__ unsigned xb_add(unsigned* p, unsigned v) { return __hip_atomic_fetch_add(p, v, __ATOMIC_RELAXED, __HIP_MEMORY_SCOPE_AGENT); }
__device__ __forceinline__ unsigned xb_xcc_id() { return (unsigned)__builtin_amdgcn_s_getreg((3 << 11) | 20) & 0xFu; }
#define XB_SPIN(cond, bar) do { unsigned _sp = 0; while (cond) { __builtin_amdgcn_s_sleep(1); \
    if ((++_sp & 255u) == 0u) { if (xb_ld(&(bar)[XB_TMO])) break; if (_sp > XB_SPIN_CAP) { atomicAdd(&(bar)[XB_TMO], 1u); break; } } } } while (0)
struct XcdBarrier { unsigned* bar; unsigned x; volatile LAS unsigned* st; };
__device__ __forceinline__ XcdBarrier xcd_barrier_post(unsigned* bar, volatile LAS unsigned* st) {
    XcdBarrier b; b.bar = bar; b.x = xb_xcc_id(); b.st = st;
    if (threadIdx.x == 0) (void)xb_add(&bar[XB_XCNT(b.x)], 1u);
    return b;
}
__device__ __forceinline__ void xcd_barrier_complete(unsigned* bar, unsigned x, unsigned& nloc, unsigned& nx) {
    const unsigned G = gridDim.x * gridDim.y * gridDim.z;
    unsigned sum, cnt, mine, sp = 0u;
    for (;;) {
        sum = 0u; cnt = 0u; mine = 0u;
#pragma unroll
        for (unsigned j = 0; j < 16; ++j) { const unsigned c = xb_ld(&bar[XB_XCNT(j)]); sum += c; cnt += (c > 0u) ? 1u : 0u; mine = (j == x) ? c : mine; }
        if (sum == G) break;
        __builtin_amdgcn_s_sleep(1);
        if ((++sp & 255u) == 0u) { if (xb_ld(&bar[XB_TMO])) break; if (sp > XB_SPIN_CAP) { atomicAdd(&bar[XB_TMO], 1u); break; } }
    }
    nloc = mine > 0u ? mine : 1u; nx = cnt > 0u ? cnt : 1u;
}
__device__ __forceinline__ void xcd_barrier(const XcdBarrier& b) {
    asm volatile("s_waitcnt vmcnt(0)" ::: "memory");
    __syncthreads();
    if (threadIdx.x == 0) {
        unsigned* bar = b.bar;
        __builtin_amdgcn_s_waitcnt(0);
        unsigned nloc = b.st[0], nx = b.st[1];
        if (nloc == 0u) { xcd_barrier_complete(bar, b.x, nloc, nx); b.st[0] = nloc; b.st[1] = nx; }
        const unsigned old = xb_add(&bar[XB_XSUB(b.x)], 1u);
        const unsigned gen = old / nloc;
        if (old + 1u == (gen + 1u) * nloc) {
            __builtin_amdgcn_fence(__ATOMIC_RELEASE, "agent");
            asm volatile("s_waitcnt vmcnt(0)" ::: "memory");
            const unsigned og = xb_add(&bar[XB_TOP], 1u);
            const unsigned tg = og / nx;
            if (og + 1u == (tg + 1u) * nx) xb_add(&bar[XB_TOPGEN], 1u);
            else XB_SPIN(xb_ld(&bar[XB_TOPGEN]) == tg, bar);
            __builtin_amdgcn_fence(__ATOMIC_ACQUIRE, "agent");
            xb_add(&bar[XB_XGEN(b.x)], 1u);
            asm volatile("s_waitcnt vmcnt(0)" ::: "memory");
        } else {
            XB_SPIN(xb_ld(&bar[XB_XGEN(b.x)]) == gen, bar);
            __builtin_amdgcn_fence(__ATOMIC_ACQUIRE, "agent");
            asm volatile("s_waitcnt vmcnt(0)" ::: "memory");
        }
    }
    __syncthreads();
}

#ifndef MK_N_LAUNCHES
#define MK_N_LAUNCHES 1
#endif
constexpr int N_PHASES = 8;
extern __shared__ __attribute__((aligned(16))) unsigned char dyn_lds[];
__global__ void __launch_bounds__(NTHR, 2) hybrid_fwd(Params P) {
    LAS unsigned char* lds = (LAS unsigned char*)dyn_lds;
    volatile LAS unsigned* MISC = (volatile LAS unsigned*)(lds + LDS_SCR);
    for (int u = threadIdx.x; u < (LDS_BYTES - LDS_SCR) / 4; u += NTHR) MISC[u] = 0u;
    __syncthreads();
    XcdBarrier bar = xcd_barrier_post((unsigned*)(P.ws + WS_CTL) + 4096 + P.ph_lo * XCD_BAR_WORDS, MISC + 8);
    const int lo = P.ph_lo, hi = P.ph_hi;
#ifndef PHASE_MASK
#define PHASE_MASK 0xFF
#endif
#define IN(k) (((PHASE_MASK >> (k)) & 1) && lo <= (k) && (k) < hi)
#define SEAM(k) do { if (IN(k) && IN((k) + 1)) xcd_barrier(bar); } while (0)
#ifndef REPEAT_MASK
#define REPEAT_MASK 0
#endif
#define REP(k) for (int rep_ = 0; rep_ < 1 + ((REPEAT_MASK >> (k)) & 1); ++rep_, (rep_ < 1 + ((REPEAT_MASK >> (k)) & 1) ? xcd_barrier(bar) : (void)0))
    if (IN(0)) REP(0) phase_prologue(P, lds);
    SEAM(0);
    if (IN(1)) REP(1) phase_h(P, lds);
    SEAM(1);
    if (IN(2)) REP(2) {
        pg8::Gemm g{(const h16*)(P.ws + WS_H), (const h16*)(P.ws + WS_W1T), T, NW1, DM, DM, DM, 0}; pg8::StaticOrder S; S.init(T, NW1, gridDim.x, blockIdx.x);
        EpiProj E{(h16*)(P.ws + WS_CQ), (h16*)(P.ws + WS_KVC), (h16*)(P.ws + WS_SGA), (h16*)(P.ws + WS_QB), (h16*)(P.ws + WS_KB), (h16*)(P.ws + WS_VB), (h16*)(P.ws + WS_SGB),
                  (float*)(P.ws + WS_SMALL), (float*)(P.ws + WS_SSQ), (const float*)(P.ws + WS_ROPE32)};
        pg8::gemm_phase(lds, g, S, E);
    }
    SEAM(2);
    if (IN(3)) {
        phase_rowops(P);
        REP(3) {
        { pg8::Gemm g{(const h16*)(P.ws + WS_CQ), (const h16*)(P.ws + WS_WQT), T, NQ, 512, 512, 512, 0}; pg8::StaticOrder S; S.init(T, NQ, gridDim.x, blockIdx.x);
          EpiQ E{(h16*)(P.ws + WS_QLAT), (h16*)(P.ws + WS_QROPE), (h16*)(P.ws + WS_QIDX), (const float*)(P.ws + WS_SSQ), (const float*)(P.ws + WS_ROPE32), (const float*)(P.ws + WS_ROPE16)};
          pg8::gemm_phase(lds, g, S, E); }
        __syncthreads();
        REP(8) phase_dilated_part(P, lds);
        }
    }
    SEAM(3);
#if DSA_PROBE == 0
    if (IN(4)) { phase_dsa(P, lds, 3 | 0x90); __syncthreads(); REP(4) phase_dilated_last(P, lds); }
#else
    if (IN(4)) { phase_dilated_last(P, lds); xcd_barrier(bar); phase_dsa(P, lds, 3 | 0x90); xcd_barrier(bar); phase_dsa(P, lds, DSA_PROBE == 1 ? (3 | 0x90) : (1 | (DSA_PROBE << 4))); }
#endif
    SEAM(4);
    if (IN(5)) REP(5) {
        pg8::Gemm g{(const h16*)(P.ws + WS_OLAT), (const h16*)(P.ws + WS_WUVT), T, 1024, 512, 2048, 512, 512}; pg8::StaticOrder S; S.init(T, 1024, gridDim.x, blockIdx.x);
        EpiOA E{(h16*)(P.ws + WS_OAB), (const h16*)(P.ws + WS_SGA)};
        pg8::gemm_phase(lds, g, S, E);
    }
    SEAM(5);
    if (IN(6)) REP(6) {
        pg8::Gemm g{(const h16*)(P.ws + WS_OAB), (const h16*)(P.ws + WS_WOT), T, DM, DM, DM, DM, 0}; pg8::StaticOrder S; S.init(T, DM, gridDim.x, blockIdx.x);
        EpiY E{(h16*)(P.ws + WS_Y), (float*)(P.ws + WS_SSY)};
        pg8::gemm_phase(lds, g, S, E);
    }
    SEAM(6);
    if (IN(7)) REP(7) phase_final(P, lds);
#undef IN
#undef SEAM
}

extern "C" void kernel_launch(void* const* d_in, const int* in_sizes, int n_in, void* d_out, int out_size, void* d_ws, size_t ws_size, hipStream_t stream) {
    static int grid = 0;
    if (grid == 0) {
        if (n_in != 14 || in_sizes[0] != T * DM || out_size != T * DM || ws_size < WS_END) { fprintf(stderr, "kernel_launch: unexpected shapes (n_in %d, in0 %d, out %d, ws %zu)\n", n_in, n_in > 0 ? in_sizes[0] : -1, out_size, ws_size); grid = -1; return; }
        int dev = 0, cus = 0, per_cu = 0;
        if (hipGetDevice(&dev) != hipSuccess || hipDeviceGetAttribute(&cus, hipDeviceAttributeMultiprocessorCount, dev) != hipSuccess) { grid = -1; return; }
        if (hipFuncSetAttribute((const void*)hybrid_fwd, hipFuncAttributeMaxDynamicSharedMemorySize, LDS_BYTES) != hipSuccess) { fprintf(stderr, "kernel_launch: hipFuncSetAttribute failed\n"); grid = -1; return; }
        if (hipOccupancyMaxActiveBlocksPerMultiprocessor(&per_cu, (const void*)hybrid_fwd, NTHR, LDS_BYTES) != hipSuccess || per_cu < 1) { fprintf(stderr, "kernel_launch: occupancy query says %d blocks per CU\n", per_cu); }
        (void)hipGetLastError();
        grid = cus;
    }
    if (grid < 0) return;
    (void)hipMemsetAsync((char*)d_ws + WS_CTL, 0, 1 * MiB, stream);
    Params P{};
    P.x = (const float*)d_in[0]; P.c = (const float*)d_in[1]; P.w_ada = (const float*)d_in[2]; P.b_ada = (const float*)d_in[3]; P.g_pre = (const float*)d_in[4]; P.g_post = (const float*)d_in[5];
    P.w_in = (const float*)d_in[6]; P.g_q = (const float*)d_in[7]; P.g_kv = (const float*)d_in[8]; P.w_uq = (const float*)d_in[9]; P.w_uq_idx = (const float*)d_in[10]; P.w_uk = (const float*)d_in[11];
    P.w_uv = (const float*)d_in[12]; P.w_out = (const float*)d_in[13]; P.out = (float*)d_out; P.ws = (unsigned char*)d_ws;
#if MK_N_LAUNCHES == 1
    P.ph_lo = 0; P.ph_hi = N_PHASES;
    hipLaunchKernelGGL(hybrid_fwd, dim3(grid), dim3(NTHR), LDS_BYTES, stream, P);
#else
    for (int k = 0; k < N_PHASES; ++k) { P.ph_lo = k; P.ph_hi = k + 1; hipLaunchKernelGGL(hybrid_fwd, dim3(grid), dim3(NTHR), LDS_BYTES, stream, P); }
#endif
}
```

```cpp
#include <hip/hip_runtime.h>
#include <cstdint>
#include <cstdio>
#include <cmath>

#define LAS __attribute__((address_space(3)))
typedef _Float16 h16;
typedef _Float16 h16x2 __attribute__((ext_vector_type(2)));
typedef _Float16 h16x4 __attribute__((ext_vector_type(4)));
typedef _Float16 h16x8 __attribute__((ext_vector_type(8)));
typedef float f32x2 __attribute__((ext_vector_type(2)));
typedef float f32x4 __attribute__((ext_vector_type(4)));
typedef unsigned u32x2 __attribute__((ext_vector_type(2)));
typedef unsigned u32x4 __attribute__((ext_vector_type(4)));

constexpr int NB = 4, SEQ = 4096, T = NB * SEQ, DM = 2048;
constexpr int NW1 = 6144;
constexpr int NQ = 3328;
constexpr int KVW = 288;
constexpr float EPS = 1e-6f;
constexpr float SCQ = 0.08838834764831845f * 1.4426950408889634f;

constexpr size_t MiB = 1u << 20;
constexpr size_t WS_CTL = 0;
constexpr size_t WS_MODP = 1 * MiB;
constexpr size_t WS_ROPE32 = 2 * MiB;
constexpr size_t WS_ROPE16 = 2 * MiB + 512 * 1024;
constexpr size_t WS_SSQ = 3 * MiB;
constexpr size_t WS_SSY = 4 * MiB;
constexpr size_t WS_W1T = 8 * MiB;
constexpr size_t WS_WQT = 32 * MiB;
constexpr size_t WS_WUVT = 36 * MiB;
constexpr size_t WS_WOT = 38 * MiB;
constexpr size_t WS_KVC = 46 * MiB;
constexpr size_t WS_KIDX = 55 * MiB;
constexpr size_t WS_WIDX = 57 * MiB;
constexpr size_t WS_SMALL = 58 * MiB;
constexpr size_t WS_CQ = 66 * MiB;
constexpr size_t WS_SGA = 82 * MiB;
constexpr size_t WS_OAB = 114 * MiB;
constexpr size_t WS_QLAT = 178 * MiB;
constexpr size_t WS_QROPE = 242 * MiB;
constexpr size_t WS_QIDX = 250 * MiB;
constexpr size_t WS_H = 282 * MiB;
constexpr size_t WS_OP4 = 282 * MiB;
constexpr size_t WS_OP16 = 314 * MiB;
constexpr size_t WS_QB = 346 * MiB;
constexpr size_t WS_KB = 378 * MiB;
constexpr size_t WS_VB = 410 * MiB;
constexpr size_t WS_SGB = 442 * MiB;
constexpr size_t WS_END = 474 * MiB;
constexpr size_t WS_LSEP = 6 * MiB;
#ifndef DSA_PROBE
#define DSA_PROBE 0
#endif
constexpr size_t WS_OLAT = DSA_PROBE ? 346 * MiB : 178 * MiB;
constexpr size_t WS_Y = 178 * MiB;

struct Params {
    const float *x, *c, *w_ada, *b_ada, *g_pre, *g_post, *w_in, *g_q, *g_kv, *w_uq, *w_uq_idx, *w_uk, *w_uv, *w_out;
    float* out; unsigned char* ws;
    int ph_lo, ph_hi;
};

__device__ __forceinline__ unsigned pk2h(float a, float b) { h16x2 t = {(h16)a, (h16)b}; return __builtin_bit_cast(unsigned, t); }
__device__ __forceinline__ float siluf(float v) { return v * __builtin_amdgcn_rcpf(1.0f + __builtin_amdgcn_exp2f(-1.4426950408889634f * v)); }
__device__ __forceinline__ float wave_sum(float v) {
#pragma unroll
    for (int o = 1; o < 64; o <<= 1) v += __shfl_xor(v, o);
    return v;
}
__device__ __forceinline__ float wave_max(float v) {
#pragma unroll
    for (int o = 1; o < 64; o <<= 1) v = fmaxf(v, __shfl_xor(v, o));
    return v;
}

constexpr int NTHR = 512, NWAVE = 8;
constexpr int LDS_SCR = 159744;
constexpr int LDS_BYTES = LDS_SCR + 4096;
#ifndef PROF_SEL
#define PROF_SEL -1
#endif
#ifndef PROF_BLK
#define PROF_BLK 37
#endif
#define PROF_B(k) do { if ((k) == PROF_SEL && threadIdx.x == 0) { *(LAS unsigned long long*)(lds + LDS_SCR + 128) = __builtin_amdgcn_s_memrealtime(); } } while (0)
#define PROF_E(k) do { if ((k) == PROF_SEL && threadIdx.x == 0) { *(LAS unsigned long long*)(lds + LDS_SCR + 136) += __builtin_amdgcn_s_memrealtime() - *(LAS unsigned long long*)(lds + LDS_SCR + 128); } } while (0)

namespace pg8 {
constexpr int BM = 256, BK = 64, HALF = 128, HTB = HALF * BK * 2, STAGE_BYTES = 8 * HTB, NXCD = 8, WGM = 8;
__host__ __device__ __forceinline__ int lds_byte(int r, int c) { const int st = (r >> 4) * 2 + (c >> 5), rr = r & 15, cc = c & 31, ob = rr * 64 + cc * 2; return st * 1024 + (ob ^ (((ob >> 9) & 1) << 5)); }
__host__ __device__ __forceinline__ void stage_rc(int b, int& R, int& C) { const int st = b / 1024, sb = b % 1024, swz = sb ^ (((sb >> 9) & 1) << 5); R = (st >> 1) * 16 + swz / 64; C = (st & 1) * 32 + (swz % 64) / 2; }
__host__ __device__ __forceinline__ int perm32(int rho) { const int n = rho >> 4, i = rho & 15; return 8 * (i >> 2) + 4 * n + (i & 3); }

struct Unit { int pm, pn; };
struct Gemm { const h16* A; const h16* Bt; int M, N, K, lda, ldb, a_pn_off; };

struct StaticOrder {
    int nM, nN, nwg, G, c;
    __device__ void init(int M, int N, int G_, int c_) { nM = M / BM; nN = N / BM; nwg = nM * nN; G = __builtin_amdgcn_readfirstlane(G_); c = __builtin_amdgcn_readfirstlane(c_); }
    __device__ bool next(int i, Unit& u) const {
        const int L = __builtin_amdgcn_readfirstlane(i * G + c); if (L >= nwg) return false;
        int wgid = L; { const int q = nwg / NXCD, r = nwg % NXCD, xcd = wgid % NXCD, off = wgid / NXCD; wgid = (xcd < r ? xcd * (q + 1) : r * (q + 1) + (xcd - r) * q) + off; }
        const int nig = WGM * nN, gid = wgid / nig, fm = gid * WGM, gsz = (nM - fm) < WGM ? (nM - fm) : WGM;
        u.pm = __builtin_amdgcn_readfirstlane(fm + ((wgid % nig) % gsz)); u.pn = __builtin_amdgcn_readfirstlane((wgid % nig) / gsz); return true;
    }
};

template <class Epi>
__device__ __forceinline__ void gemm_phase(LAS unsigned char* lds, const Gemm g, const StaticOrder& S, const Epi& E) {
    const int tid = threadIdx.x, wid = __builtin_amdgcn_readfirstlane(tid >> 6), lane = tid & 63, wr = wid >> 2, wc = wid & 3, fr = lane & 15, fq = lane >> 4;
    const int K = g.K, nt = K / BK;
    unsigned voffA[2], voffB[2];
#pragma unroll
    for (int i = 0; i < 2; ++i) { int R, C; stage_rc(tid * 16 + i * 8192, R, C); const int Rb = (R & ~31) + perm32(R & 31);
        voffA[i] = (unsigned)(R * g.lda + C) * 2u; voffB[i] = (unsigned)(Rb * g.ldb + C) * 2u; }
    const size_t kstep = (size_t)(BK * 2);
    const size_t hstepA = (size_t)HALF * g.lda * 2, hstepB = (size_t)HALF * g.ldb * 2;
    const size_t tstepA = 2 * hstepA, tstepB = 2 * hstepB;
    const unsigned ldsw = (unsigned)wid * 1024u;
    const int aoff = lds_byte(wr * 64 + fr, fq * 8), boff = lds_byte(wc * 32 + fr, fq * 8);
#define PG8_SA(b, h) (((b) * 2 + (h)) * HTB)
#define PG8_SB(b, h) ((4 + (b) * 2 + (h)) * HTB)
#define PG8_STAGE(bufoff, gbase, voff) do { _Pragma("unroll") for (int _i = 0; _i < 2; ++_i) \
        __builtin_amdgcn_global_load_lds((const unsigned*)((const char*)(gbase) + (voff)[_i]), (LAS unsigned*)(lds + (bufoff) + ldsw + _i * 8192), 16, 0, 0); } while (0)
#define PG8_LDA(dst, b, h) do { _Pragma("unroll") for (int m = 0; m < 4; ++m) _Pragma("unroll") for (int k = 0; k < 2; ++k) dst[m][k] = *(const LAS h16x8*)(lds + PG8_SA(b, h) + aoff + m * 2048 + k * 1024); } while (0)
#define PG8_LDB(dst, b, h) do { _Pragma("unroll") for (int n = 0; n < 2; ++n) _Pragma("unroll") for (int k = 0; k < 2; ++k) dst[n][k] = *(const LAS h16x8*)(lds + PG8_SB(b, h) + boff + n * 2048 + k * 1024); } while (0)
#define PG8_MMA(ai, bj, At, Bt) do { __builtin_amdgcn_s_setprio(1); _Pragma("unroll") for (int m = 0; m < 4; ++m) _Pragma("unroll") for (int n = 0; n < 2; ++n) _Pragma("unroll") for (int k = 0; k < 2; ++k) \
        acc[ai][bj][m][n] = __builtin_amdgcn_mfma_f32_16x16x32_f16(Bt[n][k], At[m][k], acc[ai][bj][m][n], 0, 0, 0); __builtin_amdgcn_s_setprio(0); } while (0)
#define PG8_WAIT_V(n) asm volatile("s_waitcnt vmcnt(" #n ")" ::: "memory")
#define PG8_WAIT_L(n) asm volatile("s_waitcnt lgkmcnt(" #n ")" ::: "memory")
#define PG8_BAR __builtin_amdgcn_s_barrier()
#define PG8_SCHED __builtin_amdgcn_sched_barrier(0)
    Unit cur, nxt; int ui = 0;
    if (!S.next(0, cur)) return;
    PROF_B(Epi::PROF_ID);
    f32x4 acc[2][2][4][2];
#pragma unroll
    for (int a = 0; a < 2; ++a)
#pragma unroll
        for (int b = 0; b < 2; ++b)
#pragma unroll
            for (int m = 0; m < 4; ++m)
#pragma unroll
                for (int n = 0; n < 2; ++n) acc[a][b][m][n] = (f32x4){0.f, 0.f, 0.f, 0.f};
    h16x8 At[4][2], B0[2][2], B1[2][2];
    const char* cA = (const char*)g.A + (size_t)cur.pm * tstepA + (size_t)cur.pn * g.a_pn_off * 2; const char* cB = (const char*)g.Bt + (size_t)cur.pn * tstepB;
    PG8_STAGE(PG8_SB(0, 0), cB, voffB); PG8_STAGE(PG8_SB(0, 1), cB + hstepB, voffB); PG8_STAGE(PG8_SA(0, 0), cA, voffA); PG8_STAGE(PG8_SA(0, 1), cA + hstepA, voffA);
    if (wr == 1) PG8_BAR;
    PG8_WAIT_V(2); PG8_BAR;
    PG8_STAGE(PG8_SB(1, 0), cB + kstep, voffB); PG8_STAGE(PG8_SA(1, 0), cA + kstep, voffA); PG8_STAGE(PG8_SB(1, 1), cB + hstepB + kstep, voffB);
    PG8_WAIT_V(6); PG8_BAR;
    for (;;) {
        const bool has_next = S.next(ui + 1, nxt);
        const char* nA = has_next ? (const char*)g.A + (size_t)nxt.pm * tstepA + (size_t)nxt.pn * g.a_pn_off * 2 : cA; const char* nB = has_next ? (const char*)g.Bt + (size_t)nxt.pn * tstepB : cB;
        for (int t = 0; t < nt; t += 2) {
            const bool last = (t == nt - 2);
            const char* a1 = cA + (size_t)(t + 1) * kstep;
            const char* a2 = last ? nA : cA + (size_t)(t + 2) * kstep; const char* b2 = last ? nB : cB + (size_t)(t + 2) * kstep;
            const char* a3 = a2 + kstep; const char* b3 = b2 + kstep;
            PG8_LDB(B0, 0, 0); PG8_LDB(B1, 0, 1); PG8_SCHED; PG8_LDA(At, 0, 0); PG8_STAGE(PG8_SA(1, 1), a1 + hstepA, voffA);
            PG8_WAIT_V(8); PG8_WAIT_L(0); PG8_BAR; PG8_MMA(0, 0, At, B0); PG8_MMA(0, 1, At, B1); PG8_BAR; PG8_SCHED;
            PG8_LDA(At, 0, 1); PG8_STAGE(PG8_SB(0, 0), b2, voffB); PG8_STAGE(PG8_SB(0, 1), b2 + hstepB, voffB); PG8_STAGE(PG8_SA(0, 0), a2, voffA);
            PG8_WAIT_V(8); PG8_WAIT_L(0); PG8_BAR; PG8_MMA(1, 0, At, B0); PG8_MMA(1, 1, At, B1); PG8_BAR; PG8_SCHED;
            PG8_LDB(B0, 1, 0); PG8_LDB(B1, 1, 1); PG8_SCHED; PG8_LDA(At, 1, 0); PG8_STAGE(PG8_SA(0, 1), a2 + hstepA, voffA);
            PG8_WAIT_V(8); PG8_WAIT_L(0); PG8_BAR; PG8_MMA(0, 0, At, B0); PG8_MMA(0, 1, At, B1); PG8_BAR; PG8_SCHED;
            PG8_LDA(At, 1, 1); PG8_STAGE(PG8_SB(1, 0), b3, voffB); PG8_STAGE(PG8_SB(1, 1), b3 + hstepB, voffB); PG8_STAGE(PG8_SA(1, 0), a3, voffA);
            PG8_WAIT_V(8); PG8_WAIT_L(0); PG8_BAR; PG8_MMA(1, 0, At, B0); PG8_MMA(1, 1, At, B1); PG8_BAR; PG8_SCHED;
        }
        if (wr == 0) PG8_BAR;
        PROF_E(Epi::PROF_ID); PROF_B(Epi::PROF_ID + 1);
        E(acc, cur, wr, wc, fr, fq);
        PROF_E(Epi::PROF_ID + 1); PROF_B(Epi::PROF_ID);
        if (!has_next) break;
#pragma unroll
        for (int a = 0; a < 2; ++a)
#pragma unroll
            for (int b = 0; b < 2; ++b)
#pragma unroll
                for (int m = 0; m < 4; ++m)
#pragma unroll
                    for (int n = 0; n < 2; ++n) acc[a][b][m][n] = (f32x4){0.f, 0.f, 0.f, 0.f};
        cur = nxt; cA = nA; cB = nB; ++ui;
        if (wr == 1) PG8_BAR;
    }
    PG8_WAIT_V(0);
    PG8_BAR;
#undef PG8_SA
#undef PG8_SB
#undef PG8_STAGE
#undef PG8_LDA
#undef PG8_LDB
#undef PG8_MMA
#undef PG8_WAIT_V
#undef PG8_WAIT_L
#undef PG8_BAR
#undef PG8_SCHED
}
}

using pg8::Unit;
__device__ __forceinline__ u32x4 pack8(const f32x4 a, const f32x4 b) { u32x4 w; w.x = pk2h(a[0], a[1]); w.y = pk2h(a[2], a[3]); w.z = pk2h(b[0], b[1]); w.w = pk2h(b[2], b[3]); return w; }

__device__ __forceinline__ float xlane32(float v, bool upper) { const auto r = __builtin_amdgcn_permlane32_swap(__float_as_uint(v), __float_as_uint(v), false, false); return __uint_as_float(upper ? r[0] : r[1]); }
__device__ __forceinline__ float xlane16(float v, bool oddrow) { const auto r = __builtin_amdgcn_permlane16_swap(__float_as_uint(v), __float_as_uint(v), false, false); return __uint_as_float(oddrow ? r[0] : r[1]); }
__device__ __forceinline__ void rope8(f32x4& v0, f32x4& v1, const f32x4 (&t)[4], const f32x4 p0, const f32x4 p1, float sg) {
#pragma unroll
    for (int e = 0; e < 4; ++e) { const float c0 = t[e >> 1][2 * (e & 1)], s0 = t[e >> 1][2 * (e & 1) + 1], c1 = t[2 + (e >> 1)][2 * (e & 1)], s1 = t[2 + (e >> 1)][2 * (e & 1) + 1];
        v0[e] = v0[e] * c0 + sg * p0[e] * s0; v1[e] = v1[e] * c1 + sg * p1[e] * s1; }
}
struct EpiProj {
    static constexpr int PROF_ID = 40;
    h16 *CQ, *KVC, *SGA, *QB, *KB, *VB, *SGB; float *SMALL, *SSQ; const float* rope32;
    __device__ __forceinline__ void operator()(const f32x4 (&acc)[2][2][4][2], const Unit& u, int wr, int wc, int fr_in, int fq_in) const {
        int fr = fr_in, fq = fq_in; asm volatile("" : "+v"(fr), "+v"(fq));
        const int pn = u.pn;
        const int rowb = u.pm * 256 + wr * 64 + fr;
        if (pn >= 8 && pn < 16 && wc == 0) {
            const bool isq = pn < 12; const float sc = isq ? SCQ : 1.0f, sg = (fq < 2) ? -1.f : 1.f; const bool upper = fq >= 2;
            h16* dst = (isq ? QB + (pn - 8) * 256 : KB + (pn - 12) * 256) + fq * 8;
            const float* tb = rope32 + 16 * (fq & 1);
            f32x4 ta[4], tn[4];
#define EP_LDT(t, g) do { const int pos_ = (rowb + 128 * ((g) >> 2) + 16 * ((g) & 3)) & (SEQ - 1); _Pragma("unroll") for (int k_ = 0; k_ < 4; ++k_) t[k_] = *(const f32x4*)(tb + (size_t)pos_ * 32 + 4 * k_); } while (0)
            EP_LDT(ta, 0);
#pragma unroll
            for (int g = 0; g < 8; ++g) {
                if (g < 7) { if (g & 1) EP_LDT(ta, g + 1); else EP_LDT(tn, g + 1); }
                const int ai = g >> 2, m = g & 3; const int row = rowb + 128 * ai + 16 * m;
#pragma unroll
                for (int bj = 0; bj < 2; ++bj) { f32x4 v0 = acc[ai][bj][m][0], v1 = acc[ai][bj][m][1], p0, p1;
#pragma unroll
                    for (int e = 0; e < 4; ++e) { p0[e] = xlane32(v0[e], upper); p1[e] = xlane32(v1[e], upper); }
                    if (g & 1) rope8(v0, v1, tn, p0, p1, sg); else rope8(v0, v1, ta, p0, p1, sg);
                    v0 = v0 * sc; v1 = v1 * sc;
                    *(u32x4*)(dst + (size_t)row * 1024 + bj * 128) = pack8(v0, v1); }
            }
#undef EP_LDT
            return;
        }
#pragma unroll
        for (int ai = 0; ai < 2; ++ai)
#pragma unroll
            for (int m = 0; m < 4; ++m) {
                const int row = rowb + ai * 128 + m * 16;
                if (pn < 2) {
                    float s = 0.f;
#pragma unroll
                    for (int bj = 0; bj < 2; ++bj) { const f32x4 v0 = acc[ai][bj][m][0], v1 = acc[ai][bj][m][1];
                        s += (v0[0] * v0[0] + v0[1] * v0[1]) + (v0[2] * v0[2] + v0[3] * v0[3]) + (v1[0] * v1[0] + v1[1] * v1[1]) + (v1[2] * v1[2] + v1[3] * v1[3]);
                        *(u32x4*)(CQ + (size_t)row * 512 + pn * 256 + bj * 128 + wc * 32 + fq * 8) = pack8(v0, v1); }
                    s += __shfl_xor(s, 16); s += __shfl_xor(s, 32);
                    if (fq == 0) SSQ[(size_t)row * 8 + pn * 4 + wc] = s;
                } else if (pn == 2) {
#pragma unroll
                    for (int bj = 0; bj < 2; ++bj) *(u32x4*)(KVC + (size_t)row * KVW + bj * 128 + wc * 32 + fq * 8) = pack8(acc[ai][bj][m][0], acc[ai][bj][m][1]);
                } else if (pn == 3) {
                    float* p = SMALL + (size_t)row * 128 + wc * 32 + fq * 8;
                    *(f32x4*)p = acc[ai][0][m][0]; *(f32x4*)(p + 4) = acc[ai][0][m][1];
                } else if (pn < 8 || pn >= 20) {
                    h16* dst = (pn < 8 ? SGA + (pn - 4) * 256 : SGB + (pn - 20) * 256) + (size_t)row * 1024 + wc * 32 + fq * 8;
#pragma unroll
                    for (int bj = 0; bj < 2; ++bj) { f32x4 v0 = acc[ai][bj][m][0], v1 = acc[ai][bj][m][1];
#pragma unroll
                        for (int e = 0; e < 4; ++e) { v0[e] = siluf(v0[e]); v1[e] = siluf(v1[e]); }
                        *(u32x4*)(dst + bj * 128) = pack8(v0, v1); }
                } else if (pn >= 16) {
                    h16* dst = VB + (size_t)row * 1024 + (pn - 16) * 256 + wc * 32 + fq * 8;
#pragma unroll
                    for (int bj = 0; bj < 2; ++bj) *(u32x4*)(dst + bj * 128) = pack8(acc[ai][bj][m][0], acc[ai][bj][m][1]);
                } else {
                    const bool isq = pn < 12; const float sc = isq ? SCQ : 1.0f;
                    h16* dst = (isq ? QB + (pn - 8) * 256 : KB + (pn - 12) * 256) + (size_t)row * 1024 + wc * 32 + fq * 8;
#pragma unroll
                    for (int bj = 0; bj < 2; ++bj) *(u32x4*)(dst + bj * 128) = pack8(acc[ai][bj][m][0] * sc, acc[ai][bj][m][1] * sc);
                }
            }
    }
};

struct EpiQ {
    static constexpr int PROF_ID = 42;
    h16 *QLAT, *QROPE, *QIDX; const float *SSQ, *rope32, *rope16;
    __device__ __forceinline__ void operator()(const f32x4 (&acc)[2][2][4][2], const Unit& u, int wr, int wc, int fr_in, int fq_in) const {
        int fr = fr_in, fq = fq_in; asm volatile("" : "+v"(fr), "+v"(fq));
        const int pn = u.pn;
        const int rowb = u.pm * 256 + wr * 64 + fr;
        const bool rope_q = (pn == 0), rope_i = (pn >= 9) && ((wc & 1) == 0);
        const float* tb = rope_q ? rope32 + 16 * (fq & 1) : rope16;
        const int tstride = rope_q ? 32 : 16;
#pragma unroll
        for (int am = 0; am < 4; ++am) { const int ai = am >> 1, mb = 2 * (am & 1);
            float rs[2];
            f32x4 tt[2][4];
#pragma unroll
            for (int mm = 0; mm < 2; ++mm) { const int m = mb + mm; const int row = rowb + ai * 128 + m * 16; float ss = 0.f;
                { const f32x4 sa_ = *(const f32x4*)(SSQ + (size_t)row * 8), sb_ = *(const f32x4*)(SSQ + (size_t)row * 8 + 4); ss = ((sa_[0] + sa_[1]) + (sa_[2] + sa_[3])) + ((sb_[0] + sb_[1]) + (sb_[2] + sb_[3])); }
                rs[mm] = __builtin_amdgcn_rsqf(ss * (1.0f / 512.0f) + EPS);
                if (rope_q || rope_i) {
#pragma unroll
                    for (int k = 0; k < 4; ++k) tt[mm][k] = *(const f32x4*)(tb + (size_t)(row & (SEQ - 1)) * tstride + 4 * k); } }
#pragma unroll
            for (int mm = 0; mm < 2; ++mm) { const int m = mb + mm;
                const int row = rowb + ai * 128 + m * 16;
                const float rstd = rs[mm];
#pragma unroll
                for (int bj = 0; bj < 2; ++bj) { f32x4 v0 = acc[ai][bj][m][0] * rstd, v1 = acc[ai][bj][m][1] * rstd;
                    if (pn == 0) {
                        f32x4 p0, p1;
#pragma unroll
                        for (int e = 0; e < 4; ++e) { p0[e] = xlane32(v0[e], fq >= 2); p1[e] = xlane32(v1[e], fq >= 2); }
                        rope8(v0, v1, tt[mm], p0, p1, (fq < 2) ? -1.f : 1.f);
                        v0 = v0 * SCQ; v1 = v1 * SCQ;
                        *(u32x4*)(QROPE + ((size_t)row * 8 + (4 * bj + wc)) * 32 + fq * 8) = pack8(v0, v1);
                    } else if (pn < 9) {
                        v0 = v0 * SCQ; v1 = v1 * SCQ;
                        *(u32x4*)(QLAT + ((size_t)row * 8 + (pn - 1)) * 256 + bj * 128 + wc * 32 + fq * 8) = pack8(v0, v1);
                    } else {
                        if ((wc & 1) == 0) {
                            f32x4 p0, p1, r0 = v0, r1 = v1;
#pragma unroll
                            for (int e = 0; e < 4; ++e) { p0[e] = xlane16(v0[e], (fq & 1) != 0); p1[e] = xlane16(v1[e], (fq & 1) != 0); }
                            rope8(r0, r1, tt[mm], p0, p1, (fq == 0) ? -1.f : 1.f);
                            if (fq < 2) { v0 = r0; v1 = r1; }
                        }
                        *(u32x4*)(QIDX + (size_t)row * 1024 + (pn - 9) * 256 + bj * 128 + wc * 32 + fq * 8) = pack8(v0, v1);
                    } }
            }
            asm volatile("" ::: "memory");
        }
    }
};

struct EpiOA {
    static constexpr int PROF_ID = 44;
    h16* OAB; const h16* SGA;
    __device__ __forceinline__ void operator()(const f32x4 (&acc)[2][2][4][2], const Unit& u, int wr, int wc, int fr_in, int fq_in) const {
        int fr = fr_in, fq = fq_in; asm volatile("" : "+v"(fr), "+v"(fq));
#pragma unroll
        for (int ai = 0; ai < 2; ++ai)
#pragma unroll
            for (int m = 0; m < 4; ++m) {
                const int row = u.pm * 256 + ai * 128 + wr * 64 + m * 16 + fr;
#pragma unroll
                for (int bj = 0; bj < 2; ++bj) { const int col = u.pn * 256 + bj * 128 + wc * 32 + fq * 8;
                    const h16x8 g = *(const h16x8*)(SGA + (size_t)row * 1024 + col);
                    f32x4 v0 = acc[ai][bj][m][0], v1 = acc[ai][bj][m][1];
#pragma unroll
                    for (int e = 0; e < 4; ++e) { v0[e] *= (float)g[e]; v1[e] *= (float)g[4 + e]; }
                    *(u32x4*)(OAB + (size_t)row * 2048 + col) = pack8(v0, v1); }
            }
    }
};

struct EpiY {
    static constexpr int PROF_ID = 46;
    h16* Y; float* SSY;
    __device__ __forceinline__ void operator()(const f32x4 (&acc)[2][2][4][2], const Unit& u, int wr, int wc, int fr_in, int fq_in) const {
        int fr = fr_in, fq = fq_in; asm volatile("" : "+v"(fr), "+v"(fq));
#pragma unroll
        for (int ai = 0; ai < 2; ++ai)
#pragma unroll
            for (int m = 0; m < 4; ++m) {
                const int row = u.pm * 256 + ai * 128 + wr * 64 + m * 16 + fr;
                float s = 0.f;
#pragma unroll
                for (int bj = 0; bj < 2; ++bj) { const f32x4 v0 = acc[ai][bj][m][0], v1 = acc[ai][bj][m][1];
                    s += (v0[0] * v0[0] + v0[1] * v0[1]) + (v0[2] * v0[2] + v0[3] * v0[3]) + (v1[0] * v1[0] + v1[1] * v1[1]) + (v1[2] * v1[2] + v1[3] * v1[3]);
                    *(u32x4*)(Y + (size_t)row * 2048 + u.pn * 256 + bj * 128 + wc * 32 + fq * 8) = pack8(v0, v1); }
                s += __shfl_xor(s, 16); s += __shfl_xor(s, 32);
                if (fq == 0) SSY[(size_t)row * 32 + u.pn * 4 + wc] = s;
            }
    }
};


__device__ __forceinline__ void p0_mod_unit(const Params& P, int unit, LAS unsigned char* lds) {
    const int tid = threadIdx.x, lane = tid & 63, w = tid >> 6, kc = unit >> 5, cc = unit & 31;
    LAS float* sc = (LAS float*)lds;
    LAS float* red = (LAS float*)(lds + 4096);
    for (int i = tid; i < 1024; i += NTHR) { const int b = i >> 8, kk = i & 255; sc[i] = siluf(P.c[b * DM + kc * 256 + kk]); }
    __syncthreads();
    f32x4 acc[4];
#pragma unroll
    for (int b = 0; b < 4; ++b) acc[b] = (f32x4){0.f, 0.f, 0.f, 0.f};
    if (lane < 48) {
        const float* wp = P.w_ada + (size_t)(kc * 256 + w * 32) * 6144 + cc * 192 + 4 * lane;
#pragma unroll 8
        for (int i = 0; i < 32; ++i) { const f32x4 wv = *(const f32x4*)(wp + (size_t)i * 6144);
#pragma unroll
            for (int b = 0; b < 4; ++b) acc[b] += wv * sc[b * 256 + w * 32 + i]; }
#pragma unroll
        for (int b = 0; b < 4; ++b) *(LAS f32x4*)(red + (w * 4 + b) * 192 + 4 * lane) = acc[b];
    }
    __syncthreads();
    float* MODP = (float*)(P.ws + WS_MODP);
    for (int o = tid; o < 768; o += NTHR) { const int b = o / 192, j = o % 192; float s = 0.f;
#pragma unroll
        for (int ww = 0; ww < 8; ++ww) s += red[(ww * 4 + b) * 192 + j];
        MODP[(size_t)(kc * 4 + b) * 6144 + cc * 192 + j] = s; }
    __syncthreads();
}
template <class SrcCol>
__device__ __forceinline__ void transpose_item(const float* W, int ldw, const float* kscale, h16* WT, int ldt, int k0, int n0, SrcCol srccol, LAS float* scr, int lane) {
    const int n4 = 4 * (lane & 15), s = srccol(n0 + n4);
#pragma unroll 8
    for (int i = 0; i < 16; ++i) { const int k = 4 * i + (lane >> 4);
        f32x4 v = (s >= 0) ? *(const f32x4*)(W + (size_t)(k0 + k) * ldw + s) : (f32x4){0.f, 0.f, 0.f, 0.f};
        if (kscale) v = v * kscale[k0 + k];
        *(LAS f32x4*)(scr + k * 64 + (n4 ^ (((k >> 3) & 7) << 2))) = v; }
    asm volatile("s_waitcnt lgkmcnt(0)" ::: "memory");
    const int c = lane & 7;
#pragma unroll
    for (int j = 0; j < 8; ++j) { const int n = (lane >> 3) + 8 * j; const LAS float* sp = scr + (8 * c) * 64 + (n ^ (c << 2));
        u32x4 o; o.x = pk2h(sp[0 * 64], sp[1 * 64]); o.y = pk2h(sp[2 * 64], sp[3 * 64]); o.z = pk2h(sp[4 * 64], sp[5 * 64]); o.w = pk2h(sp[6 * 64], sp[7 * 64]);
        *(u32x4*)(WT + (size_t)(n0 + n) * ldt + k0 + 8 * c) = o; }
    asm volatile("s_waitcnt lgkmcnt(0)" ::: "memory");
}
struct SrcW1 { __device__ int operator()(int n) const { return n < 880 ? n : (n < 1024 ? -1 : n - 144); } };
struct SrcId { __device__ int operator()(int n) const { return n; } };
struct SrcQRope { __device__ int operator()(int n) const { return (n >> 5) * 128 + (n & 31); } };

__device__ __forceinline__ void p0_fold_unit(const Params& P, int unit, LAS unsigned char* lds) {
    const int tid = threadIdx.x, h = unit >> 5, kb = (unit >> 2) & 7, rq = unit & 3;
    LAS float* wuk = (LAS float*)lds;
    LAS float* wuq = (LAS float*)(lds + 24576);
    for (int i = tid; i < 96 * 64; i += NTHR) { const int nn = i >> 6, r = i & 63; wuk[i] = P.w_uk[((size_t)h * 96 + nn) * 256 + rq * 64 + r]; }
    for (int i = tid; i < 64 * 96; i += NTHR) { const int k = i / 96, nn = i % 96; wuq[i] = P.w_uq[(size_t)(kb * 64 + k) * 1024 + h * 128 + 32 + nn]; }
    __syncthreads();
    const int r = tid & 63, kg = __builtin_amdgcn_readfirstlane(tid >> 6);
    float acc[8];
#pragma unroll
    for (int i = 0; i < 8; ++i) acc[i] = 0.f;
#pragma unroll 4
    for (int nn = 0; nn < 96; ++nn) { const float bv = wuk[nn * 64 + r];
#pragma unroll
        for (int i = 0; i < 8; ++i) acc[i] += wuq[(kg * 8 + i) * 96 + nn] * bv; }
    h16* dst = (h16*)(P.ws + WS_WQT) + (size_t)(256 + h * 256 + rq * 64 + r) * 512 + kb * 64 + kg * 8;
    const float* gq = P.g_q + kb * 64 + kg * 8;
    u32x4 o; o.x = pk2h(acc[0] * gq[0], acc[1] * gq[1]); o.y = pk2h(acc[2] * gq[2], acc[3] * gq[3]); o.z = pk2h(acc[4] * gq[4], acc[5] * gq[5]); o.w = pk2h(acc[6] * gq[6], acc[7] * gq[7]);
    *(u32x4*)dst = o;
    __syncthreads();
}
__device__ __forceinline__ void phase_prologue(const Params& P, LAS unsigned char* lds) {
    const int tid = threadIdx.x, lane = tid & 63, w = tid >> 6, G = gridDim.x, bid = blockIdx.x;
    for (int u = bid; u < 256; u += G) p0_mod_unit(P, u, lds);
    for (int u = bid; u < 256; u += G) p0_fold_unit(P, u, lds);
    {
        float* r32 = (float*)(P.ws + WS_ROPE32); float* r16 = (float*)(P.ws + WS_ROPE16);
        for (int e = bid * NTHR + tid; e < SEQ * 24; e += G * NTHR) {
            const int pos = e / 24, i = e % 24;
            const float inv = (i < 16) ? (float)pow(500000.0, -(double)i / 16.0) : (float)pow(500000.0, -(double)(i - 16) / 8.0);
            const float ang = (float)pos * inv;
            const float cv = (float)cos((double)ang), sv = (float)sin((double)ang);
            if (i < 16) { r32[((size_t)pos * 16 + i) * 2] = cv; r32[((size_t)pos * 16 + i) * 2 + 1] = sv; }
            else { r16[((size_t)pos * 8 + (i - 16)) * 2] = cv; r16[((size_t)pos * 8 + (i - 16)) * 2 + 1] = sv; }
        }
    }
    {
        h16* WUVT = (h16*)(P.ws + WS_WUVT);
        for (int e = bid * NTHR + tid; e < 1024 * 32; e += G * NTHR) { const int n = e >> 5, c8 = e & 31, hh = n >> 7; const int k = ((hh & 1) ? 0 : 256) + c8 * 8;
            *(u32x4*)(WUVT + (size_t)n * 512 + k) = (u32x4){0u, 0u, 0u, 0u}; }
    }
    LAS float* scr = (LAS float*)(lds + w * 16384);
    const int gw = bid * NWAVE + w, NGW = G * NWAVE;
    constexpr int I_W1 = 32 * 96, I_QR = 8 * 4, I_QI = 8 * 16, I_UV = 8 * 4 * 2, I_WO = 32 * 32;
    for (int it = gw; it < I_W1 + I_QR + I_QI + I_UV + I_WO; it += NGW) {
        int r = it;
        if (r < I_W1) { transpose_item(P.w_in, 6000, nullptr, (h16*)(P.ws + WS_W1T), 2048, (r / 96) * 64, (r % 96) * 64, SrcW1(), scr, lane); continue; } r -= I_W1;
        if (r < I_QR) { transpose_item(P.w_uq, 1024, P.g_q, (h16*)(P.ws + WS_WQT), 512, (r / 4) * 64, (r % 4) * 64, SrcQRope(), scr, lane); continue; } r -= I_QR;
        if (r < I_QI) { transpose_item(P.w_uq_idx, 1024, P.g_q, (h16*)(P.ws + WS_WQT) + (size_t)2304 * 512, 512, (r / 16) * 64, (r % 16) * 64, SrcId(), scr, lane); continue; } r -= I_QI;
        if (r < I_UV) { const int hh = r >> 3, kb = (r >> 1) & 3, nb = r & 1;
            transpose_item(P.w_uv + (size_t)hh * 256 * 128, 128, nullptr, (h16*)(P.ws + WS_WUVT) + (size_t)(hh * 128) * 512 + 256 * (hh & 1), 512, kb * 64, nb * 64, SrcId(), scr, lane); continue; } r -= I_UV;
        transpose_item(P.w_out, 2048, nullptr, (h16*)(P.ws + WS_WOT), 2048, (r / 32) * 64, (r % 32) * 64, SrcId(), scr, lane);
    }
}

__device__ __forceinline__ void load_mod(const Params& P, int b, int off, LAS float* dst, bool plus1) {
    const float* MODP = (const float*)(P.ws + WS_MODP);
    for (int j = threadIdx.x; j < 2048; j += NTHR) { float s = P.b_ada[off + j];
#pragma unroll
        for (int kc = 0; kc < 8; ++kc) s += MODP[(size_t)(kc * 4 + b) * 6144 + off + j];
        dst[j] = plus1 ? 1.0f + s : s; }
}
__device__ __forceinline__ void phase_h(const Params& P, LAS unsigned char* lds) {
    const int tid = threadIdx.x, lane = tid & 63, w = tid >> 6;
    LAS float* shift = (LAS float*)lds; LAS float* scale1 = (LAS float*)(lds + 8192);
    h16* H = (h16*)(P.ws + WS_H);
    for (int ch = blockIdx.x; ch < 256; ch += gridDim.x) {
        const int b = ch >> 6;
        __syncthreads();
        load_mod(P, b, 0, shift, false); load_mod(P, b, 2048, scale1, true);
        __syncthreads();
        for (int i = 0; i < 8; ++i) {
            const int row = ch * 64 + w * 8 + i;
            const float* xr = P.x + (size_t)row * DM + 4 * lane;
            f32x4 v[8]; float ss = 0.f;
#pragma unroll
            for (int j = 0; j < 8; ++j) { v[j] = *(const f32x4*)(xr + 256 * j); ss += (v[j][0] * v[j][0] + v[j][1] * v[j][1]) + (v[j][2] * v[j][2] + v[j][3] * v[j][3]); }
            const float rstd = 1.0f / sqrtf(wave_sum(ss) * (1.0f / DM) + EPS);
#pragma unroll
            for (int j = 0; j < 8; ++j) { const int col = 4 * lane + 256 * j; const f32x4 g = *(const f32x4*)(P.g_pre + col);
                const f32x4 s1 = *(const LAS f32x4*)(scale1 + col), sh = *(const LAS f32x4*)(shift + col);
                const f32x4 o = v[j] * rstd * g * s1 + sh; u32x2 pk; pk.x = pk2h(o[0], o[1]); pk.y = pk2h(o[2], o[3]);
                *(u32x2*)(H + (size_t)row * DM + col) = pk; }
        }
    }
}
__device__ __forceinline__ void phase_rowops(const Params& P) {
    const int tid = threadIdx.x, lane = tid & 63, w = tid >> 6;
    h16* KVC = (h16*)(P.ws + WS_KVC); h16* KIDX = (h16*)(P.ws + WS_KIDX); float* WIDX = (float*)(P.ws + WS_WIDX);
    const float* SMALL = (const float*)(P.ws + WS_SMALL); const float* r32 = (const float*)(P.ws + WS_ROPE32); const float* r16 = (const float*)(P.ws + WS_ROPE16);
    for (int row = blockIdx.x * NWAVE + w; row < T; row += gridDim.x * NWAVE) {
        const int pos = row & (SEQ - 1);
        h16* kr = KVC + (size_t)row * KVW;
        const h16x4 raw = *(const h16x4*)(kr + 4 * lane);
        float v[4]; float ss = 0.f;
#pragma unroll
        for (int e = 0; e < 4; ++e) { v[e] = (float)raw[e]; ss += v[e] * v[e]; }
        const float rstd = 1.0f / sqrtf(wave_sum(ss) * (1.0f / 256.0f) + EPS);
        const f32x4 g = *(const f32x4*)(P.g_kv + 4 * lane);
        u32x2 pk; pk.x = pk2h(v[0] * rstd * g[0], v[1] * rstd * g[1]); pk.y = pk2h(v[2] * rstd * g[2], v[3] * rstd * g[3]);
        *(u32x2*)(kr + 4 * lane) = pk;
        const float* sm = SMALL + (size_t)row * 128;
        if (lane < 32) {
            const int i = lane & 15; const float x1 = sm[i], x2 = sm[i + 16]; const float cv = r32[((size_t)pos * 16 + i) * 2], sv = r32[((size_t)pos * 16 + i) * 2 + 1];
            kr[256 + lane] = (h16)(lane < 16 ? x1 * cv - x2 * sv : x2 * cv + x1 * sv);
        }
        {
            float o = sm[32 + lane];
            if (lane < 16) { const int i = lane & 7; const float x1 = sm[32 + i], x2 = sm[32 + i + 8]; const float cv = r16[((size_t)pos * 8 + i) * 2], sv = r16[((size_t)pos * 8 + i) * 2 + 1];
                o = lane < 8 ? x1 * cv - x2 * sv : x2 * cv + x1 * sv; }
            KIDX[(size_t)row * 64 + lane] = (h16)o;
        }
        if (lane < 16) WIDX[(size_t)row * 16 + lane] = sm[96 + lane] * (1.0f / 32.0f);
    }
}
__device__ __forceinline__ void phase_final(const Params& P, LAS unsigned char* lds) {
    const int tid = threadIdx.x, lane = tid & 63, w = tid >> 6;
    LAS float* gate = (LAS float*)lds;
    const h16* Y = (const h16*)(P.ws + WS_Y); const float* SSY = (const float*)(P.ws + WS_SSY);
    for (int ch = blockIdx.x; ch < 256; ch += gridDim.x) {
        const int b = ch >> 6;
        __syncthreads();
        load_mod(P, b, 4096, gate, false);
        __syncthreads();
        for (int i = 0; i < 8; i += 2) {
            const int row0 = ch * 64 + w * 8 + i;
            float ss = SSY[(size_t)row0 * 32 + lane];
#pragma unroll
            for (int o = 1; o < 32; o <<= 1) ss += __shfl_xor(ss, o);
            const float rstd_mine = __builtin_amdgcn_rsqf(ss * (1.0f / DM) + EPS);
            const float rstd0 = __shfl(rstd_mine, 0), rstd1 = __shfl(rstd_mine, 32);
            f32x4 xv[2][8]; h16x4 yv[2][8];
#pragma unroll
            for (int rr = 0; rr < 2; ++rr)
#pragma unroll
                for (int j = 0; j < 8; ++j) { const int col = 4 * lane + 256 * j;
                    xv[rr][j] = __builtin_nontemporal_load((const f32x4*)(P.x + (size_t)(row0 + rr) * DM + col)); yv[rr][j] = *(const h16x4*)(Y + (size_t)(row0 + rr) * DM + col); }
#pragma unroll
            for (int rr = 0; rr < 2; ++rr) { const float rstd = rr ? rstd1 : rstd0;
#pragma unroll
                for (int j = 0; j < 8; ++j) { const int col = 4 * lane + 256 * j;
                    const f32x4 g = *(const f32x4*)(P.g_post + col), gt = *(const LAS f32x4*)(gate + col);
                    f32x4 o;
#pragma unroll
                    for (int e = 0; e < 4; ++e) o[e] = xv[rr][j][e] + gt[e] * ((float)yv[rr][j][e] * rstd * g[e]);
                    __builtin_nontemporal_store(o, (f32x4*)(P.out + (size_t)(row0 + rr) * DM + col)); } }
        }
    }
}


__device__ __forceinline__ void phase_dilated_naive(const Params& P, LAS unsigned char* lds) {
    const int tid = threadIdx.x, lane = tid & 63, w = tid >> 6;
    LAS float* qs = (LAS float*)(lds + w * 2560); LAS float* ps = qs + 128;
    const h16* QB = (const h16*)(P.ws + WS_QB); const h16* KB = (const h16*)(P.ws + WS_KB); const h16* VB = (const h16*)(P.ws + WS_VB); const h16* SGB = (const h16*)(P.ws + WS_SGB);
    h16* OAB = (h16*)(P.ws + WS_OAB);
    for (int item = blockIdx.x * NWAVE + w; item < T * 8; item += gridDim.x * NWAVE) {
        const int row = item >> 3, h = item & 7, b = row >> 12, t = row & (SEQ - 1);
        { const h16x2 q2 = *(const h16x2*)(QB + (size_t)row * 1024 + h * 128 + 2 * lane); qs[2 * lane] = (float)q2[0]; qs[2 * lane + 1] = (float)q2[1]; }
        float sv[7]; float mx = -INFINITY;
#pragma unroll
        for (int i = 0; i < 7; ++i) {
            const int e = lane + 64 * i; sv[i] = -INFINITY;
            if (e < 387) { const int c = e / 129, j = e % 129, dil = c == 0 ? 1 : (c == 1 ? 4 : 16), kt = t - j * dil;
                if (kt >= 0) { const h16* kr = KB + (size_t)(b * SEQ + kt) * 1024 + h * 128; float s = 0.f;
                    for (int d = 0; d < 128; d += 8) { const h16x8 kv = *(const h16x8*)(kr + d);
#pragma unroll
                        for (int x = 0; x < 8; ++x) s += qs[d + x] * (float)kv[x]; }
                    sv[i] = s; } }
            mx = fmaxf(mx, sv[i]);
        }
        mx = wave_max(mx);
        float sum = 0.f;
#pragma unroll
        for (int i = 0; i < 7; ++i) { const int e = lane + 64 * i; const float p = (sv[i] == -INFINITY) ? 0.f : exp2f(sv[i] - mx); sum += p; if (e < 392) ps[e] = p; }
        sum = wave_sum(sum);
        float a0 = 0.f, a1 = 0.f;
        for (int e = 0; e < 387; ++e) { const int c = e / 129, j = e % 129, dil = c == 0 ? 1 : (c == 1 ? 4 : 16), kt = t - j * dil;
            if (kt >= 0) { const float p = ps[e]; const h16x2 v2 = *(const h16x2*)(VB + (size_t)(b * SEQ + kt) * 1024 + h * 128 + 2 * lane); a0 += p * (float)v2[0]; a1 += p * (float)v2[1]; } }
        const float inv = 1.0f / sum;
        const h16x2 g2 = *(const h16x2*)(SGB + (size_t)row * 1024 + h * 128 + 2 * lane);
        const h16x2 o2 = {(h16)(a0 * inv * (float)g2[0]), (h16)(a1 * inv * (float)g2[1])};
        *(h16x2*)(OAB + (size_t)row * 2048 + 1024 + h * 128 + 2 * lane) = o2;
    }
}

constexpr int SP_PITCH = 592;
constexpr int SP_BUF = 32 * SP_PITCH;
constexpr int SP_LIST = 8 * SP_BUF;
__device__ __forceinline__ void sparse_attn_query(const Params& P, LAS unsigned char* lds, int wid, int lane, int b, int row, int kvalid, const LAS unsigned short* list);
__device__ __forceinline__ void phase_dsa_naive(const Params& P, LAS unsigned char* lds) {
    const int tid = threadIdx.x, lane = tid & 63, w = tid >> 6;
    LAS float* sc = (LAS float*)lds;
    LAS float* qv = (LAS float*)(lds + 131072);
    LAS float* wv = qv + 1024;
    const h16* QIDX = (const h16*)(P.ws + WS_QIDX); const h16* KIDX = (const h16*)(P.ws + WS_KIDX); const float* WIDX = (const float*)(P.ws + WS_WIDX);
    const h16* QLAT = (const h16*)(P.ws + WS_QLAT); const h16* QROPE = (const h16*)(P.ws + WS_QROPE); const h16* KVC = (const h16*)(P.ws + WS_KVC); h16* OLAT = (h16*)(P.ws + WS_OLAT);
    for (int item = blockIdx.x; item < T / 8; item += gridDim.x) {
        const int row0 = item * 8, b = row0 >> 12;
        for (int qi = 0; qi < 8; ++qi) {
            const int row = row0 + qi, t = row & (SEQ - 1);
            __syncthreads();
            for (int i = tid; i < 1024; i += NTHR) qv[i] = (float)QIDX[(size_t)row * 1024 + i];
            if (tid < 16) wv[tid] = WIDX[(size_t)row * 16 + tid];
            __syncthreads();
            for (int k = tid; k <= t; k += NTHR) {
                float kf[64];
                const h16* kr = KIDX + (size_t)(b * SEQ + k) * 64;
#pragma unroll
                for (int d = 0; d < 64; d += 8) { const h16x8 kv = *(const h16x8*)(kr + d);
#pragma unroll
                    for (int x = 0; x < 8; ++x) kf[d + x] = (float)kv[x]; }
                float acc = 0.f;
                for (int h = 0; h < 16; ++h) { float dt = 0.f;
#pragma unroll
                    for (int d = 0; d < 64; ++d) dt += qv[h * 64 + d] * kf[d];
                    acc += wv[h] * fmaxf(dt, 0.f); }
                sc[qi * SEQ + k] = acc + 0.0f;
            }
        }
        __syncthreads();
        {
            const int row = row0 + w, t = row & (SEQ - 1), n = t + 1;
            LAS float* myrow = sc + w * SEQ;
            LAS unsigned short* idxs = (LAS unsigned short*)(lds + SP_LIST) + w * 256;
            if (n <= 256) {
#pragma unroll
                for (int i = 0; i < 4; ++i) { const int k = lane + 64 * i; idxs[k] = (k < n) ? (unsigned short)k : (unsigned short)0xFFFFu; }
            } else {
                const LAS unsigned* ur = (const LAS unsigned*)myrow;
                const int ni = (n + 63) >> 6;
                auto key = [&](int i) -> unsigned { const int k = 64 * i + lane; const unsigned bits = ur[k]; const unsigned u = (bits & 0x80000000u) ? ~bits : (bits | 0x80000000u); return (k < n) ? u : 0u; };
                unsigned thr = 0u;
                for (int bit = 31; bit >= 0; --bit) {
                    const unsigned cand = thr | (1u << bit); int cnt = 0;
                    for (int i = 0; i < ni; ++i) cnt += __popcll(__ballot(key(i) >= cand));
                    if (cnt >= 256) thr = cand;
                }
                int cgt = 0;
                for (int i = 0; i < ni; ++i) cgt += __popcll(__ballot(key(i) > thr));
                const int need_eq = 256 - cgt;
                int base = 0, eqb = 0;
                for (int i = 0; i < ni; ++i) { const unsigned u = key(i); const bool eq = u == thr; const unsigned long long me = __ballot(eq);
                    const int eqr = eqb + __popcll(me & ((1ull << lane) - 1ull));
                    const bool sel = u > thr || (eq && eqr < need_eq); const unsigned long long mk = __ballot(sel);
                    const int pos = base + __popcll(mk & ((1ull << lane) - 1ull));
                    if (sel && pos < 256) idxs[pos] = (unsigned short)(64 * i + lane);
                    base += __popcll(mk); eqb += __popcll(me); }
            }
        }
        __syncthreads();
        { const int row = row0 + w, t = row & (SEQ - 1); sparse_attn_query(P, lds, w, lane, b, row, (t + 1 < 256) ? t + 1 : 256, (const LAS unsigned short*)(lds + SP_LIST) + w * 256); }
        __syncthreads();
    }
}

typedef float f32x16 __attribute__((ext_vector_type(16)));
typedef short s16x4 __attribute__((ext_vector_type(4)));
__device__ __forceinline__ unsigned imgb_off(unsigned row, unsigned ch) { return 256u * row + 16u * (ch ^ (((row & 3u) << 2) | ((row >> 2) & 3u))); }
constexpr int DIL_STG = 98304, DIL_LSE = DIL_STG + 8 * 4608;
__device__ __forceinline__ void dil_load(u32x4 (&rg)[12], const h16* src_bh, int m0, int dil, int res, int tid) {
#pragma unroll
    for (int p = 0; p < 12; ++p) {
        const int kk = p * 32 + (tid >> 4); int j = m0 - 128 + kk; j = j < 0 ? 0 : j;
        const unsigned sw = (unsigned)(((kk & 3) << 2) | ((kk >> 2) & 3));
        rg[p] = *(const u32x4*)(src_bh + (size_t)(j * dil + res) * 1024 + 8 * ((unsigned)(tid & 15) ^ sw));
    }
}
__device__ __forceinline__ void dil_write(LAS unsigned char* lds, const u32x4 (&rg)[12], int tid) {
#pragma unroll
    for (int p = 0; p < 12; ++p) *(LAS u32x4*)(lds + p * 8192 + tid * 16) = rg[p];
}
struct DilUnit { int dil, pslot, b, h, res, blk; };
template <bool LAST>
__device__ __forceinline__ void dilated_unit(const Params& P, LAS unsigned char* lds, const DilUnit u, u32x4 (&kv)[12], const DilUnit nxt, bool has_next) {
    const int dil = u.dil, pslot = u.pslot, b = u.b, h = u.h, res = u.res, blk = u.blk;
    const int tid = threadIdx.x, lane = tid & 63, wid = __builtin_amdgcn_readfirstlane(tid >> 6), n = lane & 31, hi = lane >> 5;
    const int m0 = blk * 256;
    const size_t bh = (size_t)b * SEQ * 1024 + h * 128;
    const h16* QBp = (const h16*)(P.ws + WS_QB) + bh; const h16* VBp = (const h16*)(P.ws + WS_VB) + bh;
    PROF_B(10);
    dil_write(lds, kv, tid);
    dil_load(kv, VBp, m0, dil, res, tid);
    h16x8 qf[8];
    { const h16* qp = QBp + (size_t)((m0 + 32 * wid + n) * dil + res) * 1024 + 8 * hi;
#pragma unroll
      for (int ks = 0; ks < 8; ++ks) qf[ks] = *(const h16x8*)(qp + 16 * ks); }
    __syncthreads();
    PROF_E(10); PROF_B(11);
    f32x16 sa[5];
#pragma unroll
    for (int ti = 0; ti < 5; ++ti) {
#pragma unroll
        for (int r = 0; r < 16; ++r) sa[ti][r] = 0.f;
#pragma unroll
        for (int ks = 0; ks < 8; ++ks) { const h16x8 kf = *(const LAS h16x8*)(lds + imgb_off(32 * (wid + ti) + n, 2 * ks + hi));
            sa[ti] = __builtin_amdgcn_mfma_f32_32x32x16_f16(kf, qf[ks], sa[ti], 0, 0, 0); }
    }
    PROF_E(11); PROF_B(12);
    const int jmin = 128 - m0;
    float mx = -INFINITY;
#pragma unroll
    for (int ti = 0; ti < 5; ++ti)
#pragma unroll
        for (int r = 0; r < 16; ++r) { const int kin = (r & 3) + 8 * (r >> 2) + 4 * hi; bool ok = (32 * (wid + ti) + kin) >= jmin;
            if (ti == 0) ok = ok && (kin >= n); if (ti == 4) ok = ok && (kin <= n);
            const float s = ok ? sa[ti][r] : -INFINITY; sa[ti][r] = s; mx = fmaxf(mx, s); }
    mx = fmaxf(mx, __shfl_xor(mx, 32));
    float l = 0.f;
#pragma unroll
    for (int ti = 0; ti < 5; ++ti)
#pragma unroll
        for (int r = 0; r < 16; ++r) { const float p = __builtin_amdgcn_exp2f(sa[ti][r] - mx); sa[ti][r] = p; l += p; }
    l += __shfl_xor(l, 32);
    h16x8 pf[5][2];
#pragma unroll
    for (int ti = 0; ti < 5; ++ti)
#pragma unroll
        for (int s = 0; s < 2; ++s)
#pragma unroll
            for (int jj = 0; jj < 8; ++jj) pf[ti][s][jj] = (h16)sa[ti][8 * s + jj];
    PROF_E(12); PROF_B(13);
    __syncthreads();
    dil_write(lds, kv, tid);
    if (has_next) dil_load(kv, (const h16*)(P.ws + WS_KB) + (size_t)nxt.b * SEQ * 1024 + nxt.h * 128, nxt.blk * 256, nxt.dil, nxt.res, tid);
    __syncthreads();
    PROF_E(13); PROF_B(14);
    f32x16 oa[4];
#pragma unroll
    for (int c = 0; c < 4; ++c)
#pragma unroll
        for (int r = 0; r < 16; ++r) oa[c][r] = 0.f;
    const int dgrp = (lane >> 4) & 1, q4 = (lane & 15) >> 2, p4 = lane & 3;
#pragma unroll
    for (int ti = 0; ti < 5; ++ti)
#pragma unroll
        for (int s = 0; s < 2; ++s) {
#pragma unroll
            for (int c = 0; c < 4; ++c) {
                const unsigned row0 = 32 * (wid + ti) + 16 * s + 4 * hi + q4, ch = 4 * c + 2 * dgrp + (p4 >> 1);
                const s16x4 t0 = __builtin_amdgcn_ds_read_tr16_b64_v4i16((LAS s16x4*)(lds + imgb_off(row0, ch) + 8 * (p4 & 1)));
                const s16x4 t1 = __builtin_amdgcn_ds_read_tr16_b64_v4i16((LAS s16x4*)(lds + imgb_off(row0 + 8, ch) + 8 * (p4 & 1)));
                typedef short s16x8 __attribute__((ext_vector_type(8)));
                const s16x8 v8 = {t0[0], t0[1], t0[2], t0[3], t1[0], t1[1], t1[2], t1[3]};
                oa[c] = __builtin_amdgcn_mfma_f32_32x32x16_f16(__builtin_bit_cast(h16x8, v8), pf[ti][s], oa[c], 0, 0, 0);
            }
        }
    PROF_E(14); PROF_B(15);
    const float invl = 1.0f / l, lse = mx + __builtin_amdgcn_logf(l);
    LAS unsigned char* stg = lds + DIL_STG + wid * 4608;
    LAS float* lsew = (LAS float*)(lds + DIL_LSE) + wid * 32;
    float* LSEP = (float*)(P.ws + WS_LSEP);
    const int pos_n = (m0 + 32 * wid + n) * dil + res;
    if (LAST) { if (hi == 0) lsew[n] = lse; }
    else if (hi == 0) LSEP[((size_t)pslot * T + (size_t)b * SEQ + pos_n) * 8 + h] = lse;
#pragma unroll
    for (int half = 0; half < 2; ++half) {
#pragma unroll
        for (int cc = 0; cc < 2; ++cc)
#pragma unroll
            for (int rg = 0; rg < 4; ++rg) { const f32x16& o = oa[2 * half + cc]; u32x2 w2; w2.x = pk2h(o[4 * rg] * invl, o[4 * rg + 1] * invl); w2.y = pk2h(o[4 * rg + 2] * invl, o[4 * rg + 3] * invl);
                *(LAS u32x2*)(stg + n * 144 + 2 * (32 * cc + 8 * rg + 4 * hi)) = w2; }
        h16x8 m4[4], m16[4], mg[4]; float ml4[4], ml16[4];
        if (LAST) {
#pragma unroll
            for (int i = 0; i < 4; ++i) { const int rowl = (lane >> 3) + 8 * i; const size_t grow = (size_t)b * SEQ + (size_t)((m0 + 32 * wid + rowl) * dil + res); const size_t coff = (size_t)h * 128 + 64 * half + 8 * (lane & 7);
                m4[i] = *(const h16x8*)((const h16*)(P.ws + WS_OP4) + grow * 1024 + coff); m16[i] = *(const h16x8*)((const h16*)(P.ws + WS_OP16) + grow * 1024 + coff);
                mg[i] = *(const h16x8*)((const h16*)(P.ws + WS_SGB) + grow * 1024 + coff); ml4[i] = LSEP[grow * 8 + h]; ml16[i] = LSEP[((size_t)T + grow) * 8 + h]; }
        }
        asm volatile("s_waitcnt lgkmcnt(0)" ::: "memory");
#pragma unroll
        for (int i = 0; i < 4; ++i) {
            const int rowl = (lane >> 3) + 8 * i, ch = lane & 7;
            const u32x4 v = *(const LAS u32x4*)(stg + rowl * 144 + 16 * ch);
            const size_t grow = (size_t)b * SEQ + (size_t)((m0 + 32 * wid + rowl) * dil + res);
            const size_t coff = (size_t)h * 128 + 64 * half + 8 * ch;
            if (!LAST) { *(u32x4*)((h16*)(P.ws + (pslot ? WS_OP16 : WS_OP4)) + grow * 1024 + coff) = v; }
            else {
                const float l1 = lsew[rowl], l4 = ml4[i], l16 = ml16[i];
                const float mm = fmaxf(l1, fmaxf(l4, l16));
                const float w1 = __builtin_amdgcn_exp2f(l1 - mm), w4 = __builtin_amdgcn_exp2f(l4 - mm), w16 = __builtin_amdgcn_exp2f(l16 - mm), iw = 1.0f / (w1 + w4 + w16);
                const h16x8 o1 = __builtin_bit_cast(h16x8, v);
                float r8[8];
#pragma unroll
                for (int e = 0; e < 8; ++e) r8[e] = (w1 * (float)o1[e] + w4 * (float)m4[i][e] + w16 * (float)m16[i][e]) * iw * (float)mg[i][e];
                u32x4 ov; ov.x = pk2h(r8[0], r8[1]); ov.y = pk2h(r8[2], r8[3]); ov.z = pk2h(r8[4], r8[5]); ov.w = pk2h(r8[6], r8[7]);
                *(u32x4*)((h16*)(P.ws + WS_OAB) + grow * 2048 + 1024 + coff) = ov;
            }
        }
        asm volatile("s_waitcnt lgkmcnt(0)" ::: "memory");
    }
    __syncthreads();
    PROF_E(15);
}
__device__ __forceinline__ DilUnit dil_part_unit(int idx) {
    const int cfg = idx >> 9, w_ = idx & 511, xcd = w_ & 7, lu = w_ >> 3, bhh = xcd * 4 + (lu >> 4), rb = lu & 15;
    DilUnit u; u.b = bhh >> 3; u.h = bhh & 7;
    if (cfg == 0) { u.dil = 4; u.pslot = 0; u.res = rb & 3; u.blk = rb >> 2; } else { u.dil = 16; u.pslot = 1; u.res = rb; u.blk = 0; }
    return u;
}
__device__ __forceinline__ DilUnit dil_last_unit(int idx) {
    const int xcd = idx & 7, lu = idx >> 3, bhh = xcd * 4 + (lu >> 4);
    DilUnit u; u.b = bhh >> 3; u.h = bhh & 7; u.dil = 1; u.pslot = 0; u.res = 0; u.blk = lu & 15;
    return u;
}
__device__ __forceinline__ void phase_dilated_part(const Params& P, LAS unsigned char* lds) {
    int idx = blockIdx.x; if (idx >= 1024) return;
    u32x4 kv[12];
    DilUnit u = dil_part_unit(idx);
    dil_load(kv, (const h16*)(P.ws + WS_KB) + (size_t)u.b * SEQ * 1024 + u.h * 128, u.blk * 256, u.dil, u.res, threadIdx.x);
    for (;;) {
        const int nidx = idx + gridDim.x; const bool hn = nidx < 1024; const DilUnit nu = dil_part_unit(hn ? nidx : idx);
        dilated_unit<false>(P, lds, u, kv, nu, hn);
        if (!hn) break;
        idx = nidx; u = nu;
    }
}
__device__ __forceinline__ void phase_dilated_last(const Params& P, LAS unsigned char* lds) {
    int idx = blockIdx.x; if (idx >= 512) return;
    u32x4 kv[12];
    DilUnit u = dil_last_unit(idx);
    dil_load(kv, (const h16*)(P.ws + WS_KB) + (size_t)u.b * SEQ * 1024 + u.h * 128, u.blk * 256, u.dil, u.res, threadIdx.x);
    for (;;) {
        const int nidx = idx + gridDim.x; const bool hn = nidx < 512; const DilUnit nu = dil_last_unit(hn ? nidx : idx);
        dilated_unit<true>(P, lds, u, kv, nu, hn);
        if (!hn) break;
        idx = nidx; u = nu;
    }
}

__device__ __forceinline__ void sparse_attn_query(const Params& P, LAS unsigned char* lds, int wid, int lane_in, int b, int row, int kvalid, const LAS unsigned short* list) {
    int lane = lane_in; asm volatile("" : "+v"(lane));
    LAS unsigned char* buf = lds + wid * SP_BUF;
    const int n = lane & 15, g = lane >> 4, q4 = n >> 2, p4 = n & 3, sub = lane >> 2, c4 = lane & 3;
    PROF_B(30);
    h16x8 qf[9];
    {
        const h16* ql = (const h16*)(P.ws + WS_QLAT) + ((size_t)row * 8 + (n & 7)) * 256 + 8 * g;
        const h16* qr = (const h16*)(P.ws + WS_QROPE) + ((size_t)row * 8 + (n & 7)) * 32 + 8 * g;
        const h16x8 z = {(h16)0.f, (h16)0.f, (h16)0.f, (h16)0.f, (h16)0.f, (h16)0.f, (h16)0.f, (h16)0.f};
#pragma unroll
        for (int ks = 0; ks < 8; ++ks) { const h16x8 v = *(const h16x8*)(ql + 32 * ks); qf[ks] = (n < 8) ? v : z; }
        { const h16x8 v = *(const h16x8*)qr; qf[8] = (n < 8) ? v : z; }
    }
    f32x4 oacc[16];
#pragma unroll
    for (int dt = 0; dt < 16; ++dt) oacc[dt] = (f32x4){0.f, 0.f, 0.f, 0.f};
    float m = -INFINITY, l = 0.f;
    const unsigned char* kvb = P.ws + WS_KVC + (size_t)b * SEQ * (KVW * 2) + 16 * c4;
    u32x4 stg[18];
#define SP_ISSUE(step_) do { unsigned i0 = list[32 * (step_) + sub], i1 = list[32 * (step_) + 16 + sub]; i0 = (i0 == 0xFFFFu) ? 0u : i0; i1 = (i1 == 0xFFFFu) ? 0u : i1; \
        const unsigned char* r0 = kvb + (size_t)i0 * 576; const unsigned char* r1 = kvb + (size_t)i1 * 576; \
        _Pragma("unroll") for (int cg = 0; cg < 9; ++cg) { stg[2 * cg] = *(const u32x4*)(r0 + 64 * cg); stg[2 * cg + 1] = *(const u32x4*)(r1 + 64 * cg); } } while (0)
    SP_ISSUE(0);
    PROF_E(30);
    for (int step = 0; step < 8; ++step) {
        PROF_B(31);
#pragma unroll
        for (int cg = 0; cg < 9; ++cg) { *(LAS u32x4*)(buf + SP_PITCH * sub + 64 * cg + 16 * c4) = stg[2 * cg]; *(LAS u32x4*)(buf + SP_PITCH * (16 + sub) + 64 * cg + 16 * c4) = stg[2 * cg + 1]; }
        if (step < 7) SP_ISSUE(step + 1);
        asm volatile("s_waitcnt lgkmcnt(0)" ::: "memory");
        PROF_E(31); PROF_B(32);
        f32x4 s0 = (f32x4){0.f, 0.f, 0.f, 0.f}, s1 = (f32x4){0.f, 0.f, 0.f, 0.f};
#pragma unroll
        for (int ks = 0; ks < 9; ++ks) {
            const h16x8 a0 = *(const LAS h16x8*)(buf + SP_PITCH * n + 64 * ks + 16 * g), a1 = *(const LAS h16x8*)(buf + SP_PITCH * (16 + n) + 64 * ks + 16 * g);
            s0 = __builtin_amdgcn_mfma_f32_16x16x32_f16(a0, qf[ks], s0, 0, 0, 0); s1 = __builtin_amdgcn_mfma_f32_16x16x32_f16(a1, qf[ks], s1, 0, 0, 0);
        }
        PROF_E(32); PROF_B(33);
        float mx = -INFINITY;
#pragma unroll
        for (int r = 0; r < 4; ++r) { const int lp = 32 * step + 4 * g + r;
            s0[r] = (lp < kvalid) ? s0[r] : -INFINITY; s1[r] = (lp + 16 < kvalid) ? s1[r] : -INFINITY; mx = fmaxf(mx, fmaxf(s0[r], s1[r])); }
        mx = fmaxf(mx, __shfl_xor(mx, 16)); mx = fmaxf(mx, __shfl_xor(mx, 32));
        if (__builtin_amdgcn_ballot_w64(mx > m + 8.0f) != 0ull) {
            const float mnew = fmaxf(m, mx), alpha = __builtin_amdgcn_exp2f(m - mnew);
            m = mnew; l *= alpha;
#pragma unroll
            for (int dt = 0; dt < 16; ++dt) oacc[dt] = oacc[dt] * alpha;
        }
        h16x8 pf;
#pragma unroll
        for (int r = 0; r < 4; ++r) { const float p0 = __builtin_amdgcn_exp2f(s0[r] - m), p1 = __builtin_amdgcn_exp2f(s1[r] - m); l += p0 + p1; pf[r] = (h16)p0; pf[4 + r] = (h16)p1; }
        PROF_E(33); PROF_B(34);
#pragma unroll
        for (int dt = 0; dt < 16; ++dt) {
            const s16x4 t0 = __builtin_amdgcn_ds_read_tr16_b64_v4i16((LAS s16x4*)(buf + SP_PITCH * (4 * g + q4) + 32 * dt + 8 * p4));
            const s16x4 t1 = __builtin_amdgcn_ds_read_tr16_b64_v4i16((LAS s16x4*)(buf + SP_PITCH * (16 + 4 * g + q4) + 32 * dt + 8 * p4));
            typedef short s16x8 __attribute__((ext_vector_type(8)));
            const s16x8 v8 = {t0[0], t0[1], t0[2], t0[3], t1[0], t1[1], t1[2], t1[3]};
            oacc[dt] = __builtin_amdgcn_mfma_f32_16x16x32_f16(__builtin_bit_cast(h16x8, v8), pf, oacc[dt], 0, 0, 0);
        }
        asm volatile("s_waitcnt lgkmcnt(0)" ::: "memory");
        PROF_E(34);
    }
#undef SP_ISSUE
    PROF_B(35);
    l += __shfl_xor(l, 16); l += __shfl_xor(l, 32);
    const float inv = 1.0f / l;
    if (n < 8) {
        h16* op = (h16*)(P.ws + WS_OLAT) + ((size_t)row * 8 + n) * 256 + 4 * g;
#pragma unroll
        for (int dt = 0; dt < 16; ++dt) { u32x2 w2; w2.x = pk2h(oacc[dt][0] * inv, oacc[dt][1] * inv); w2.y = pk2h(oacc[dt][2] * inv, oacc[dt][3] * inv); *(u32x2*)(op + 16 * dt) = w2; }
    }
    PROF_E(35);
}

constexpr int DS_QI = 0;
constexpr int DS_WQ = 36864;
constexpr int DS_CNTB = DS_WQ + 1024;
constexpr int DS_CGT = DS_CNTB + 1024;
constexpr int DS_CEQ = DS_CGT + 512;
constexpr int DS_PCNT = DS_CEQ + 512;
constexpr int DS_TCNT = DS_PCNT + 2048;
constexpr int DS_TLIST = DS_TCNT + 64;
constexpr int DS_TSC = DS_TLIST + 2048;
constexpr int DS_TK = DS_TSC + 4096;
constexpr int DS_LIST = SP_LIST;
constexpr int TIE_CAP = 64, TIE_FAST = 16;
__device__ __forceinline__ unsigned sortable_hi16(float s) { const unsigned bits = __float_as_uint(s + 0.0f); return ((bits & 0x80000000u) ? ~bits : (bits | 0x80000000u)) >> 16; }
typedef _Float16 h16x2v __attribute__((ext_vector_type(2)));
__device__ __forceinline__ unsigned pk_count_gt(unsigned acc, unsigned v, unsigned cm1pk) {
    unsigned d;
    asm("v_pk_sub_u16 %1, %2, %3 clamp\n\tv_pk_min_u16 %1, %1, %4\n\tv_pk_add_u16 %0, %0, %1" : "+v"(acc), "=&v"(d) : "v"(v), "v"(cm1pk), "v"(0x00010001u));
    return acc;
}
__device__ __forceinline__ unsigned pk_mask_gt(unsigned m, unsigned v, unsigned cm1pk) {
    unsigned d;
    asm("v_pk_sub_u16 %1, %2, %3 clamp\n\tv_pk_min_u16 %1, %1, %4\n\tv_lshl_or_b32 %0, %0, 1, %1" : "+v"(m), "=&v"(d) : "v"(v), "v"(cm1pk), "v"(0x00010001u));
    return m;
}
__device__ __forceinline__ void dsa_score_group(LAS unsigned char* lds, const h16x8 (&kf)[4][2], int grp, int w, int q, int kq, int tq, int ntile, unsigned (&c8)[8]) {
    const unsigned sw = (unsigned)((q >> 1) & 7);
    const LAS float* WQ = (const LAS float*)(lds + DS_WQ);
    const LAS unsigned char* qrow = lds + DS_QI + q * 128;
    const unsigned o0 = 16u * ((unsigned)kq ^ sw), o1 = 16u * ((unsigned)(4 + kq) ^ sw);
    const f32x4 zero4 = {0.f, 0.f, 0.f, 0.f};
    f32x4 acc[4];
    {
        const h16x8 a0 = *(const LAS h16x8*)(qrow + 16 * 2048 + o0), a1 = *(const LAS h16x8*)(qrow + 16 * 2048 + o1), b0 = *(const LAS h16x8*)(qrow + 17 * 2048 + o0), b1 = *(const LAS h16x8*)(qrow + 17 * 2048 + o1);
#pragma unroll
        for (int j = 0; j < 4; ++j) { acc[j] = __builtin_amdgcn_mfma_f32_16x16x32_f16(kf[j][0], a0, zero4, 0, 0, 0); acc[j] = __builtin_amdgcn_mfma_f32_16x16x32_f16(kf[j][1], a1, acc[j], 0, 0, 0);
            acc[j] = __builtin_amdgcn_mfma_f32_16x16x32_f16(kf[j][0], b0, acc[j], 0, 0, 0); acc[j] = __builtin_amdgcn_mfma_f32_16x16x32_f16(kf[j][1], b1, acc[j], 0, 0, 0); }
    }
    h16x8 qn0 = *(const LAS h16x8*)(qrow + o0), qn1 = *(const LAS h16x8*)(qrow + o1); float wn = WQ[q * 16];
#pragma unroll 2
    for (int h = 0; h < 16; ++h) {
        const h16x8 q0 = qn0, q1 = qn1; const float wh = wn;
        const int hn = (h + 1) & 15;
        qn0 = *(const LAS h16x8*)(qrow + hn * 2048 + o0); qn1 = *(const LAS h16x8*)(qrow + hn * 2048 + o1); wn = WQ[q * 16 + hn];
#pragma unroll
        for (int j = 0; j < 4; ++j) { f32x4 lg = __builtin_amdgcn_mfma_f32_16x16x32_f16(kf[j][0], q0, zero4, 0, 0, 0); lg = __builtin_amdgcn_mfma_f32_16x16x32_f16(kf[j][1], q1, lg, 0, 0, 0);
#pragma unroll
            for (int r = 0; r < 4; ++r) acc[j][r] = __builtin_fmaf(__builtin_fabsf(lg[r]), wh, acc[j][r]); }
    }
    const int tt0 = w + 32 * grp;
#pragma unroll
    for (int j = 0; j < 4; ++j) { const int tt = tt0 + 8 * j; unsigned c4[4];
#pragma unroll
        for (int r = 0; r < 4; ++r) { const int k = 16 * tt + 4 * kq + r; c4[r] = (tt < ntile && k <= tq) ? sortable_hi16(acc[j][r]) : 0u; }
        c8[j * 2] = c4[0] | (c4[1] << 16); c8[j * 2 + 1] = c4[2] | (c4[3] << 16); }
}

__device__ __forceinline__ void dsa_select_unit(const Params& P, LAS unsigned char* lds, int b, int uq, int stages = 9) {
    int tid = threadIdx.x; asm volatile("" : "+v"(tid));
    const int lane = tid & 63, w = __builtin_amdgcn_readfirstlane(tid >> 6), q = lane & 15, kq = lane >> 4;
    const int t0 = 16 * uq, row0 = b * SEQ + t0, tq = t0 + q, ntile = uq + 1, Kq = (tq + 1 < 256) ? tq + 1 : 256;
    const h16* QIDX = (const h16*)(P.ws + WS_QIDX); const h16* KIDX = (const h16*)(P.ws + WS_KIDX) + (size_t)b * SEQ * 64; const float* WIDX = (const float*)(P.ws + WS_WIDX);
    LAS float* WQ = (LAS float*)(lds + DS_WQ); LAS unsigned* CNTB = (LAS unsigned*)(lds + DS_CNTB); LAS unsigned* CGT = (LAS unsigned*)(lds + DS_CGT); LAS unsigned* CEQ = (LAS unsigned*)(lds + DS_CEQ);
    LAS unsigned* PCNT = (LAS unsigned*)(lds + DS_PCNT); LAS unsigned* TCNT = (LAS unsigned*)(lds + DS_TCNT); LAS unsigned short* TLIST = (LAS unsigned short*)(lds + DS_TLIST);
    LAS float* TSC = (LAS float*)(lds + DS_TSC); LAS unsigned short* LIST = (LAS unsigned short*)(lds + DS_LIST);
    PROF_B(20);
#pragma unroll
    for (int i = 0; i < 4; ++i) { const int pc = 4 * w + i, head = pc >> 1, r = 8 * (pc & 1) + (lane >> 3), c = lane & 7;
        __builtin_amdgcn_global_load_lds((const unsigned*)(QIDX + (size_t)(row0 + r) * 1024 + head * 64 + 8 * (c ^ ((r >> 1) & 7))), (LAS unsigned*)(lds + DS_QI + pc * 1024), 16, 0, 0); }
    {
        const int r = tid >> 5, d2 = tid & 31; float a0 = 0.f, a1 = 0.f;
        const h16* qp = QIDX + (size_t)(row0 + r) * 1024 + 2 * d2; const float* wp = WIDX + (size_t)(row0 + r) * 16;
#pragma unroll
        for (int h = 0; h < 16; ++h) { const h16x2v qv = *(const h16x2v*)(qp + h * 64); const float wv = wp[h]; a0 += wv * (float)qv[0]; a1 += wv * (float)qv[1]; }
        const h16 h0 = (h16)a0, h1 = (h16)a1; const h16 l0 = (h16)(a0 - (float)h0), l1 = (h16)(a1 - (float)h1);
        const unsigned off = r * 128 + 16 * ((unsigned)(d2 >> 2) ^ (unsigned)((r >> 1) & 7)) + 4 * (d2 & 3);
        const h16x2v hv = {h0, h1}, lv = {l0, l1};
        *(LAS h16x2v*)(lds + DS_QI + 16 * 2048 + off) = hv; *(LAS h16x2v*)(lds + DS_QI + 17 * 2048 + off) = lv;
    }
    if (tid < 256) WQ[tid] = WIDX[(size_t)(row0 + (tid >> 4)) * 16 + (tid & 15)];
    if (tid < 16) TCNT[tid] = 0u;
    *(LAS u32x4*)(lds + DS_LIST + tid * 16) = (u32x4){0xFFFFFFFFu, 0xFFFFFFFFu, 0xFFFFFFFFu, 0xFFFFFFFFu};
    asm volatile("s_waitcnt vmcnt(0)" ::: "memory");
    __syncthreads();
    PROF_E(20); PROF_B(21);
    unsigned cs[64];
#pragma unroll
    for (int i = 0; i < 64; ++i) cs[i] = 0u;
    h16x8 kfA[4][2], kfB[4][2];
#define DSA_LOADK(kf, grp_) do { _Pragma("unroll") for (int j = 0; j < 4; ++j) { const int tt = w + 32 * (grp_) + 8 * j, ttc = tt < ntile ? tt : ntile - 1; \
        const h16* kp = KIDX + (size_t)(16 * ttc + q) * 64 + 8 * kq; kf[j][0] = *(const h16x8*)kp; kf[j][1] = *(const h16x8*)(kp + 32); } } while (0)
    DSA_LOADK(kfA, 0);
    for (int gp = 0; gp < 4; ++gp) {
        if (w + 64 * gp >= ntile) break;
        DSA_LOADK(kfB, 2 * gp + 1);
        unsigned ca[8], cb[8];
        dsa_score_group(lds, kfA, 2 * gp, w, q, kq, tq, ntile, ca);
        if (gp < 3) DSA_LOADK(kfA, 2 * gp + 2);
        if (w + 64 * gp + 32 < ntile) dsa_score_group(lds, kfB, 2 * gp + 1, w, q, kq, tq, ntile, cb);
        else {
#pragma unroll
            for (int i = 0; i < 8; ++i) cb[i] = 0u;
        }
#define CS_PUT(G) case G: _Pragma("unroll") for (int i = 0; i < 8; ++i) { cs[G * 16 + i] = ca[i]; cs[G * 16 + 8 + i] = cb[i]; } break;
        switch (gp) { CS_PUT(0) CS_PUT(1) CS_PUT(2) default: _Pragma("unroll") for (int i = 0; i < 8; ++i) { cs[48 + i] = ca[i]; cs[56 + i] = cb[i]; } break; }
#undef CS_PUT
    }
#undef DSA_LOADK
    if (stages < 2) { unsigned x = 0; _Pragma("unroll") for (int i = 0; i < 64; ++i) x ^= cs[i]; asm volatile("" :: "v"(x)); __syncthreads(); return; }
    PROF_E(21); PROF_B(22);
    unsigned thr = 0u;
    for (int bit = 15; bit >= 0; --bit) {
        const unsigned cand = thr | (1u << bit), cm1 = (cand - 1u) * 0x00010001u; unsigned cp0 = 0u, cp1 = 0u, cp2 = 0u, cp3 = 0u;
#pragma unroll
        for (int i = 0; i < 64; i += 4) { cp0 = pk_count_gt(cp0, cs[i], cm1); cp1 = pk_count_gt(cp1, cs[i + 1], cm1); cp2 = pk_count_gt(cp2, cs[i + 2], cm1); cp3 = pk_count_gt(cp3, cs[i + 3], cm1); }
        const unsigned cp = (cp0 + cp1) + (cp2 + cp3);
        unsigned cnt = (cp & 0xFFFFu) + (cp >> 16);
        cnt += __shfl_xor(cnt, 16); cnt += __shfl_xor(cnt, 32);
        LAS unsigned* cb = CNTB + (bit & 1) * 128;
        if (kq == 0) cb[w * 16 + q] = cnt;
        __syncthreads();
        unsigned tot = 0u;
#pragma unroll
        for (int ww = 0; ww < 8; ++ww) tot += cb[ww * 16 + q];
        if (tot >= (unsigned)Kq) thr = cand;
    }
    if (stages < 3) { asm volatile("" :: "v"(thr)); __syncthreads(); return; }
    PROF_E(22); PROF_B(23);
    unsigned mg[4], me[4];
    {
        const unsigned t0p = thr * 0x00010001u, t1p = (thr - 1u) * 0x00010001u;
#pragma unroll
        for (int j = 0; j < 4; ++j) { unsigned g_ = 0u, e_ = 0u;
#pragma unroll
            for (int ii = 0; ii < 16; ++ii) { g_ = pk_mask_gt(g_, cs[16 * j + ii], t0p); e_ = pk_mask_gt(e_, cs[16 * j + ii], t1p); }
            mg[j] = g_; me[j] = e_ & ~g_; }
    }
    const unsigned cgt = __popc(mg[0]) + __popc(mg[1]) + __popc(mg[2]) + __popc(mg[3]), ceq = __popc(me[0]) + __popc(me[1]) + __popc(me[2]) + __popc(me[3]);
    PCNT[w * 64 + lane] = cgt;
    unsigned cgw = cgt, cew = ceq;
    cgw += __shfl_xor(cgw, 16); cgw += __shfl_xor(cgw, 32); cew += __shfl_xor(cew, 16); cew += __shfl_xor(cew, 32);
    if (kq == 0) { CGT[w * 16 + q] = cgw; CEQ[w * 16 + q] = cew; }
    __syncthreads();
    unsigned gt_tot = 0u, eq_tot = 0u, base = 0u;
#pragma unroll
    for (int ww = 0; ww < 8; ++ww) { gt_tot += CGT[ww * 16 + q]; eq_tot += CEQ[ww * 16 + q]; }
    for (int ww = 0; ww < 8; ++ww)
#pragma unroll
        for (int kk = 0; kk < 4; ++kk) { const unsigned v = PCNT[ww * 64 + kk * 16 + q]; base += (ww < w || (ww == w && kk < kq)) ? v : 0u; }
    const unsigned need = (unsigned)Kq - gt_tot;
    {
        LAS unsigned short* lq = LIST + q * 256; unsigned pos = base;
#pragma unroll
        for (int j = 0; j < 4; ++j) {
            unsigned m_ = mg[j];
            while (__builtin_amdgcn_ballot_w64(m_ != 0u) != 0ull) {
                if (m_ != 0u) { const int bt = 31 - __builtin_clz(m_); const int hf = bt >> 4, i = 16 * j + 15 - (bt & 15); const int grp = i >> 3, jj = (i >> 1) & 3, r = 2 * (i & 1) + hf;
                    lq[pos] = (unsigned short)(16 * (w + 32 * grp + 8 * jj) + 4 * kq + r); ++pos; m_ &= ~(1u << bt); }
            }
            unsigned e_ = me[j];
            while (__builtin_amdgcn_ballot_w64(e_ != 0u) != 0ull) {
                if (e_ != 0u) { const int bt = 31 - __builtin_clz(e_); const int hf = bt >> 4, i = 16 * j + 15 - (bt & 15); const int grp = i >> 3, jj = (i >> 1) & 3, r = 2 * (i & 1) + hf;
                    const unsigned slot = __hip_atomic_fetch_add(&TCNT[q], 1u, __ATOMIC_RELAXED, __HIP_MEMORY_SCOPE_WORKGROUP);
                    if (slot < (unsigned)TIE_CAP) TLIST[q * TIE_CAP + slot] = (unsigned short)(16 * (w + 32 * grp + 8 * jj) + 4 * kq + r);
                    e_ &= ~(1u << bt); }
            }
        }
    }
    __syncthreads();
    if (stages < 4) return;
    PROF_E(23); PROF_B(24);
    {
        LAS unsigned char* tk = lds + DS_TK + w * 4096;
        unsigned nt0 = TCNT[w], nt1 = TCNT[w + 8]; nt0 = nt0 < (unsigned)TIE_CAP ? nt0 : (unsigned)TIE_CAP; nt1 = nt1 < (unsigned)TIE_CAP ? nt1 : (unsigned)TIE_CAP;
        const bool fast = (nt0 <= (unsigned)TIE_FAST) && (nt1 <= (unsigned)TIE_FAST);
        if (fast) {
            u32x4 kr[4];
#pragma unroll
            for (int i = 0; i < 4; ++i) { const int qi = i >> 1, ti = 8 * (i & 1) + (lane >> 3); const unsigned nt = qi ? nt1 : nt0; const unsigned key = ((unsigned)ti < nt) ? TLIST[(w + 8 * qi) * TIE_CAP + ti] : 0u;
                kr[i] = *(const u32x4*)(KIDX + (size_t)key * 64 + 8 * (lane & 7)); }
#pragma unroll
            for (int i = 0; i < 4; ++i) *(LAS u32x4*)(tk + i * 1024 + lane * 16) = kr[i];
            asm volatile("s_waitcnt lgkmcnt(0)" ::: "memory");
        }
        for (int qi = 0; qi < 2; ++qi) {
            const int ql = w + 8 * qi;
            const unsigned ntie = qi ? nt1 : nt0;
            const unsigned gtq = __shfl(gt_tot, ql), needq = __shfl(need, ql);
            const int hh = lane & 15, jj = lane >> 4;
            const LAS unsigned char* qb = lds + DS_QI + hh * 2048 + ql * 128; const unsigned swq = (unsigned)((ql >> 1) & 7);
            const float wh = WQ[ql * 16 + hh];
            for (unsigned g0 = 0; g0 < ntie; g0 += 4) {
                const unsigned ti = g0 + jj; const unsigned key = (ti < ntie) ? TLIST[ql * TIE_CAP + ti] : 0u;
                float dt = 0.f;
#pragma unroll
                for (int c = 0; c < 8; ++c) {
                    h16x8 kv; if (fast) kv = *(const LAS h16x8*)(tk + qi * 2048 + (ti & 15) * 128 + 16 * c); else kv = *(const h16x8*)(KIDX + (size_t)key * 64 + 8 * c);
                    const h16x8 qv = *(const LAS h16x8*)(qb + 16 * ((unsigned)c ^ swq));
#pragma unroll
                    for (int e = 0; e < 8; e += 2) { const h16x2v a = {kv[e], kv[e + 1]}, bq = {qv[e], qv[e + 1]}; dt = __builtin_amdgcn_fdot2(a, bq, dt, false); } }
                float sc = wh * fmaxf(dt, 0.f);
                sc += __shfl_xor(sc, 1); sc += __shfl_xor(sc, 2); sc += __shfl_xor(sc, 4); sc += __shfl_xor(sc, 8);
                if (hh == 0 && ti < ntie) TSC[ql * TIE_CAP + ti] = sc + 0.0f;
            }
            asm volatile("s_waitcnt lgkmcnt(0)" ::: "memory");
            const float mys = (lane < (int)ntie) ? TSC[ql * TIE_CAP + lane] : -INFINITY; const unsigned myk = (lane < (int)ntie) ? TLIST[ql * TIE_CAP + lane] : 0xFFFFu;
            unsigned rank = 0u;
            for (unsigned o = 0; o < ntie; ++o) { const float so = TSC[ql * TIE_CAP + o]; const unsigned ko = TLIST[ql * TIE_CAP + o]; rank += (so > mys || (so == mys && ko < myk)) ? 1u : 0u; }
            if (lane < (int)ntie && rank < needq) LIST[ql * 256 + gtq + rank] = (unsigned short)myk;
            if (lane == 0) ((LAS int*)(lds + LDS_SCR + 256))[ql] = (int)(gtq + (needq < ntie ? needq : ntie));
        }
    }
    (void)eq_tot;
    __syncthreads();
    PROF_E(24);
}

__device__ __forceinline__ unsigned xb_xcc_id();
__device__ __forceinline__ void phase_dsa(const Params& P, LAS unsigned char* lds, int mode) {
    const int tid = threadIdx.x, lane = tid & 63, w = __builtin_amdgcn_readfirstlane(tid >> 6);
    unsigned* tick = (unsigned*)(P.ws + WS_CTL) + 2048 + (mode >> 8) * 64;
    LAS int* wi = (LAS int*)(lds + LDS_SCR + 512);
    const int pref = (int)(xb_xcc_id() >> 1) & 3;
    for (;;) {
        __syncthreads();
        if (tid == 0) { int got = -1;
            for (int a = 0; a < 4 && got < 0; ++a) { const int bb = (pref + a) & 3; const unsigned t = __hip_atomic_fetch_add(tick + bb * 16, 1u, __ATOMIC_RELAXED, __HIP_MEMORY_SCOPE_AGENT); if (t < 64u) got = bb * 64 + (int)t; }
            wi[0] = got; }
        __syncthreads();
        const int item = wi[0];
        if (item < 0) break;
        const int b = item >> 6, j = item & 63;
        for (int ui = 0; ui < 4; ++ui) {
            const int uq = (ui == 0) ? j : (ui == 1) ? 127 - j : (ui == 2) ? 128 + j : 255 - j;
            if (mode & 1) dsa_select_unit(P, lds, b, uq, (mode >> 4) & 15);
            if (mode & 2) for (int qi = 0; qi < 2; ++qi) { const int ql = w + 8 * qi, t = 16 * uq + ql;
                sparse_attn_query(P, lds, w, lane, b, b * SEQ + t, ((const LAS int*)(lds + LDS_SCR + 256))[ql], (const LAS unsigned short*)(lds + DS_LIST) + ql * 256); }
            __syncthreads();
        }
    }
}

#define XB_TMO      128
#define XB_XCNT(j)  (256  + 64 * (j))
#define XB_XSUB(j)  (1280 + 64 * (j))
#define XB_XGEN(j)  (2304 + 64 * (j))
#define XB_TOP      3328
#define XB_TOPGEN   3392
#define XCD_BAR_WORDS 3456
#define XB_SPIN_CAP (1u << 22)
__device__ __forceinline__ unsigned xb_ld(unsigned* p)              { return __hip_atomic_load(p, __ATOMIC_RELAXED, __HIP_MEMORY_SCOPE_AGENT); }
__device__ __forceinline__ unsigned xb_add(unsigned* p, unsigned v) { return __hip_atomic_fetch_add(p, v, __ATOMIC_RELAXED, __HIP_MEMORY_SCOPE_AGENT); }
__device__ __forceinline__ unsigned xb_xcc_id() { return (unsigned)__builtin_amdgcn_s_getreg((3 << 11) | 20) & 0xFu; }
#define XB_SPIN(cond, bar) do { unsigned _sp = 0; while (cond) { __builtin_amdgcn_s_sleep(1); \
    if ((++_sp & 255u) == 0u) { if (xb_ld(&(bar)[XB_TMO])) break; if (_sp > XB_SPIN_CAP) { atomicAdd(&(bar)[XB_TMO], 1u); break; } } } } while (0)
struct XcdBarrier { unsigned* bar; unsigned x; volatile LAS unsigned* st; };
__device__ __forceinline__ XcdBarrier xcd_barrier_post(unsigned* bar, volatile LAS unsigned* st) {
    XcdBarrier b; b.bar = bar; b.x = xb_xcc_id(); b.st = st;
    if (threadIdx.x == 0) (void)xb_add(&bar[XB_XCNT(b.x)], 1u);
    return b;
}
__device__ __forceinline__ void xcd_barrier_complete(unsigned* bar, unsigned x, unsigned& nloc, unsigned& nx) {
    const unsigned G = gridDim.x * gridDim.y * gridDim.z;
    unsigned sum, cnt, mine, sp = 0u;
    for (;;) {
        sum = 0u; cnt = 0u; mine = 0u;
#pragma unroll
        for (unsigned j = 0; j < 16; ++j) { const unsigned c = xb_ld(&bar[XB_XCNT(j)]); sum += c; cnt += (c > 0u) ? 1u : 0u; mine = (j == x) ? c : mine; }
        if (sum == G) break;
        __builtin_amdgcn_s_sleep(1);
        if ((++sp & 255u) == 0u) { if (xb_ld(&bar[XB_TMO])) break; if (sp > XB_SPIN_CAP) { atomicAdd(&bar[XB_TMO], 1u); break; } }
    }
    nloc = mine > 0u ? mine : 1u; nx = cnt > 0u ? cnt : 1u;
}
__device__ __forceinline__ void xcd_barrier(const XcdBarrier& b) {
    asm volatile("s_waitcnt vmcnt(0)" ::: "memory");
    __syncthreads();
    if (threadIdx.x == 0) {
        unsigned* bar = b.bar;
        __builtin_amdgcn_s_waitcnt(0);
        unsigned nloc = b.st[0], nx = b.st[1];
        if (nloc == 0u) { xcd_barrier_complete(bar, b.x, nloc, nx); b.st[0] = nloc; b.st[1] = nx; }
        const unsigned old = xb_add(&bar[XB_XSUB(b.x)], 1u);
        const unsigned gen = old / nloc;
        if (old + 1u == (gen + 1u) * nloc) {
            __builtin_amdgcn_fence(__ATOMIC_RELEASE, "agent");
            asm volatile("s_waitcnt vmcnt(0)" ::: "memory");
            const unsigned og = xb_add(&bar[XB_TOP], 1u);
            const unsigned tg = og / nx;
            if (og + 1u == (tg + 1u) * nx) xb_add(&bar[XB_TOPGEN], 1u);
            else XB_SPIN(xb_ld(&bar[XB_TOPGEN]) == tg, bar);
            __builtin_amdgcn_fence(__ATOMIC_ACQUIRE, "agent");
            xb_add(&bar[XB_XGEN(b.x)], 1u);
            asm volatile("s_waitcnt vmcnt(0)" ::: "memory");
        } else {
            XB_SPIN(xb_ld(&bar[XB_XGEN(b.x)]) == gen, bar);
            __builtin_amdgcn_fence(__ATOMIC_ACQUIRE, "agent");
            asm volatile("s_waitcnt vmcnt(0)" ::: "memory");
        }
    }
    __syncthreads();
}

#ifndef MK_N_LAUNCHES
#define MK_N_LAUNCHES 1
#endif
constexpr int N_PHASES = 8;
extern __shared__ __attribute__((aligned(16))) unsigned char dyn_lds[];
__global__ void __launch_bounds__(NTHR, 2) hybrid_fwd(Params P) {
    LAS unsigned char* lds = (LAS unsigned char*)dyn_lds;
    volatile LAS unsigned* MISC = (volatile LAS unsigned*)(lds + LDS_SCR);
    for (int u = threadIdx.x; u < (LDS_BYTES - LDS_SCR) / 4; u += NTHR) MISC[u] = 0u;
    __syncthreads();
    XcdBarrier bar = xcd_barrier_post((unsigned*)(P.ws + WS_CTL) + 4096 + P.ph_lo * XCD_BAR_WORDS, MISC + 8);
    const int lo = P.ph_lo, hi = P.ph_hi;
#ifndef PHASE_MASK
#define PHASE_MASK 0xFF
#endif
#define IN(k) (((PHASE_MASK >> (k)) & 1) && lo <= (k) && (k) < hi)
#define SEAM(k) do { if (IN(k) && IN((k) + 1)) xcd_barrier(bar); } while (0)
#ifndef REPEAT_MASK
#define REPEAT_MASK 0
#endif
#define REP(k) for (int rep_ = 0; rep_ < 1 + ((REPEAT_MASK >> (k)) & 1); ++rep_, (rep_ < 1 + ((REPEAT_MASK >> (k)) & 1) ? xcd_barrier(bar) : (void)0))
    if (IN(0)) REP(0) phase_prologue(P, lds);
    SEAM(0);
    if (IN(1)) REP(1) phase_h(P, lds);
    SEAM(1);
    if (IN(2)) REP(2) {
        pg8::Gemm g{(const h16*)(P.ws + WS_H), (const h16*)(P.ws + WS_W1T), T, NW1, DM, DM, DM, 0}; pg8::StaticOrder S; S.init(T, NW1, gridDim.x, blockIdx.x);
        EpiProj E{(h16*)(P.ws + WS_CQ), (h16*)(P.ws + WS_KVC), (h16*)(P.ws + WS_SGA), (h16*)(P.ws + WS_QB), (h16*)(P.ws + WS_KB), (h16*)(P.ws + WS_VB), (h16*)(P.ws + WS_SGB),
                  (float*)(P.ws + WS_SMALL), (float*)(P.ws + WS_SSQ), (const float*)(P.ws + WS_ROPE32)};
        pg8::gemm_phase(lds, g, S, E);
    }
    SEAM(2);
    if (IN(3)) {
        phase_rowops(P);
        REP(3) {
        { pg8::Gemm g{(const h16*)(P.ws + WS_CQ), (const h16*)(P.ws + WS_WQT), T, NQ, 512, 512, 512, 0}; pg8::StaticOrder S; S.init(T, NQ, gridDim.x, blockIdx.x);
          EpiQ E{(h16*)(P.ws + WS_QLAT), (h16*)(P.ws + WS_QROPE), (h16*)(P.ws + WS_QIDX), (const float*)(P.ws + WS_SSQ), (const float*)(P.ws + WS_ROPE32), (const float*)(P.ws + WS_ROPE16)};
          pg8::gemm_phase(lds, g, S, E); }
        __syncthreads();
        REP(8) phase_dilated_part(P, lds);
        }
    }
    SEAM(3);
#if DSA_PROBE == 0
    if (IN(4)) { phase_dsa(P, lds, 3 | 0x90); __syncthreads(); REP(4) phase_dilated_last(P, lds); }
#else
    if (IN(4)) { phase_dilated_last(P, lds); xcd_barrier(bar); phase_dsa(P, lds, 3 | 0x90); xcd_barrier(bar); phase_dsa(P, lds, 0x100 | (DSA_PROBE == 1 ? (3 | 0x90) : (1 | ((DSA_PROBE == 6 ? 1 : DSA_PROBE) << 4)))); }
#endif
    SEAM(4);
    if (IN(5)) REP(5) {
        pg8::Gemm g{(const h16*)(P.ws + WS_OLAT), (const h16*)(P.ws + WS_WUVT), T, 1024, 512, 2048, 512, 512}; pg8::StaticOrder S; S.init(T, 1024, gridDim.x, blockIdx.x);
        EpiOA E{(h16*)(P.ws + WS_OAB), (const h16*)(P.ws + WS_SGA)};
        pg8::gemm_phase(lds, g, S, E);
    }
    SEAM(5);
    if (IN(6)) REP(6) {
        pg8::Gemm g{(const h16*)(P.ws + WS_OAB), (const h16*)(P.ws + WS_WOT), T, DM, DM, DM, DM, 0}; pg8::StaticOrder S; S.init(T, DM, gridDim.x, blockIdx.x);
        EpiY E{(h16*)(P.ws + WS_Y), (float*)(P.ws + WS_SSY)};
        pg8::gemm_phase(lds, g, S, E);
    }
    SEAM(6);
    if (IN(7)) REP(7) phase_final(P, lds);
    if (PROF_SEL >= 0 && threadIdx.x == 0) { const unsigned long long t0 = __builtin_amdgcn_s_memrealtime(), d = *(LAS unsigned long long*)(lds + LDS_SCR + 136);
        while (__builtin_amdgcn_s_memrealtime() - t0 < d) __builtin_amdgcn_s_sleep(8); }
#undef IN
#undef SEAM
}

extern "C" void kernel_launch(void* const* d_in, const int* in_sizes, int n_in, void* d_out, int out_size, void* d_ws, size_t ws_size, hipStream_t stream) {
    static int grid = 0;
    if (grid == 0) {
        if (n_in != 14 || in_sizes[0] != T * DM || out_size != T * DM || ws_size < WS_END) { fprintf(stderr, "kernel_launch: unexpected shapes (n_in %d, in0 %d, out %d, ws %zu)\n", n_in, n_in > 0 ? in_sizes[0] : -1, out_size, ws_size); grid = -1; return; }
        int dev = 0, cus = 0, per_cu = 0;
        if (hipGetDevice(&dev) != hipSuccess || hipDeviceGetAttribute(&cus, hipDeviceAttributeMultiprocessorCount, dev) != hipSuccess) { grid = -1; return; }
        if (hipFuncSetAttribute((const void*)hybrid_fwd, hipFuncAttributeMaxDynamicSharedMemorySize, LDS_BYTES) != hipSuccess) { fprintf(stderr, "kernel_launch: hipFuncSetAttribute failed\n"); grid = -1; return; }
        if (hipOccupancyMaxActiveBlocksPerMultiprocessor(&per_cu, (const void*)hybrid_fwd, NTHR, LDS_BYTES) != hipSuccess || per_cu < 1) { fprintf(stderr, "kernel_launch: occupancy query says %d blocks per CU\n", per_cu); }
        (void)hipGetLastError();
        grid = cus;
    }
    if (grid < 0) return;
    (void)hipMemsetAsync((char*)d_ws + WS_CTL, 0, 1 * MiB, stream);
    Params P{};
    P.x = (const float*)d_in[0]; P.c = (const float*)d_in[1]; P.w_ada = (const float*)d_in[2]; P.b_ada = (const float*)d_in[3]; P.g_pre = (const float*)d_in[4]; P.g_post = (const float*)d_in[5];
    P.w_in = (const float*)d_in[6]; P.g_q = (const float*)d_in[7]; P.g_kv = (const float*)d_in[8]; P.w_uq = (const float*)d_in[9]; P.w_uq_idx = (const float*)d_in[10]; P.w_uk = (const float*)d_in[11];
    P.w_uv = (const float*)d_in[12]; P.w_out = (const float*)d_in[13]; P.out = (float*)d_out; P.ws = (unsigned char*)d_ws;
#if MK_N_LAUNCHES == 1
    P.ph_lo = 0; P.ph_hi = N_PHASES;
    hipLaunchKernelGGL(hybrid_fwd, dim3(grid), dim3(NTHR), LDS_BYTES, stream, P);
#else
    for (int k = 0; k < N_PHASES; ++k) { P.ph_lo = k; P.ph_hi = k + 1; hipLaunchKernelGGL(hybrid_fwd, dim3(grid), dim3(NTHR), LDS_BYTES, stream, P); }
#endif
}
```

```cpp
#include <hip/hip_runtime.h>
#include <cstdint>
#include <cstdio>
#include <cmath>

#define LAS __attribute__((address_space(3)))
typedef _Float16 h16;
typedef _Float16 h16x2 __attribute__((ext_vector_type(2)));
typedef _Float16 h16x4 __attribute__((ext_vector_type(4)));
typedef _Float16 h16x8 __attribute__((ext_vector_type(8)));
typedef float f32x2 __attribute__((ext_vector_type(2)));
typedef float f32x4 __attribute__((ext_vector_type(4)));
typedef unsigned u32x2 __attribute__((ext_vector_type(2)));
typedef unsigned u32x4 __attribute__((ext_vector_type(4)));

constexpr int NB = 4, SEQ = 4096, T = NB * SEQ, DM = 2048;
constexpr int NW1 = 6144;
constexpr int NQ = 3328;
constexpr int KVW = 288;
constexpr float EPS = 1e-6f;
constexpr float SCQ = 0.08838834764831845f * 1.4426950408889634f;

constexpr size_t MiB = 1u << 20;
constexpr size_t WS_CTL = 0;
constexpr size_t WS_MODP = 1 * MiB;
constexpr size_t WS_ROPE32 = 2 * MiB;
constexpr size_t WS_ROPE16 = 2 * MiB + 512 * 1024;
constexpr size_t WS_SSQ = 3 * MiB;
constexpr size_t WS_SSY = 4 * MiB;
constexpr size_t WS_W1T = 8 * MiB;
constexpr size_t WS_WQT = 32 * MiB;
constexpr size_t WS_WUVT = 36 * MiB;
constexpr size_t WS_WOT = 38 * MiB;
constexpr size_t WS_KVC = 46 * MiB;
constexpr size_t WS_KIDX = 55 * MiB;
constexpr size_t WS_WIDX = 57 * MiB;
constexpr size_t WS_SMALL = 58 * MiB;
constexpr size_t WS_CQ = 66 * MiB;
constexpr size_t WS_SGA = 82 * MiB;
constexpr size_t WS_OAB = 114 * MiB;
constexpr size_t WS_QLAT = 178 * MiB;
constexpr size_t WS_QROPE = 242 * MiB;
constexpr size_t WS_QIDX = 250 * MiB;
constexpr size_t WS_H = 282 * MiB;
constexpr size_t WS_OP4 = 282 * MiB;
constexpr size_t WS_OP16 = 314 * MiB;
constexpr size_t WS_QB = 346 * MiB;
constexpr size_t WS_KB = 378 * MiB;
constexpr size_t WS_VB = 410 * MiB;
constexpr size_t WS_SGB = 442 * MiB;
constexpr size_t WS_END = 474 * MiB;
constexpr size_t WS_LSEP = 6 * MiB;
#ifndef DSA_PROBE
#define DSA_PROBE 0
#endif
constexpr size_t WS_OLAT = DSA_PROBE ? 346 * MiB : 178 * MiB;
constexpr size_t WS_Y = 178 * MiB;

struct Params {
    const float *x, *c, *w_ada, *b_ada, *g_pre, *g_post, *w_in, *g_q, *g_kv, *w_uq, *w_uq_idx, *w_uk, *w_uv, *w_out;
    float* out; unsigned char* ws;
    int ph_lo, ph_hi;
};

__device__ __forceinline__ unsigned pk2h(float a, float b) { h16x2 t = {(h16)a, (h16)b}; return __builtin_bit_cast(unsigned, t); }
__device__ __forceinline__ float siluf(float v) { return v * __builtin_amdgcn_rcpf(1.0f + __builtin_amdgcn_exp2f(-1.4426950408889634f * v)); }
__device__ __forceinline__ float wave_sum(float v) {
#pragma unroll
    for (int o = 1; o < 64; o <<= 1) v += __shfl_xor(v, o);
    return v;
}
__device__ __forceinline__ float wave_max(float v) {
#pragma unroll
    for (int o = 1; o < 64; o <<= 1) v = fmaxf(v, __shfl_xor(v, o));
    return v;
}

constexpr int NTHR = 512, NWAVE = 8;
constexpr int LDS_SCR = 159744;
constexpr int LDS_BYTES = LDS_SCR + 4096;
#ifndef PROF_SEL
#define PROF_SEL -1
#endif
#ifndef PROF_BLK
#define PROF_BLK 37
#endif
#define PROF_B(k) do { if ((k) == PROF_SEL && threadIdx.x == 0) { *(LAS unsigned long long*)(lds + LDS_SCR + 128) = __builtin_amdgcn_s_memrealtime(); } } while (0)
#define PROF_E(k) do { if ((k) == PROF_SEL && threadIdx.x == 0) { *(LAS unsigned long long*)(lds + LDS_SCR + 136) += __builtin_amdgcn_s_memrealtime() - *(LAS unsigned long long*)(lds + LDS_SCR + 128); } } while (0)

namespace pg8 {
constexpr int BM = 256, BK = 64, HALF = 128, HTB = HALF * BK * 2, STAGE_BYTES = 8 * HTB, NXCD = 8, WGM = 8;
__host__ __device__ __forceinline__ int lds_byte(int r, int c) { const int st = (r >> 4) * 2 + (c >> 5), rr = r & 15, cc = c & 31, ob = rr * 64 + cc * 2; return st * 1024 + (ob ^ (((ob >> 9) & 1) << 5)); }
__host__ __device__ __forceinline__ void stage_rc(int b, int& R, int& C) { const int st = b / 1024, sb = b % 1024, swz = sb ^ (((sb >> 9) & 1) << 5); R = (st >> 1) * 16 + swz / 64; C = (st & 1) * 32 + (swz % 64) / 2; }
__host__ __device__ __forceinline__ int perm32(int rho) { const int n = rho >> 4, i = rho & 15; return 8 * (i >> 2) + 4 * n + (i & 3); }

struct Unit { int pm, pn; };
struct Gemm { const h16* A; const h16* Bt; int M, N, K, lda, ldb, a_pn_off; };

struct StaticOrder {
    int nM, nN, nwg, G, c;
    __device__ void init(int M, int N, int G_, int c_) { nM = M / BM; nN = N / BM; nwg = nM * nN; G = __builtin_amdgcn_readfirstlane(G_); c = __builtin_amdgcn_readfirstlane(c_); }
    __device__ bool next(int i, Unit& u) const {
        const int L = __builtin_amdgcn_readfirstlane(i * G + c); if (L >= nwg) return false;
        int wgid = L; { const int q = nwg / NXCD, r = nwg % NXCD, xcd = wgid % NXCD, off = wgid / NXCD; wgid = (xcd < r ? xcd * (q + 1) : r * (q + 1) + (xcd - r) * q) + off; }
        const int nig = WGM * nN, gid = wgid / nig, fm = gid * WGM, gsz = (nM - fm) < WGM ? (nM - fm) : WGM;
        u.pm = __builtin_amdgcn_readfirstlane(fm + ((wgid % nig) % gsz)); u.pn = __builtin_amdgcn_readfirstlane((wgid % nig) / gsz); return true;
    }
};

template <class Epi>
__device__ __forceinline__ void gemm_phase(LAS unsigned char* lds, const Gemm g, const StaticOrder& S, const Epi& E) {
    const int tid = threadIdx.x, wid = __builtin_amdgcn_readfirstlane(tid >> 6), lane = tid & 63, wr = wid >> 2, wc = wid & 3, fr = lane & 15, fq = lane >> 4;
    const int K = g.K, nt = K / BK;
    unsigned voffA[2], voffB[2];
#pragma unroll
    for (int i = 0; i < 2; ++i) { int R, C; stage_rc(tid * 16 + i * 8192, R, C); const int Rb = (R & ~31) + perm32(R & 31);
        voffA[i] = (unsigned)(R * g.lda + C) * 2u; voffB[i] = (unsigned)(Rb * g.ldb + C) * 2u; }
    const size_t kstep = (size_t)(BK * 2);
    const size_t hstepA = (size_t)HALF * g.lda * 2, hstepB = (size_t)HALF * g.ldb * 2;
    const size_t tstepA = 2 * hstepA, tstepB = 2 * hstepB;
    const unsigned ldsw = (unsigned)wid * 1024u;
    const int aoff = lds_byte(wr * 64 + fr, fq * 8), boff = lds_byte(wc * 32 + fr, fq * 8);
#define PG8_SA(b, h) (((b) * 2 + (h)) * HTB)
#define PG8_SB(b, h) ((4 + (b) * 2 + (h)) * HTB)
#define PG8_STAGE(bufoff, gbase, voff) do { _Pragma("unroll") for (int _i = 0; _i < 2; ++_i) \
        __builtin_amdgcn_global_load_lds((const unsigned*)((const char*)(gbase) + (voff)[_i]), (LAS unsigned*)(lds + (bufoff) + ldsw + _i * 8192), 16, 0, 0); } while (0)
#define PG8_LDA(dst, b, h) do { _Pragma("unroll") for (int m = 0; m < 4; ++m) _Pragma("unroll") for (int k = 0; k < 2; ++k) dst[m][k] = *(const LAS h16x8*)(lds + PG8_SA(b, h) + aoff + m * 2048 + k * 1024); } while (0)
#define PG8_LDB(dst, b, h) do { _Pragma("unroll") for (int n = 0; n < 2; ++n) _Pragma("unroll") for (int k = 0; k < 2; ++k) dst[n][k] = *(const LAS h16x8*)(lds + PG8_SB(b, h) + boff + n * 2048 + k * 1024); } while (0)
#define PG8_MMA(ai, bj, At, Bt) do { __builtin_amdgcn_s_setprio(1); _Pragma("unroll") for (int m = 0; m < 4; ++m) _Pragma("unroll") for (int n = 0; n < 2; ++n) _Pragma("unroll") for (int k = 0; k < 2; ++k) \
        acc[ai][bj][m][n] = __builtin_amdgcn_mfma_f32_16x16x32_f16(Bt[n][k], At[m][k], acc[ai][bj][m][n], 0, 0, 0); __builtin_amdgcn_s_setprio(0); } while (0)
#define PG8_WAIT_V(n) asm volatile("s_waitcnt vmcnt(" #n ")" ::: "memory")
#define PG8_WAIT_L(n) asm volatile("s_waitcnt lgkmcnt(" #n ")" ::: "memory")
#define PG8_BAR __builtin_amdgcn_s_barrier()
#define PG8_SCHED __builtin_amdgcn_sched_barrier(0)
    Unit cur, nxt; int ui = 0;
    if (!S.next(0, cur)) return;
    PROF_B(Epi::PROF_ID);
    f32x4 acc[2][2][4][2];
#pragma unroll
    for (int a = 0; a < 2; ++a)
#pragma unroll
        for (int b = 0; b < 2; ++b)
#pragma unroll
            for (int m = 0; m < 4; ++m)
#pragma unroll
                for (int n = 0; n < 2; ++n) acc[a][b][m][n] = (f32x4){0.f, 0.f, 0.f, 0.f};
    h16x8 At[4][2], B0[2][2], B1[2][2];
    const char* cA = (const char*)g.A + (size_t)cur.pm * tstepA + (size_t)cur.pn * g.a_pn_off * 2; const char* cB = (const char*)g.Bt + (size_t)cur.pn * tstepB;
    PG8_STAGE(PG8_SB(0, 0), cB, voffB); PG8_STAGE(PG8_SB(0, 1), cB + hstepB, voffB); PG8_STAGE(PG8_SA(0, 0), cA, voffA); PG8_STAGE(PG8_SA(0, 1), cA + hstepA, voffA);
    if (wr == 1) PG8_BAR;
    PG8_WAIT_V(2); PG8_BAR;
    PG8_STAGE(PG8_SB(1, 0), cB + kstep, voffB); PG8_STAGE(PG8_SA(1, 0), cA + kstep, voffA); PG8_STAGE(PG8_SB(1, 1), cB + hstepB + kstep, voffB);
    PG8_WAIT_V(6); PG8_BAR;
    for (;;) {
        const bool has_next = S.next(ui + 1, nxt);
        const char* nA = has_next ? (const char*)g.A + (size_t)nxt.pm * tstepA + (size_t)nxt.pn * g.a_pn_off * 2 : cA; const char* nB = has_next ? (const char*)g.Bt + (size_t)nxt.pn * tstepB : cB;
        for (int t = 0; t < nt; t += 2) {
            const bool last = (t == nt - 2);
            const char* a1 = cA + (size_t)(t + 1) * kstep;
            const char* a2 = last ? nA : cA + (size_t)(t + 2) * kstep; const char* b2 = last ? nB : cB + (size_t)(t + 2) * kstep;
            const char* a3 = a2 + kstep; const char* b3 = b2 + kstep;
            PG8_LDB(B0, 0, 0); PG8_LDB(B1, 0, 1); PG8_SCHED; PG8_LDA(At, 0, 0); PG8_STAGE(PG8_SA(1, 1), a1 + hstepA, voffA);
            PG8_WAIT_V(8); PG8_WAIT_L(0); PG8_BAR; PG8_MMA(0, 0, At, B0); PG8_MMA(0, 1, At, B1); PG8_BAR; PG8_SCHED;
            PG8_LDA(At, 0, 1); PG8_STAGE(PG8_SB(0, 0), b2, voffB); PG8_STAGE(PG8_SB(0, 1), b2 + hstepB, voffB); PG8_STAGE(PG8_SA(0, 0), a2, voffA);
            PG8_WAIT_V(8); PG8_WAIT_L(0); PG8_BAR; PG8_MMA(1, 0, At, B0); PG8_MMA(1, 1, At, B1); PG8_BAR; PG8_SCHED;
            PG8_LDB(B0, 1, 0); PG8_LDB(B1, 1, 1); PG8_SCHED; PG8_LDA(At, 1, 0); PG8_STAGE(PG8_SA(0, 1), a2 + hstepA, voffA);
            PG8_WAIT_V(8); PG8_WAIT_L(0); PG8_BAR; PG8_MMA(0, 0, At, B0); PG8_MMA(0, 1, At, B1); PG8_BAR; PG8_SCHED;
            PG8_LDA(At, 1, 1); PG8_STAGE(PG8_SB(1, 0), b3, voffB); PG8_STAGE(PG8_SB(1, 1), b3 + hstepB, voffB); PG8_STAGE(PG8_SA(1, 0), a3, voffA);
            PG8_WAIT_V(8); PG8_WAIT_L(0); PG8_BAR; PG8_MMA(1, 0, At, B0); PG8_MMA(1, 1, At, B1); PG8_BAR; PG8_SCHED;
        }
        if (wr == 0) PG8_BAR;
        PROF_E(Epi::PROF_ID); PROF_B(Epi::PROF_ID + 1);
        { const int cls_ = (Epi::PROF_ID == 40) ? (cur.pn < 2 ? 60 : cur.pn < 4 ? 61 : (cur.pn < 8 || cur.pn >= 20) ? 62 : cur.pn < 16 ? 63 : 64) : (Epi::PROF_ID == 42 ? (cur.pn == 0 ? 65 : cur.pn < 9 ? 66 : 67) : 0);
          if (cls_ == PROF_SEL) PROF_B(PROF_SEL);
          E(acc, cur, wr, wc, fr, fq);
          if (cls_ == PROF_SEL) PROF_E(PROF_SEL); }
        PROF_E(Epi::PROF_ID + 1); PROF_B(Epi::PROF_ID);
        if (!has_next) break;
#pragma unroll
        for (int a = 0; a < 2; ++a)
#pragma unroll
            for (int b = 0; b < 2; ++b)
#pragma unroll
                for (int m = 0; m < 4; ++m)
#pragma unroll
                    for (int n = 0; n < 2; ++n) acc[a][b][m][n] = (f32x4){0.f, 0.f, 0.f, 0.f};
        cur = nxt; cA = nA; cB = nB; ++ui;
        if (wr == 1) PG8_BAR;
    }
    PG8_WAIT_V(0);
    PG8_BAR;
#undef PG8_SA
#undef PG8_SB
#undef PG8_STAGE
#undef PG8_LDA
#undef PG8_LDB
#undef PG8_MMA
#undef PG8_WAIT_V
#undef PG8_WAIT_L
#undef PG8_BAR
#undef PG8_SCHED
}
}

using pg8::Unit;
__device__ __forceinline__ u32x4 pack8(const f32x4 a, const f32x4 b) { u32x4 w; w.x = pk2h(a[0], a[1]); w.y = pk2h(a[2], a[3]); w.z = pk2h(b[0], b[1]); w.w = pk2h(b[2], b[3]); return w; }

__device__ __forceinline__ float xlane32(float v, bool upper) { const auto r = __builtin_amdgcn_permlane32_swap(__float_as_uint(v), __float_as_uint(v), false, false); return __uint_as_float(upper ? r[0] : r[1]); }
__device__ __forceinline__ float xlane16(float v, bool oddrow) { const auto r = __builtin_amdgcn_permlane16_swap(__float_as_uint(v), __float_as_uint(v), false, false); return __uint_as_float(oddrow ? r[0] : r[1]); }
__device__ __forceinline__ void rope8(f32x4& v0, f32x4& v1, const f32x4 (&t)[4], const f32x4 p0, const f32x4 p1, float sg) {
#pragma unroll
    for (int e = 0; e < 4; ++e) { const float c0 = t[e >> 1][2 * (e & 1)], s0 = t[e >> 1][2 * (e & 1) + 1], c1 = t[2 + (e >> 1)][2 * (e & 1)], s1 = t[2 + (e >> 1)][2 * (e & 1) + 1];
        v0[e] = v0[e] * c0 + sg * p0[e] * s0; v1[e] = v1[e] * c1 + sg * p1[e] * s1; }
}
struct EpiProj {
    static constexpr int PROF_ID = 40;
    h16 *CQ, *KVC, *SGA, *QB, *KB, *VB, *SGB; float *SMALL, *SSQ; const float* rope32;
    __device__ __forceinline__ void operator()(const f32x4 (&acc)[2][2][4][2], const Unit& u, int wr, int wc, int fr_in, int fq_in) const {
        int fr = fr_in, fq = fq_in; asm volatile("" : "+v"(fr), "+v"(fq));
        const int pn = u.pn;
        const int rowb = u.pm * 256 + wr * 64 + fr;
        if (pn >= 8 && pn < 16 && wc == 0) {
            const bool isq = pn < 12; const float sc = isq ? SCQ : 1.0f, sg = (fq < 2) ? -1.f : 1.f; const bool upper = fq >= 2;
            h16* dst = (isq ? QB + (pn - 8) * 256 : KB + (pn - 12) * 256) + fq * 8;
            const float* tb = rope32 + 16 * (fq & 1);
            f32x4 ta[4], tn[4];
#define EP_LDT(t, g) do { const int pos_ = (rowb + 128 * ((g) >> 2) + 16 * ((g) & 3)) & (SEQ - 1); _Pragma("unroll") for (int k_ = 0; k_ < 4; ++k_) t[k_] = *(const f32x4*)(tb + (size_t)pos_ * 32 + 4 * k_); } while (0)
            EP_LDT(ta, 0);
#pragma unroll
            for (int g = 0; g < 8; ++g) {
                if (g < 7) { if (g & 1) EP_LDT(ta, g + 1); else EP_LDT(tn, g + 1); }
                const int ai = g >> 2, m = g & 3; const int row = rowb + 128 * ai + 16 * m;
#pragma unroll
                for (int bj = 0; bj < 2; ++bj) { f32x4 v0 = acc[ai][bj][m][0], v1 = acc[ai][bj][m][1], p0, p1;
#pragma unroll
                    for (int e = 0; e < 4; ++e) { p0[e] = xlane32(v0[e], upper); p1[e] = xlane32(v1[e], upper); }
                    if (g & 1) rope8(v0, v1, tn, p0, p1, sg); else rope8(v0, v1, ta, p0, p1, sg);
                    v0 = v0 * sc; v1 = v1 * sc;
                    *(u32x4*)(dst + (size_t)row * 1024 + bj * 128) = pack8(v0, v1); }
            }
#undef EP_LDT
            return;
        }
#pragma unroll
        for (int ai = 0; ai < 2; ++ai)
#pragma unroll
            for (int m = 0; m < 4; ++m) {
                const int row = rowb + ai * 128 + m * 16;
                if (pn < 2) {
                    float s = 0.f;
#pragma unroll
                    for (int bj = 0; bj < 2; ++bj) { const f32x4 v0 = acc[ai][bj][m][0], v1 = acc[ai][bj][m][1];
                        s += (v0[0] * v0[0] + v0[1] * v0[1]) + (v0[2] * v0[2] + v0[3] * v0[3]) + (v1[0] * v1[0] + v1[1] * v1[1]) + (v1[2] * v1[2] + v1[3] * v1[3]);
                        *(u32x4*)(CQ + (size_t)row * 512 + pn * 256 + bj * 128 + wc * 32 + fq * 8) = pack8(v0, v1); }
                    s += __shfl_xor(s, 16); s += __shfl_xor(s, 32);
                    if (fq == 0) SSQ[(size_t)row * 8 + pn * 4 + wc] = s;
                } else if (pn == 2) {
#pragma unroll
                    for (int bj = 0; bj < 2; ++bj) *(u32x4*)(KVC + (size_t)row * KVW + bj * 128 + wc * 32 + fq * 8) = pack8(acc[ai][bj][m][0], acc[ai][bj][m][1]);
                } else if (pn == 3) {
                    float* p = SMALL + (size_t)row * 128 + wc * 32 + fq * 8;
                    *(f32x4*)p = acc[ai][0][m][0]; *(f32x4*)(p + 4) = acc[ai][0][m][1];
                } else if (pn < 8 || pn >= 20) {
                    h16* dst = (pn < 8 ? SGA + (pn - 4) * 256 : SGB + (pn - 20) * 256) + (size_t)row * 1024 + wc * 32 + fq * 8;
#pragma unroll
                    for (int bj = 0; bj < 2; ++bj) { f32x4 v0 = acc[ai][bj][m][0], v1 = acc[ai][bj][m][1];
#pragma unroll
                        for (int e = 0; e < 4; ++e) { v0[e] = siluf(v0[e]); v1[e] = siluf(v1[e]); }
                        *(u32x4*)(dst + bj * 128) = pack8(v0, v1); }
                } else if (pn >= 16) {
                    h16* dst = VB + (size_t)row * 1024 + (pn - 16) * 256 + wc * 32 + fq * 8;
#pragma unroll
                    for (int bj = 0; bj < 2; ++bj) *(u32x4*)(dst + bj * 128) = pack8(acc[ai][bj][m][0], acc[ai][bj][m][1]);
                } else {
                    const bool isq = pn < 12; const float sc = isq ? SCQ : 1.0f;
                    h16* dst = (isq ? QB + (pn - 8) * 256 : KB + (pn - 12) * 256) + (size_t)row * 1024 + wc * 32 + fq * 8;
#pragma unroll
                    for (int bj = 0; bj < 2; ++bj) *(u32x4*)(dst + bj * 128) = pack8(acc[ai][bj][m][0] * sc, acc[ai][bj][m][1] * sc);
                }
            }
    }
};

struct EpiQ {
    static constexpr int PROF_ID = 42;
    h16 *QLAT, *QROPE, *QIDX; const float *SSQ, *rope32, *rope16;
    __device__ __forceinline__ void operator()(const f32x4 (&acc)[2][2][4][2], const Unit& u, int wr, int wc, int fr_in, int fq_in) const {
        int fr = fr_in, fq = fq_in; asm volatile("" : "+v"(fr), "+v"(fq));
        const int pn = u.pn;
        const int rowb = u.pm * 256 + wr * 64 + fr;
        if (pn >= 1 && pn < 9) {
            float rs[8];
#pragma unroll
            for (int gb = 0; gb < 8; gb += 4) {
                f32x4 sa_[4], sb_[4];
#pragma unroll
                for (int g = 0; g < 4; ++g) { const int row = rowb + 128 * ((gb + g) >> 2) + 16 * (g & 3); sa_[g] = *(const f32x4*)(SSQ + (size_t)row * 8); sb_[g] = *(const f32x4*)(SSQ + (size_t)row * 8 + 4); }
#pragma unroll
                for (int g = 0; g < 4; ++g) rs[gb + g] = __builtin_amdgcn_rsqf((((sa_[g][0] + sa_[g][1]) + (sa_[g][2] + sa_[g][3])) + ((sb_[g][0] + sb_[g][1]) + (sb_[g][2] + sb_[g][3]))) * (1.0f / 512.0f) + EPS);
            }
#pragma unroll
            for (int g = 0; g < 8; ++g) { const int ai = g >> 2, m = g & 3; const int row = rowb + 128 * ai + 16 * m; const float sc = rs[g] * SCQ;
#pragma unroll
                for (int bj = 0; bj < 2; ++bj)
                    *(u32x4*)(QLAT + ((size_t)row * 8 + (pn - 1)) * 256 + bj * 128 + wc * 32 + fq * 8) = pack8(acc[ai][bj][m][0] * sc, acc[ai][bj][m][1] * sc); }
            return;
        }
        const bool rope_q = (pn == 0), rope_i = (pn >= 9) && ((wc & 1) == 0);
        const float* tb = rope_q ? rope32 + 16 * (fq & 1) : rope16;
        const int tstride = rope_q ? 32 : 16;
#pragma unroll
        for (int am = 0; am < 4; ++am) { const int ai = am >> 1, mb = 2 * (am & 1);
            f32x4 tt[2][4];
            float rs2[2];
#pragma unroll
            for (int mm = 0; mm < 2; ++mm) { const int row = rowb + ai * 128 + (mb + mm) * 16;
                const f32x4 sa_ = *(const f32x4*)(SSQ + (size_t)row * 8), sb_ = *(const f32x4*)(SSQ + (size_t)row * 8 + 4);
                if (rope_q || rope_i) {
#pragma unroll
                    for (int k = 0; k < 4; ++k) tt[mm][k] = *(const f32x4*)(tb + (size_t)(row & (SEQ - 1)) * tstride + 4 * k); }
                rs2[mm] = __builtin_amdgcn_rsqf((((sa_[0] + sa_[1]) + (sa_[2] + sa_[3])) + ((sb_[0] + sb_[1]) + (sb_[2] + sb_[3]))) * (1.0f / 512.0f) + EPS); }
#pragma unroll
            for (int mm = 0; mm < 2; ++mm) { const int m = mb + mm;
                const int row = rowb + ai * 128 + m * 16;
                const float rstd = rs2[mm];
#pragma unroll
                for (int bj = 0; bj < 2; ++bj) { f32x4 v0 = acc[ai][bj][m][0] * rstd, v1 = acc[ai][bj][m][1] * rstd;
                    if (pn == 0) {
                        f32x4 p0, p1;
#pragma unroll
                        for (int e = 0; e < 4; ++e) { p0[e] = xlane32(v0[e], fq >= 2); p1[e] = xlane32(v1[e], fq >= 2); }
                        rope8(v0, v1, tt[mm], p0, p1, (fq < 2) ? -1.f : 1.f);
                        v0 = v0 * SCQ; v1 = v1 * SCQ;
                        *(u32x4*)(QROPE + ((size_t)row * 8 + (4 * bj + wc)) * 32 + fq * 8) = pack8(v0, v1);
                    } else {
                        if ((wc & 1) == 0) {
                            f32x4 p0, p1, r0 = v0, r1 = v1;
#pragma unroll
                            for (int e = 0; e < 4; ++e) { p0[e] = xlane16(v0[e], (fq & 1) != 0); p1[e] = xlane16(v1[e], (fq & 1) != 0); }
                            rope8(r0, r1, tt[mm], p0, p1, (fq == 0) ? -1.f : 1.f);
                            if (fq < 2) { v0 = r0; v1 = r1; }
                        }
                        *(u32x4*)(QIDX + (size_t)row * 1024 + (pn - 9) * 256 + bj * 128 + wc * 32 + fq * 8) = pack8(v0, v1);
                    } }
            }
            asm volatile("" ::: "memory");
        }
    }
};

struct EpiOA {
    static constexpr int PROF_ID = 44;
    h16* OAB; const h16* SGA;
    __device__ __forceinline__ void operator()(const f32x4 (&acc)[2][2][4][2], const Unit& u, int wr, int wc, int fr_in, int fq_in) const {
        int fr = fr_in, fq = fq_in; asm volatile("" : "+v"(fr), "+v"(fq));
#pragma unroll
        for (int ai = 0; ai < 2; ++ai)
#pragma unroll
            for (int m = 0; m < 4; ++m) {
                const int row = u.pm * 256 + ai * 128 + wr * 64 + m * 16 + fr;
#pragma unroll
                for (int bj = 0; bj < 2; ++bj) { const int col = u.pn * 256 + bj * 128 + wc * 32 + fq * 8;
                    const h16x8 g = *(const h16x8*)(SGA + (size_t)row * 1024 + col);
                    f32x4 v0 = acc[ai][bj][m][0], v1 = acc[ai][bj][m][1];
#pragma unroll
                    for (int e = 0; e < 4; ++e) { v0[e] *= (float)g[e]; v1[e] *= (float)g[4 + e]; }
                    *(u32x4*)(OAB + (size_t)row * 2048 + col) = pack8(v0, v1); }
            }
    }
};

struct EpiY {
    static constexpr int PROF_ID = 46;
    h16* Y; float* SSY;
    __device__ __forceinline__ void operator()(const f32x4 (&acc)[2][2][4][2], const Unit& u, int wr, int wc, int fr_in, int fq_in) const {
        int fr = fr_in, fq = fq_in; asm volatile("" : "+v"(fr), "+v"(fq));
#pragma unroll
        for (int ai = 0; ai < 2; ++ai)
#pragma unroll
            for (int m = 0; m < 4; ++m) {
                const int row = u.pm * 256 + ai * 128 + wr * 64 + m * 16 + fr;
                float s = 0.f;
#pragma unroll
                for (int bj = 0; bj < 2; ++bj) { const f32x4 v0 = acc[ai][bj][m][0], v1 = acc[ai][bj][m][1];
                    s += (v0[0] * v0[0] + v0[1] * v0[1]) + (v0[2] * v0[2] + v0[3] * v0[3]) + (v1[0] * v1[0] + v1[1] * v1[1]) + (v1[2] * v1[2] + v1[3] * v1[3]);
                    *(u32x4*)(Y + (size_t)row * 2048 + u.pn * 256 + bj * 128 + wc * 32 + fq * 8) = pack8(v0, v1); }
                s += __shfl_xor(s, 16); s += __shfl_xor(s, 32);
                if (fq == 0) SSY[(size_t)row * 32 + u.pn * 4 + wc] = s;
            }
    }
};


__device__ __forceinline__ void p0_mod_unit(const Params& P, int unit, LAS unsigned char* lds) {
    const int tid = threadIdx.x, lane = tid & 63, w = tid >> 6, kc = unit / 24, cc = unit % 24;
    LAS float* sc = (LAS float*)lds;
    LAS float* red = (LAS float*)(lds + 4096);
    for (int i = tid; i < 1024; i += NTHR) { const int b = i >> 8, kk = i & 255; sc[i] = siluf(P.c[b * DM + kc * 256 + kk]); }
    __syncthreads();
    f32x4 acc[4];
#pragma unroll
    for (int b = 0; b < 4; ++b) acc[b] = (f32x4){0.f, 0.f, 0.f, 0.f};
    const float* wp = P.w_ada + (size_t)(kc * 256 + w * 32) * 6144 + cc * 256 + 4 * lane;
#pragma unroll 16
    for (int i = 0; i < 32; ++i) { const f32x4 wv = __builtin_nontemporal_load((const f32x4*)(wp + (size_t)i * 6144));
#pragma unroll
        for (int b = 0; b < 4; ++b) acc[b] += wv * sc[b * 256 + w * 32 + i]; }
#pragma unroll
    for (int b = 0; b < 4; ++b) *(LAS f32x4*)(red + (w * 4 + b) * 256 + 4 * lane) = acc[b];
    __syncthreads();
    float* MODP = (float*)(P.ws + WS_MODP);
    for (int o = tid; o < 1024; o += NTHR) { const int b = o >> 8, j = o & 255; float s = 0.f;
#pragma unroll
        for (int ww = 0; ww < 8; ++ww) s += red[(ww * 4 + b) * 256 + j];
        MODP[(size_t)(kc * 4 + b) * 6144 + cc * 256 + j] = s; }
    __syncthreads();
}
template <class SrcCol>
__device__ __forceinline__ void transpose_item(const float* W, int ldw, const float* kscale, h16* WT, int ldt, int k0, int n0, SrcCol srccol, LAS float* scr, int lane) {
    const int n4 = 4 * (lane & 15), s = srccol(n0 + n4);
    f32x4 tv[16];
#pragma unroll
    for (int i = 0; i < 16; ++i) { const int k = 4 * i + (lane >> 4); tv[i] = (s >= 0) ? __builtin_nontemporal_load((const f32x4*)(W + (size_t)(k0 + k) * ldw + s)) : (f32x4){0.f, 0.f, 0.f, 0.f}; }
#pragma unroll
    for (int i = 0; i < 16; ++i) { const int k = 4 * i + (lane >> 4); f32x4 v = tv[i];
        if (kscale) v = v * kscale[k0 + k];
        *(LAS f32x4*)(scr + k * 64 + (n4 ^ (((k >> 3) & 7) << 2))) = v; }
    asm volatile("s_waitcnt lgkmcnt(0)" ::: "memory");
    const int c = lane & 7;
#pragma unroll
    for (int j = 0; j < 8; ++j) { const int n = (lane >> 3) + 8 * j; const LAS float* sp = scr + (8 * c) * 64 + (n ^ (c << 2));
        u32x4 o; o.x = pk2h(sp[0 * 64], sp[1 * 64]); o.y = pk2h(sp[2 * 64], sp[3 * 64]); o.z = pk2h(sp[4 * 64], sp[5 * 64]); o.w = pk2h(sp[6 * 64], sp[7 * 64]);
        *(u32x4*)(WT + (size_t)(n0 + n) * ldt + k0 + 8 * c) = o; }
    asm volatile("s_waitcnt lgkmcnt(0)" ::: "memory");
}
struct SrcW1 { __device__ int operator()(int n) const { return n < 880 ? n : (n < 1024 ? -1 : n - 144); } };
struct SrcId { __device__ int operator()(int n) const { return n; } };
struct SrcQRope { __device__ int operator()(int n) const { return (n >> 5) * 128 + (n & 31); } };

__device__ __forceinline__ void p0_fold_unit(const Params& P, int unit, LAS unsigned char* lds) {
    const int tid = threadIdx.x, h = unit >> 5, kb = (unit >> 2) & 7, rq = unit & 3;
    LAS float* wuk = (LAS float*)lds;
    LAS float* wuq = (LAS float*)(lds + 24576);
    for (int i = tid; i < 96 * 64; i += NTHR) { const int nn = i >> 6, r = i & 63; wuk[i] = P.w_uk[((size_t)h * 96 + nn) * 256 + rq * 64 + r]; }
    for (int i = tid; i < 64 * 96; i += NTHR) { const int k = i / 96, nn = i % 96; wuq[i] = P.w_uq[(size_t)(kb * 64 + k) * 1024 + h * 128 + 32 + nn]; }
    __syncthreads();
    const int r = tid & 63, kg = __builtin_amdgcn_readfirstlane(tid >> 6);
    float acc[8];
#pragma unroll
    for (int i = 0; i < 8; ++i) acc[i] = 0.f;
#pragma unroll 2
    for (int nn = 0; nn < 96; nn += 4) { const float b0 = wuk[nn * 64 + r], b1 = wuk[(nn + 1) * 64 + r], b2 = wuk[(nn + 2) * 64 + r], b3 = wuk[(nn + 3) * 64 + r];
#pragma unroll
        for (int i = 0; i < 8; ++i) { const f32x4 a = *(const LAS f32x4*)(wuq + (kg * 8 + i) * 96 + nn); acc[i] += (a[0] * b0 + a[1] * b1) + (a[2] * b2 + a[3] * b3); } }
    h16* dst = (h16*)(P.ws + WS_WQT) + (size_t)(256 + h * 256 + rq * 64 + r) * 512 + kb * 64 + kg * 8;
    const float* gq = P.g_q + kb * 64 + kg * 8;
    u32x4 o; o.x = pk2h(acc[0] * gq[0], acc[1] * gq[1]); o.y = pk2h(acc[2] * gq[2], acc[3] * gq[3]); o.z = pk2h(acc[4] * gq[4], acc[5] * gq[5]); o.w = pk2h(acc[6] * gq[6], acc[7] * gq[7]);
    *(u32x4*)dst = o;
    __syncthreads();
}
__device__ __forceinline__ void phase_prologue(const Params& P, LAS unsigned char* lds) {
    const int tid = threadIdx.x, lane = tid & 63, w = tid >> 6, G = gridDim.x, bid = blockIdx.x;
    PROF_B(50);
    for (int u = bid; u < 192; u += G) p0_mod_unit(P, u, lds);
    PROF_E(50); PROF_B(51);
    for (int u = bid; u < 256; u += G) p0_fold_unit(P, u, lds);
    PROF_E(51); PROF_B(52);
    {
        float* r32 = (float*)(P.ws + WS_ROPE32); float* r16 = (float*)(P.ws + WS_ROPE16);
        for (int e = bid * NTHR + tid; e < SEQ * 24; e += G * NTHR) {
            const int pos = e / 24, i = e % 24;
            const float inv = (i < 16) ? (float)pow(500000.0, -(double)i / 16.0) : (float)pow(500000.0, -(double)(i - 16) / 8.0);
            const float ang = (float)pos * inv;
            const float cv = (float)cos((double)ang), sv = (float)sin((double)ang);
            if (i < 16) { r32[((size_t)pos * 16 + i) * 2] = cv; r32[((size_t)pos * 16 + i) * 2 + 1] = sv; }
            else { r16[((size_t)pos * 8 + (i - 16)) * 2] = cv; r16[((size_t)pos * 8 + (i - 16)) * 2 + 1] = sv; }
        }
    }
    {
        h16* WUVT = (h16*)(P.ws + WS_WUVT);
        for (int e = bid * NTHR + tid; e < 1024 * 32; e += G * NTHR) { const int n = e >> 5, c8 = e & 31, hh = n >> 7; const int k = ((hh & 1) ? 0 : 256) + c8 * 8;
            *(u32x4*)(WUVT + (size_t)n * 512 + k) = (u32x4){0u, 0u, 0u, 0u}; }
    }
    PROF_E(52); PROF_B(53);
    LAS float* scr = (LAS float*)(lds + w * 16384);
    const int gw = bid * NWAVE + w, NGW = G * NWAVE;
    constexpr int I_W1 = 32 * 96, I_QR = 8 * 4, I_QI = 8 * 16, I_UV = 8 * 4 * 2, I_WO = 32 * 32;
    for (int it = gw; it < I_W1 + I_QR + I_QI + I_UV + I_WO; it += NGW) {
        int r = it;
        if (r < I_W1) { transpose_item(P.w_in, 6000, nullptr, (h16*)(P.ws + WS_W1T), 2048, (r / 96) * 64, (r % 96) * 64, SrcW1(), scr, lane); continue; } r -= I_W1;
        if (r < I_QR) { transpose_item(P.w_uq, 1024, P.g_q, (h16*)(P.ws + WS_WQT), 512, (r / 4) * 64, (r % 4) * 64, SrcQRope(), scr, lane); continue; } r -= I_QR;
        if (r < I_QI) { transpose_item(P.w_uq_idx, 1024, P.g_q, (h16*)(P.ws + WS_WQT) + (size_t)2304 * 512, 512, (r / 16) * 64, (r % 16) * 64, SrcId(), scr, lane); continue; } r -= I_QI;
        if (r < I_UV) { const int hh = r >> 3, kb = (r >> 1) & 3, nb = r & 1;
            transpose_item(P.w_uv + (size_t)hh * 256 * 128, 128, nullptr, (h16*)(P.ws + WS_WUVT) + (size_t)(hh * 128) * 512 + 256 * (hh & 1), 512, kb * 64, nb * 64, SrcId(), scr, lane); continue; } r -= I_UV;
        transpose_item(P.w_out, 2048, nullptr, (h16*)(P.ws + WS_WOT), 2048, (r / 32) * 64, (r % 32) * 64, SrcId(), scr, lane);
    }
    PROF_E(53);
}

__device__ __forceinline__ void load_mod(const Params& P, int b, int off, LAS float* dst, bool plus1) {
    const float* MODP = (const float*)(P.ws + WS_MODP);
    for (int j = threadIdx.x; j < 2048; j += NTHR) { float s = P.b_ada[off + j];
#pragma unroll
        for (int kc = 0; kc < 8; ++kc) s += MODP[(size_t)(kc * 4 + b) * 6144 + off + j];
        dst[j] = plus1 ? 1.0f + s : s; }
}
__device__ __forceinline__ void phase_h(const Params& P, LAS unsigned char* lds) {
    const int tid = threadIdx.x, lane = tid & 63, w = tid >> 6;
    LAS float* shift = (LAS float*)lds; LAS float* scale1 = (LAS float*)(lds + 8192);
    h16* H = (h16*)(P.ws + WS_H);
    for (int ch = blockIdx.x; ch < 256; ch += gridDim.x) {
        const int b = ch >> 6;
        __syncthreads();
        load_mod(P, b, 0, shift, false); load_mod(P, b, 2048, scale1, true);
        __syncthreads();
        for (int i = 0; i < 8; ++i) {
            const int row = ch * 64 + w * 8 + i;
            const float* xr = P.x + (size_t)row * DM + 4 * lane;
            f32x4 v[8]; float ss = 0.f;
#pragma unroll
            for (int j = 0; j < 8; ++j) { v[j] = *(const f32x4*)(xr + 256 * j); ss += (v[j][0] * v[j][0] + v[j][1] * v[j][1]) + (v[j][2] * v[j][2] + v[j][3] * v[j][3]); }
            const float rstd = 1.0f / sqrtf(wave_sum(ss) * (1.0f / DM) + EPS);
#pragma unroll
            for (int j = 0; j < 8; ++j) { const int col = 4 * lane + 256 * j; const f32x4 g = *(const f32x4*)(P.g_pre + col);
                const f32x4 s1 = *(const LAS f32x4*)(scale1 + col), sh = *(const LAS f32x4*)(shift + col);
                const f32x4 o = v[j] * rstd * g * s1 + sh; u32x2 pk; pk.x = pk2h(o[0], o[1]); pk.y = pk2h(o[2], o[3]);
                *(u32x2*)(H + (size_t)row * DM + col) = pk; }
        }
    }
}
__device__ __forceinline__ void phase_rowops(const Params& P) {
    const int tid = threadIdx.x, lane = tid & 63, w = tid >> 6;
    h16* KVC = (h16*)(P.ws + WS_KVC); h16* KIDX = (h16*)(P.ws + WS_KIDX); float* WIDX = (float*)(P.ws + WS_WIDX);
    const float* SMALL = (const float*)(P.ws + WS_SMALL); const float* r32 = (const float*)(P.ws + WS_ROPE32); const float* r16 = (const float*)(P.ws + WS_ROPE16);
    for (int row = blockIdx.x * NWAVE + w; row < T; row += gridDim.x * NWAVE) {
        const int pos = row & (SEQ - 1);
        h16* kr = KVC + (size_t)row * KVW;
        const h16x4 raw = *(const h16x4*)(kr + 4 * lane);
        float v[4]; float ss = 0.f;
#pragma unroll
        for (int e = 0; e < 4; ++e) { v[e] = (float)raw[e]; ss += v[e] * v[e]; }
        const float rstd = 1.0f / sqrtf(wave_sum(ss) * (1.0f / 256.0f) + EPS);
        const f32x4 g = *(const f32x4*)(P.g_kv + 4 * lane);
        u32x2 pk; pk.x = pk2h(v[0] * rstd * g[0], v[1] * rstd * g[1]); pk.y = pk2h(v[2] * rstd * g[2], v[3] * rstd * g[3]);
        *(u32x2*)(kr + 4 * lane) = pk;
        const float* sm = SMALL + (size_t)row * 128;
        if (lane < 32) {
            const int i = lane & 15; const float x1 = sm[i], x2 = sm[i + 16]; const float cv = r32[((size_t)pos * 16 + i) * 2], sv = r32[((size_t)pos * 16 + i) * 2 + 1];
            kr[256 + lane] = (h16)(lane < 16 ? x1 * cv - x2 * sv : x2 * cv + x1 * sv);
        }
        {
            float o = sm[32 + lane];
            if (lane < 16) { const int i = lane & 7; const float x1 = sm[32 + i], x2 = sm[32 + i + 8]; const float cv = r16[((size_t)pos * 8 + i) * 2], sv = r16[((size_t)pos * 8 + i) * 2 + 1];
                o = lane < 8 ? x1 * cv - x2 * sv : x2 * cv + x1 * sv; }
            KIDX[(size_t)row * 64 + lane] = (h16)o;
        }
        if (lane < 16) WIDX[(size_t)row * 16 + lane] = sm[96 + lane] * (1.0f / 32.0f);
    }
}
__device__ __forceinline__ void phase_final(const Params& P, LAS unsigned char* lds) {
    const int tid = threadIdx.x, lane = tid & 63, w = tid >> 6;
    LAS float* gate = (LAS float*)lds;
    const h16* Y = (const h16*)(P.ws + WS_Y); const float* SSY = (const float*)(P.ws + WS_SSY);
    for (int ch = blockIdx.x; ch < 256; ch += gridDim.x) {
        const int b = ch >> 6;
        __syncthreads();
        load_mod(P, b, 4096, gate, false);
        __syncthreads();
        for (int i = 0; i < 8; i += 2) {
            const int row0 = ch * 64 + w * 8 + i;
            float ss = SSY[(size_t)row0 * 32 + lane];
#pragma unroll
            for (int o = 1; o < 32; o <<= 1) ss += __shfl_xor(ss, o);
            const float rstd_mine = __builtin_amdgcn_rsqf(ss * (1.0f / DM) + EPS);
            const float rstd0 = __shfl(rstd_mine, 0), rstd1 = __shfl(rstd_mine, 32);
            f32x4 xv[2][8]; h16x4 yv[2][8];
#pragma unroll
            for (int rr = 0; rr < 2; ++rr)
#pragma unroll
                for (int j = 0; j < 8; ++j) { const int col = 4 * lane + 256 * j;
                    xv[rr][j] = __builtin_nontemporal_load((const f32x4*)(P.x + (size_t)(row0 + rr) * DM + col)); yv[rr][j] = *(const h16x4*)(Y + (size_t)(row0 + rr) * DM + col); }
#pragma unroll
            for (int rr = 0; rr < 2; ++rr) { const float rstd = rr ? rstd1 : rstd0;
#pragma unroll
                for (int j = 0; j < 8; ++j) { const int col = 4 * lane + 256 * j;
                    const f32x4 g = *(const f32x4*)(P.g_post + col), gt = *(const LAS f32x4*)(gate + col);
                    f32x4 o;
#pragma unroll
                    for (int e = 0; e < 4; ++e) o[e] = xv[rr][j][e] + gt[e] * ((float)yv[rr][j][e] * rstd * g[e]);
                    __builtin_nontemporal_store(o, (f32x4*)(P.out + (size_t)(row0 + rr) * DM + col)); } }
        }
    }
}


constexpr int SP_PITCH = 592;
constexpr int SP_BUF = 32 * SP_PITCH;
constexpr int SP_LIST = 8 * SP_BUF;
__device__ __forceinline__ void sparse_attn_query(const Params& P, LAS unsigned char* lds, int wid, int lane, int b, int row, int kvalid, const LAS unsigned short* list);
typedef float f32x16 __attribute__((ext_vector_type(16)));
typedef short s16x4 __attribute__((ext_vector_type(4)));
__device__ __forceinline__ unsigned imgb_off(unsigned row, unsigned ch) { return 256u * row + 16u * (ch ^ (((row & 3u) << 2) | ((row >> 2) & 3u))); }
constexpr int DIL_STG = 98304, DIL_LSE = DIL_STG + 8 * 4608;
__device__ __forceinline__ void dil_load(u32x4 (&rg)[12], const h16* src_bh, int m0, int dil, int res, int tid) {
#pragma unroll
    for (int p = 0; p < 12; ++p) {
        const int kk = p * 32 + (tid >> 4); int j = m0 - 128 + kk; j = j < 0 ? 0 : j;
        const unsigned sw = (unsigned)(((kk & 3) << 2) | ((kk >> 2) & 3));
        rg[p] = *(const u32x4*)(src_bh + (size_t)(j * dil + res) * 1024 + 8 * ((unsigned)(tid & 15) ^ sw));
    }
}
__device__ __forceinline__ void dil_write(LAS unsigned char* lds, const u32x4 (&rg)[12], int tid) {
#pragma unroll
    for (int p = 0; p < 12; ++p) *(LAS u32x4*)(lds + p * 8192 + tid * 16) = rg[p];
}
struct DilUnit { int dil, pslot, b, h, res, blk; };
template <bool LAST>
__device__ __forceinline__ void dilated_unit(const Params& P, LAS unsigned char* lds, const DilUnit u, u32x4 (&kv)[12], const DilUnit nxt, bool has_next) {
    const int dil = u.dil, pslot = u.pslot, b = u.b, h = u.h, res = u.res, blk = u.blk;
    const int tid = threadIdx.x, lane = tid & 63, wid = __builtin_amdgcn_readfirstlane(tid >> 6), n = lane & 31, hi = lane >> 5;
    const int m0 = blk * 256;
    const size_t bh = (size_t)b * SEQ * 1024 + h * 128;
    const h16* QBp = (const h16*)(P.ws + WS_QB) + bh; const h16* VBp = (const h16*)(P.ws + WS_VB) + bh;
    PROF_B(10);
    dil_write(lds, kv, tid);
    dil_load(kv, VBp, m0, dil, res, tid);
    h16x8 qf[8];
    { const h16* qp = QBp + (size_t)((m0 + 32 * wid + n) * dil + res) * 1024 + 8 * hi;
#pragma unroll
      for (int ks = 0; ks < 8; ++ks) qf[ks] = *(const h16x8*)(qp + 16 * ks); }
    __syncthreads();
    PROF_E(10); PROF_B(11);
    f32x16 sa[5];
#pragma unroll
    for (int ti = 0; ti < 5; ++ti) {
#pragma unroll
        for (int r = 0; r < 16; ++r) sa[ti][r] = 0.f;
#pragma unroll
        for (int ks = 0; ks < 8; ++ks) { const h16x8 kf = *(const LAS h16x8*)(lds + imgb_off(32 * (wid + ti) + n, 2 * ks + hi));
            sa[ti] = __builtin_amdgcn_mfma_f32_32x32x16_f16(kf, qf[ks], sa[ti], 0, 0, 0); }
    }
    PROF_E(11); PROF_B(12);
    const int jmin = 128 - m0;
    float mx = -INFINITY;
#pragma unroll
    for (int ti = 0; ti < 5; ++ti)
#pragma unroll
        for (int r = 0; r < 16; ++r) { const int kin = (r & 3) + 8 * (r >> 2) + 4 * hi; bool ok = (32 * (wid + ti) + kin) >= jmin;
            if (ti == 0) ok = ok && (kin >= n); if (ti == 4) ok = ok && (kin <= n);
            const float s = ok ? sa[ti][r] : -INFINITY; sa[ti][r] = s; mx = fmaxf(mx, s); }
    mx = fmaxf(mx, __shfl_xor(mx, 32));
    float l = 0.f;
#pragma unroll
    for (int ti = 0; ti < 5; ++ti)
#pragma unroll
        for (int r = 0; r < 16; ++r) { const float p = __builtin_amdgcn_exp2f(sa[ti][r] - mx); sa[ti][r] = p; l += p; }
    l += __shfl_xor(l, 32);
    h16x8 pf[5][2];
#pragma unroll
    for (int ti = 0; ti < 5; ++ti)
#pragma unroll
        for (int s = 0; s < 2; ++s)
#pragma unroll
            for (int jj = 0; jj < 8; ++jj) pf[ti][s][jj] = (h16)sa[ti][8 * s + jj];
    PROF_E(12); PROF_B(13);
    __syncthreads();
    dil_write(lds, kv, tid);
    if (has_next) dil_load(kv, (const h16*)(P.ws + WS_KB) + (size_t)nxt.b * SEQ * 1024 + nxt.h * 128, nxt.blk * 256, nxt.dil, nxt.res, tid);
    __syncthreads();
    PROF_E(13); PROF_B(14);
    f32x16 oa[4];
#pragma unroll
    for (int c = 0; c < 4; ++c)
#pragma unroll
        for (int r = 0; r < 16; ++r) oa[c][r] = 0.f;
    const int dgrp = (lane >> 4) & 1, q4 = (lane & 15) >> 2, p4 = lane & 3;
#pragma unroll
    for (int ti = 0; ti < 5; ++ti)
#pragma unroll
        for (int s = 0; s < 2; ++s) {
#pragma unroll
            for (int c = 0; c < 4; ++c) {
                const unsigned row0 = 32 * (wid + ti) + 16 * s + 4 * hi + q4, ch = 4 * c + 2 * dgrp + (p4 >> 1);
                const s16x4 t0 = __builtin_amdgcn_ds_read_tr16_b64_v4i16((LAS s16x4*)(lds + imgb_off(row0, ch) + 8 * (p4 & 1)));
                const s16x4 t1 = __builtin_amdgcn_ds_read_tr16_b64_v4i16((LAS s16x4*)(lds + imgb_off(row0 + 8, ch) + 8 * (p4 & 1)));
                typedef short s16x8 __attribute__((ext_vector_type(8)));
                const s16x8 v8 = {t0[0], t0[1], t0[2], t0[3], t1[0], t1[1], t1[2], t1[3]};
                oa[c] = __builtin_amdgcn_mfma_f32_32x32x16_f16(__builtin_bit_cast(h16x8, v8), pf[ti][s], oa[c], 0, 0, 0);
            }
        }
    PROF_E(14); PROF_B(15);
    const float invl = 1.0f / l, lse = mx + __builtin_amdgcn_logf(l);
    LAS unsigned char* stg = lds + DIL_STG + wid * 4608;
    LAS float* lsew = (LAS float*)(lds + DIL_LSE) + wid * 32;
    float* LSEP = (float*)(P.ws + WS_LSEP);
    const int pos_n = (m0 + 32 * wid + n) * dil + res;
    if (LAST) { if (hi == 0) lsew[n] = lse; }
    else if (hi == 0) LSEP[((size_t)pslot * T + (size_t)b * SEQ + pos_n) * 8 + h] = lse;
#pragma unroll
    for (int half = 0; half < 2; ++half) {
#pragma unroll
        for (int cc = 0; cc < 2; ++cc)
#pragma unroll
            for (int rg = 0; rg < 4; ++rg) { const f32x16& o = oa[2 * half + cc]; u32x2 w2; w2.x = pk2h(o[4 * rg] * invl, o[4 * rg + 1] * invl); w2.y = pk2h(o[4 * rg + 2] * invl, o[4 * rg + 3] * invl);
                *(LAS u32x2*)(stg + n * 144 + 2 * (32 * cc + 8 * rg + 4 * hi)) = w2; }
        h16x8 m4[4], m16[4], mg[4]; float ml4[4], ml16[4];
        if (LAST) {
#pragma unroll
            for (int i = 0; i < 4; ++i) { const int rowl = (lane >> 3) + 8 * i; const size_t grow = (size_t)b * SEQ + (size_t)((m0 + 32 * wid + rowl) * dil + res); const size_t coff = (size_t)h * 128 + 64 * half + 8 * (lane & 7);
                m4[i] = *(const h16x8*)((const h16*)(P.ws + WS_OP4) + grow * 1024 + coff); m16[i] = *(const h16x8*)((const h16*)(P.ws + WS_OP16) + grow * 1024 + coff);
                mg[i] = *(const h16x8*)((const h16*)(P.ws + WS_SGB) + grow * 1024 + coff); ml4[i] = LSEP[grow * 8 + h]; ml16[i] = LSEP[((size_t)T + grow) * 8 + h]; }
        }
        asm volatile("s_waitcnt lgkmcnt(0)" ::: "memory");
#pragma unroll
        for (int i = 0; i < 4; ++i) {
            const int rowl = (lane >> 3) + 8 * i, ch = lane & 7;
            const u32x4 v = *(const LAS u32x4*)(stg + rowl * 144 + 16 * ch);
            const size_t grow = (size_t)b * SEQ + (size_t)((m0 + 32 * wid + rowl) * dil + res);
            const size_t coff = (size_t)h * 128 + 64 * half + 8 * ch;
            if (!LAST) { *(u32x4*)((h16*)(P.ws + (pslot ? WS_OP16 : WS_OP4)) + grow * 1024 + coff) = v; }
            else {
                const float l1 = lsew[rowl], l4 = ml4[i], l16 = ml16[i];
                const float mm = fmaxf(l1, fmaxf(l4, l16));
                const float w1 = __builtin_amdgcn_exp2f(l1 - mm), w4 = __builtin_amdgcn_exp2f(l4 - mm), w16 = __builtin_amdgcn_exp2f(l16 - mm), iw = 1.0f / (w1 + w4 + w16);
                const h16x8 o1 = __builtin_bit_cast(h16x8, v);
                float r8[8];
#pragma unroll
                for (int e = 0; e < 8; ++e) r8[e] = (w1 * (float)o1[e] + w4 * (float)m4[i][e] + w16 * (float)m16[i][e]) * iw * (float)mg[i][e];
                u32x4 ov; ov.x = pk2h(r8[0], r8[1]); ov.y = pk2h(r8[2], r8[3]); ov.z = pk2h(r8[4], r8[5]); ov.w = pk2h(r8[6], r8[7]);
                *(u32x4*)((h16*)(P.ws + WS_OAB) + grow * 2048 + 1024 + coff) = ov;
            }
        }
        asm volatile("s_waitcnt lgkmcnt(0)" ::: "memory");
    }
    __syncthreads();
    PROF_E(15);
}
__device__ __forceinline__ DilUnit dil_part_unit(int idx) {
    const int cfg = idx >> 9, w_ = idx & 511, xcd = w_ & 7, lu = w_ >> 3, bhh = xcd * 4 + (lu >> 4), rb = lu & 15;
    DilUnit u; u.b = bhh >> 3; u.h = bhh & 7;
    if (cfg == 0) { u.dil = 4; u.pslot = 0; u.res = rb & 3; u.blk = rb >> 2; } else { u.dil = 16; u.pslot = 1; u.res = rb; u.blk = 0; }
    return u;
}
__device__ __forceinline__ DilUnit dil_last_unit(int idx) {
    const int xcd = idx & 7, lu = idx >> 3, bhh = xcd * 4 + (lu >> 4);
    DilUnit u; u.b = bhh >> 3; u.h = bhh & 7; u.dil = 1; u.pslot = 0; u.res = 0; u.blk = lu & 15;
    return u;
}
__device__ __forceinline__ void phase_dilated_part(const Params& P, LAS unsigned char* lds) {
    int idx = blockIdx.x; if (idx >= 1024) return;
    u32x4 kv[12];
    DilUnit u = dil_part_unit(idx);
    dil_load(kv, (const h16*)(P.ws + WS_KB) + (size_t)u.b * SEQ * 1024 + u.h * 128, u.blk * 256, u.dil, u.res, threadIdx.x);
    for (;;) {
        const int nidx = idx + gridDim.x; const bool hn = nidx < 1024; const DilUnit nu = dil_part_unit(hn ? nidx : idx);
        dilated_unit<false>(P, lds, u, kv, nu, hn);
        if (!hn) break;
        idx = nidx; u = nu;
    }
}
__device__ __forceinline__ void phase_dilated_last(const Params& P, LAS unsigned char* lds) {
    int idx = blockIdx.x; if (idx >= 512) return;
    u32x4 kv[12];
    DilUnit u = dil_last_unit(idx);
    dil_load(kv, (const h16*)(P.ws + WS_KB) + (size_t)u.b * SEQ * 1024 + u.h * 128, u.blk * 256, u.dil, u.res, threadIdx.x);
    for (;;) {
        const int nidx = idx + gridDim.x; const bool hn = nidx < 512; const DilUnit nu = dil_last_unit(hn ? nidx : idx);
        dilated_unit<true>(P, lds, u, kv, nu, hn);
        if (!hn) break;
        idx = nidx; u = nu;
    }
}

__device__ __forceinline__ void sparse_attn_query(const Params& P, LAS unsigned char* lds, int wid, int lane_in, int b, int row, int kvalid, const LAS unsigned short* list) {
    int lane = lane_in; asm volatile("" : "+v"(lane));
    LAS unsigned char* buf = lds + wid * SP_BUF;
    const int n = lane & 15, g = lane >> 4, q4 = n >> 2, p4 = n & 3, sub = lane >> 2, c4 = lane & 3;
    PROF_B(30);
    h16x8 qf[9];
    {
        const h16* ql = (const h16*)(P.ws + WS_QLAT) + ((size_t)row * 8 + (n & 7)) * 256 + 8 * g;
        const h16* qr = (const h16*)(P.ws + WS_QROPE) + ((size_t)row * 8 + (n & 7)) * 32 + 8 * g;
        const h16x8 z = {(h16)0.f, (h16)0.f, (h16)0.f, (h16)0.f, (h16)0.f, (h16)0.f, (h16)0.f, (h16)0.f};
#pragma unroll
        for (int ks = 0; ks < 8; ++ks) { const h16x8 v = *(const h16x8*)(ql + 32 * ks); qf[ks] = (n < 8) ? v : z; }
        { const h16x8 v = *(const h16x8*)qr; qf[8] = (n < 8) ? v : z; }
    }
    f32x4 oacc[16];
#pragma unroll
    for (int dt = 0; dt < 16; ++dt) oacc[dt] = (f32x4){0.f, 0.f, 0.f, 0.f};
    float m = -INFINITY, l = 0.f;
    const unsigned char* kvb = P.ws + WS_KVC + (size_t)b * SEQ * (KVW * 2) + 16 * c4;
    u32x4 stg[18];
#define SP_ISSUE(step_) do { unsigned i0 = list[32 * (step_) + sub], i1 = list[32 * (step_) + 16 + sub]; i0 = (i0 == 0xFFFFu) ? 0u : i0; i1 = (i1 == 0xFFFFu) ? 0u : i1; \
        const unsigned char* r0 = kvb + (size_t)i0 * 576; const unsigned char* r1 = kvb + (size_t)i1 * 576; \
        _Pragma("unroll") for (int cg = 0; cg < 9; ++cg) { stg[2 * cg] = *(const u32x4*)(r0 + 64 * cg); stg[2 * cg + 1] = *(const u32x4*)(r1 + 64 * cg); } } while (0)
    SP_ISSUE(0);
    PROF_E(30);
    for (int step = 0; step < 8; ++step) {
        PROF_B(31);
#pragma unroll
        for (int cg = 0; cg < 9; ++cg) { *(LAS u32x4*)(buf + SP_PITCH * sub + 64 * cg + 16 * c4) = stg[2 * cg]; *(LAS u32x4*)(buf + SP_PITCH * (16 + sub) + 64 * cg + 16 * c4) = stg[2 * cg + 1]; }
        if (step < 7) SP_ISSUE(step + 1);
        asm volatile("s_waitcnt lgkmcnt(0)" ::: "memory");
        PROF_E(31); PROF_B(32);
        f32x4 s0 = (f32x4){0.f, 0.f, 0.f, 0.f}, s1 = (f32x4){0.f, 0.f, 0.f, 0.f};
#pragma unroll
        for (int ks = 0; ks < 9; ++ks) {
            const h16x8 a0 = *(const LAS h16x8*)(buf + SP_PITCH * n + 64 * ks + 16 * g), a1 = *(const LAS h16x8*)(buf + SP_PITCH * (16 + n) + 64 * ks + 16 * g);
            s0 = __builtin_amdgcn_mfma_f32_16x16x32_f16(a0, qf[ks], s0, 0, 0, 0); s1 = __builtin_amdgcn_mfma_f32_16x16x32_f16(a1, qf[ks], s1, 0, 0, 0);
        }
        PROF_E(32); PROF_B(33);
        float mx = -INFINITY;
#pragma unroll
        for (int r = 0; r < 4; ++r) { const int lp = 32 * step + 4 * g + r;
            s0[r] = (lp < kvalid) ? s0[r] : -INFINITY; s1[r] = (lp + 16 < kvalid) ? s1[r] : -INFINITY; mx = fmaxf(mx, fmaxf(s0[r], s1[r])); }
        mx = fmaxf(mx, __shfl_xor(mx, 16)); mx = fmaxf(mx, __shfl_xor(mx, 32));
        if (__builtin_amdgcn_ballot_w64(mx > m + 8.0f) != 0ull) {
            const float mnew = fmaxf(m, mx), alpha = __builtin_amdgcn_exp2f(m - mnew);
            m = mnew; l *= alpha;
#pragma unroll
            for (int dt = 0; dt < 16; ++dt) oacc[dt] = oacc[dt] * alpha;
        }
        h16x8 pf;
#pragma unroll
        for (int r = 0; r < 4; ++r) { const float p0 = __builtin_amdgcn_exp2f(s0[r] - m), p1 = __builtin_amdgcn_exp2f(s1[r] - m); l += p0 + p1; pf[r] = (h16)p0; pf[4 + r] = (h16)p1; }
        PROF_E(33); PROF_B(34);
#pragma unroll
        for (int dt = 0; dt < 16; ++dt) {
            const s16x4 t0 = __builtin_amdgcn_ds_read_tr16_b64_v4i16((LAS s16x4*)(buf + SP_PITCH * (4 * g + q4) + 32 * dt + 8 * p4));
            const s16x4 t1 = __builtin_amdgcn_ds_read_tr16_b64_v4i16((LAS s16x4*)(buf + SP_PITCH * (16 + 4 * g + q4) + 32 * dt + 8 * p4));
            typedef short s16x8 __attribute__((ext_vector_type(8)));
            const s16x8 v8 = {t0[0], t0[1], t0[2], t0[3], t1[0], t1[1], t1[2], t1[3]};
            oacc[dt] = __builtin_amdgcn_mfma_f32_16x16x32_f16(__builtin_bit_cast(h16x8, v8), pf, oacc[dt], 0, 0, 0);
        }
        asm volatile("s_waitcnt lgkmcnt(0)" ::: "memory");
        PROF_E(34);
    }
#undef SP_ISSUE
    PROF_B(35);
    l += __shfl_xor(l, 16); l += __shfl_xor(l, 32);
    const float inv = 1.0f / l;
    if (n < 8) {
        h16* op = (h16*)(P.ws + WS_OLAT) + ((size_t)row * 8 + n) * 256 + 4 * g;
#pragma unroll
        for (int dt = 0; dt < 16; ++dt) { u32x2 w2; w2.x = pk2h(oacc[dt][0] * inv, oacc[dt][1] * inv); w2.y = pk2h(oacc[dt][2] * inv, oacc[dt][3] * inv); *(u32x2*)(op + 16 * dt) = w2; }
    }
    PROF_E(35);
}

constexpr int DS_QI = 0;
constexpr int DS_WQ = 36864;
constexpr int DS_CNTB = DS_WQ + 1024;
constexpr int DS_CGT = DS_CNTB + 1024;
constexpr int DS_CEQ = DS_CGT + 512;
constexpr int DS_PCNT = DS_CEQ + 512;
constexpr int DS_TCNT = DS_PCNT + 2048;
constexpr int DS_TLIST = DS_TCNT + 64;
constexpr int DS_TSC = DS_TLIST + 2048;
constexpr int DS_TK = DS_TSC + 4096;
constexpr int DS_LIST = SP_LIST;
constexpr int TIE_CAP = 64, TIE_FAST = 16;
__device__ __forceinline__ unsigned sortable_hi16(float s) { const unsigned bits = __float_as_uint(s + 0.0f); return ((bits & 0x80000000u) ? ~bits : (bits | 0x80000000u)) >> 16; }
typedef _Float16 h16x2v __attribute__((ext_vector_type(2)));
__device__ __forceinline__ unsigned pk_count_gt(unsigned acc, unsigned v, unsigned cm1pk) {
    unsigned d;
    asm("v_pk_sub_u16 %1, %2, %3 clamp\n\tv_pk_min_u16 %1, %1, %4\n\tv_pk_add_u16 %0, %0, %1" : "+v"(acc), "=&v"(d) : "v"(v), "v"(cm1pk), "v"(0x00010001u));
    return acc;
}
__device__ __forceinline__ unsigned pk_mask_gt(unsigned m, unsigned v, unsigned cm1pk) {
    unsigned d;
    asm("v_pk_sub_u16 %1, %2, %3 clamp\n\tv_pk_min_u16 %1, %1, %4\n\tv_lshl_or_b32 %0, %0, 1, %1" : "+v"(m), "=&v"(d) : "v"(v), "v"(cm1pk), "v"(0x00010001u));
    return m;
}
__device__ __forceinline__ void dsa_score_group(LAS unsigned char* lds, const h16x8 (&kf)[4][2], int grp, int w, int q, int kq, int tq, int ntile, unsigned (&c8)[8]) {
    const unsigned sw = (unsigned)((q >> 1) & 7);
    const LAS float* WQ = (const LAS float*)(lds + DS_WQ);
    const LAS unsigned char* qrow = lds + DS_QI + q * 128;
    const unsigned o0 = 16u * ((unsigned)kq ^ sw), o1 = 16u * ((unsigned)(4 + kq) ^ sw);
    const f32x4 zero4 = {0.f, 0.f, 0.f, 0.f};
    f32x4 acc[4];
    {
        const h16x8 a0 = *(const LAS h16x8*)(qrow + 16 * 2048 + o0), a1 = *(const LAS h16x8*)(qrow + 16 * 2048 + o1), b0 = *(const LAS h16x8*)(qrow + 17 * 2048 + o0), b1 = *(const LAS h16x8*)(qrow + 17 * 2048 + o1);
#pragma unroll
        for (int j = 0; j < 4; ++j) { acc[j] = __builtin_amdgcn_mfma_f32_16x16x32_f16(kf[j][0], a0, zero4, 0, 0, 0); acc[j] = __builtin_amdgcn_mfma_f32_16x16x32_f16(kf[j][1], a1, acc[j], 0, 0, 0);
            acc[j] = __builtin_amdgcn_mfma_f32_16x16x32_f16(kf[j][0], b0, acc[j], 0, 0, 0); acc[j] = __builtin_amdgcn_mfma_f32_16x16x32_f16(kf[j][1], b1, acc[j], 0, 0, 0); }
    }
#define DSA_MM(lg, qa, qb) do { _Pragma("unroll") for (int j = 0; j < 4; ++j) lg[j] = __builtin_amdgcn_mfma_f32_16x16x32_f16(kf[j][0], qa, zero4, 0, 0, 0); \
        _Pragma("unroll") for (int j = 0; j < 4; ++j) lg[j] = __builtin_amdgcn_mfma_f32_16x16x32_f16(kf[j][1], qb, lg[j], 0, 0, 0); } while (0)
#define DSA_ACC(lg, wv) do { _Pragma("unroll") for (int j = 0; j < 4; ++j) _Pragma("unroll") for (int r = 0; r < 4; ++r) \
        asm volatile("v_fma_f32 %0, |%1|, %2, %0" : "+v"(acc[j][r]) : "v"(lg[j][r]), "v"(wv)); } while (0)
    f32x4 lgA[4], lgB[4];
    h16x8 qa0 = *(const LAS h16x8*)(qrow + o0), qa1 = *(const LAS h16x8*)(qrow + o1); float wa = WQ[q * 16];
    h16x8 qb0 = *(const LAS h16x8*)(qrow + 2048 + o0), qb1 = *(const LAS h16x8*)(qrow + 2048 + o1); float wb = WQ[q * 16 + 1];
    DSA_MM(lgA, qa0, qa1);
    for (int h = 0; h < 16; h += 2) {
        __builtin_amdgcn_sched_barrier(0);
        DSA_MM(lgB, qb0, qb1);
        const int h2 = (h + 2) & 15, h3 = (h + 3) & 15;
        qa0 = *(const LAS h16x8*)(qrow + h2 * 2048 + o0); qa1 = *(const LAS h16x8*)(qrow + h2 * 2048 + o1); const float wa2 = WQ[q * 16 + h2];
        __builtin_amdgcn_sched_barrier(0);
        DSA_ACC(lgA, wa);
        __builtin_amdgcn_sched_barrier(0);
        if (h < 14) DSA_MM(lgA, qa0, qa1);
        qb0 = *(const LAS h16x8*)(qrow + h3 * 2048 + o0); qb1 = *(const LAS h16x8*)(qrow + h3 * 2048 + o1); const float wb2 = WQ[q * 16 + h3];
        __builtin_amdgcn_sched_barrier(0);
        if (h >= 14) asm volatile("s_nop 7\n\ts_nop 7" ::: );
        DSA_ACC(lgB, wb);
        wa = wa2; wb = wb2;
    }
#undef DSA_MM
#undef DSA_ACC
    const int tt0 = w + 32 * grp;
#pragma unroll
    for (int j = 0; j < 4; ++j) { const int tt = tt0 + 8 * j; unsigned c4[4];
#pragma unroll
        for (int r = 0; r < 4; ++r) { const int k = 16 * tt + 4 * kq + r; c4[r] = (tt < ntile && k <= tq) ? sortable_hi16(acc[j][r]) : 0u; }
        c8[j * 2] = c4[0] | (c4[1] << 16); c8[j * 2 + 1] = c4[2] | (c4[3] << 16); }
}

__device__ __forceinline__ void dsa_select_unit(const Params& P, LAS unsigned char* lds, int b, int uq, int stages = 9) {
    int tid = threadIdx.x; asm volatile("" : "+v"(tid));
    const int lane = tid & 63, w = __builtin_amdgcn_readfirstlane(tid >> 6), q = lane & 15, kq = lane >> 4;
    const int t0 = 16 * uq, row0 = b * SEQ + t0, tq = t0 + q, ntile = uq + 1, Kq = (tq + 1 < 256) ? tq + 1 : 256;
    const h16* QIDX = (const h16*)(P.ws + WS_QIDX); const h16* KIDX = (const h16*)(P.ws + WS_KIDX) + (size_t)b * SEQ * 64; const float* WIDX = (const float*)(P.ws + WS_WIDX);
    LAS float* WQ = (LAS float*)(lds + DS_WQ); LAS unsigned* CNTB = (LAS unsigned*)(lds + DS_CNTB); LAS unsigned* CGT = (LAS unsigned*)(lds + DS_CGT); LAS unsigned* CEQ = (LAS unsigned*)(lds + DS_CEQ);
    LAS unsigned* PCNT = (LAS unsigned*)(lds + DS_PCNT); LAS unsigned* TCNT = (LAS unsigned*)(lds + DS_TCNT); LAS unsigned short* TLIST = (LAS unsigned short*)(lds + DS_TLIST);
    LAS float* TSC = (LAS float*)(lds + DS_TSC); LAS unsigned short* LIST = (LAS unsigned short*)(lds + DS_LIST);
    PROF_B(20);
#pragma unroll
    for (int i = 0; i < 4; ++i) { const int pc = 4 * w + i, head = pc >> 1, r = 8 * (pc & 1) + (lane >> 3), c = lane & 7;
        __builtin_amdgcn_global_load_lds((const unsigned*)(QIDX + (size_t)(row0 + r) * 1024 + head * 64 + 8 * (c ^ ((r >> 1) & 7))), (LAS unsigned*)(lds + DS_QI + pc * 1024), 16, 0, 0); }
    {
        const int r = tid >> 5, d2 = tid & 31; float a0 = 0.f, a1 = 0.f;
        const h16* qp = QIDX + (size_t)(row0 + r) * 1024 + 2 * d2; const float* wp = WIDX + (size_t)(row0 + r) * 16;
#pragma unroll
        for (int h = 0; h < 16; ++h) { const h16x2v qv = *(const h16x2v*)(qp + h * 64); const float wv = wp[h]; a0 += wv * (float)qv[0]; a1 += wv * (float)qv[1]; }
        const h16 h0 = (h16)a0, h1 = (h16)a1; const h16 l0 = (h16)(a0 - (float)h0), l1 = (h16)(a1 - (float)h1);
        const unsigned off = r * 128 + 16 * ((unsigned)(d2 >> 2) ^ (unsigned)((r >> 1) & 7)) + 4 * (d2 & 3);
        const h16x2v hv = {h0, h1}, lv = {l0, l1};
        *(LAS h16x2v*)(lds + DS_QI + 16 * 2048 + off) = hv; *(LAS h16x2v*)(lds + DS_QI + 17 * 2048 + off) = lv;
    }
    if (tid < 256) WQ[tid] = WIDX[(size_t)(row0 + (tid >> 4)) * 16 + (tid & 15)];
    if (tid < 16) TCNT[tid] = 0u;
    *(LAS u32x4*)(lds + DS_LIST + tid * 16) = (u32x4){0xFFFFFFFFu, 0xFFFFFFFFu, 0xFFFFFFFFu, 0xFFFFFFFFu};
    asm volatile("s_waitcnt vmcnt(0)" ::: "memory");
    __syncthreads();
    PROF_E(20); PROF_B(21);
    unsigned cs[64];
#pragma unroll
    for (int i = 0; i < 64; ++i) cs[i] = 0u;
    h16x8 kfA[4][2], kfB[4][2];
#define DSA_LOADK(kf, grp_) do { _Pragma("unroll") for (int j = 0; j < 4; ++j) { const int tt = w + 32 * (grp_) + 8 * j, ttc = tt < ntile ? tt : ntile - 1; \
        const h16* kp = KIDX + (size_t)(16 * ttc + q) * 64 + 8 * kq; kf[j][0] = *(const h16x8*)kp; kf[j][1] = *(const h16x8*)(kp + 32); } } while (0)
    DSA_LOADK(kfA, 0);
    for (int gp = 0; gp < 4; ++gp) {
        if (w + 64 * gp >= ntile) break;
        DSA_LOADK(kfB, 2 * gp + 1);
        unsigned ca[8], cb[8];
        dsa_score_group(lds, kfA, 2 * gp, w, q, kq, tq, ntile, ca);
        if (gp < 3) DSA_LOADK(kfA, 2 * gp + 2);
        if (w + 64 * gp + 32 < ntile) dsa_score_group(lds, kfB, 2 * gp + 1, w, q, kq, tq, ntile, cb);
        else {
#pragma unroll
            for (int i = 0; i < 8; ++i) cb[i] = 0u;
        }
#define CS_PUT(G) case G: _Pragma("unroll") for (int i = 0; i < 8; ++i) { cs[G * 16 + i] = ca[i]; cs[G * 16 + 8 + i] = cb[i]; } break;
        switch (gp) { CS_PUT(0) CS_PUT(1) CS_PUT(2) default: _Pragma("unroll") for (int i = 0; i < 8; ++i) { cs[48 + i] = ca[i]; cs[56 + i] = cb[i]; } break; }
#undef CS_PUT
    }
#undef DSA_LOADK
    if (stages < 2) { unsigned x = 0; _Pragma("unroll") for (int i = 0; i < 64; ++i) x ^= cs[i]; asm volatile("" :: "v"(x)); __syncthreads(); return; }
    PROF_E(21); PROF_B(22);
    unsigned thr = 0u; int nbits = 16;
    {
        unsigned mxp = 0u;
#pragma unroll
        for (int i = 0; i < 64; ++i) asm("v_pk_max_u16 %0, %0, %1" : "+v"(mxp) : "v"(cs[i]));
        unsigned mq = (mxp & 0xFFFFu) > (mxp >> 16) ? (mxp & 0xFFFFu) : (mxp >> 16);
        { const unsigned o1 = __shfl_xor(mq, 16); mq = mq > o1 ? mq : o1; const unsigned o2 = __shfl_xor(mq, 32); mq = mq > o2 ? mq : o2; }
        if (kq == 0) CNTB[w * 16 + q] = mq;
        __syncthreads();
#pragma unroll
        for (int ww = 0; ww < 8; ++ww) { const unsigned o = CNTB[ww * 16 + q]; mq = mq > o ? mq : o; }
        const unsigned base = mq > 511u ? mq - 511u : 0u, bm1 = base * 0x00010001u;
        unsigned c0 = 0u, c1 = 0u, c2 = 0u, c3 = 0u;
#pragma unroll
        for (int i = 0; i < 64; i += 4) { c0 = pk_count_gt(c0, cs[i], bm1); c1 = pk_count_gt(c1, cs[i + 1], bm1); c2 = pk_count_gt(c2, cs[i + 2], bm1); c3 = pk_count_gt(c3, cs[i + 3], bm1); }
        const unsigned cpp = (c0 + c1) + (c2 + c3); unsigned cin = (cpp & 0xFFFFu) + (cpp >> 16);
        cin += __shfl_xor(cin, 16); cin += __shfl_xor(cin, 32);
        if (kq == 0) CNTB[128 + w * 16 + q] = cin;
        __syncthreads();
        unsigned tin = 0u;
#pragma unroll
        for (int ww = 0; ww < 8; ++ww) tin += CNTB[128 + ww * 16 + q];
        const bool okq = tin >= (unsigned)Kq;
        if (tid == 0) CGT[0] = 0u;
        __syncthreads();
        if (!okq) CGT[0] = 1u;
        __syncthreads();
        if (CGT[0] == 0u) {
            nbits = 9;
#pragma unroll
            for (int i = 0; i < 64; ++i) asm("v_pk_sub_u16 %0, %0, %1 clamp" : "+v"(cs[i]) : "v"(bm1));
        }
        __syncthreads();
    }
    for (int bit = nbits - 1; bit >= 0; --bit) {
        const unsigned cand = thr | (1u << bit), cm1 = (cand - 1u) * 0x00010001u; unsigned cp0 = 0u, cp1 = 0u, cp2 = 0u, cp3 = 0u;
#pragma unroll
        for (int i = 0; i < 64; i += 4) { cp0 = pk_count_gt(cp0, cs[i], cm1); cp1 = pk_count_gt(cp1, cs[i + 1], cm1); cp2 = pk_count_gt(cp2, cs[i + 2], cm1); cp3 = pk_count_gt(cp3, cs[i + 3], cm1); }
        const unsigned cp = (cp0 + cp1) + (cp2 + cp3);
        unsigned cnt = (cp & 0xFFFFu) + (cp >> 16);
        cnt += __shfl_xor(cnt, 16); cnt += __shfl_xor(cnt, 32);
        LAS unsigned* cb = CNTB + (bit & 1) * 128;
        if (kq == 0) cb[w * 16 + q] = cnt;
        __syncthreads();
        unsigned tot = 0u;
#pragma unroll
        for (int ww = 0; ww < 8; ++ww) tot += cb[ww * 16 + q];
        if (tot >= (unsigned)Kq) thr = cand;
    }
    if (stages < 3) { asm volatile("" :: "v"(thr)); __syncthreads(); return; }
    PROF_E(22); PROF_B(23);
    unsigned mg[4], me[4];
    {
        const unsigned t0p = thr * 0x00010001u, t1p = (thr - 1u) * 0x00010001u;
#pragma unroll
        for (int j = 0; j < 4; ++j) { unsigned g_ = 0u, e_ = 0u;
#pragma unroll
            for (int ii = 0; ii < 16; ++ii) { g_ = pk_mask_gt(g_, cs[16 * j + ii], t0p); e_ = pk_mask_gt(e_, cs[16 * j + ii], t1p); }
            mg[j] = g_; me[j] = e_ & ~g_; }
    }
    const unsigned cgt = __popc(mg[0]) + __popc(mg[1]) + __popc(mg[2]) + __popc(mg[3]), ceq = __popc(me[0]) + __popc(me[1]) + __popc(me[2]) + __popc(me[3]);
    PCNT[w * 64 + lane] = cgt;
    unsigned cgw = cgt, cew = ceq;
    cgw += __shfl_xor(cgw, 16); cgw += __shfl_xor(cgw, 32); cew += __shfl_xor(cew, 16); cew += __shfl_xor(cew, 32);
    if (kq == 0) { CGT[w * 16 + q] = cgw; CEQ[w * 16 + q] = cew; }
    __syncthreads();
    unsigned gt_tot = 0u, eq_tot = 0u, base = 0u;
#pragma unroll
    for (int ww = 0; ww < 8; ++ww) { gt_tot += CGT[ww * 16 + q]; eq_tot += CEQ[ww * 16 + q]; }
    for (int ww = 0; ww < 8; ++ww)
#pragma unroll
        for (int kk = 0; kk < 4; ++kk) { const unsigned v = PCNT[ww * 64 + kk * 16 + q]; base += (ww < w || (ww == w && kk < kq)) ? v : 0u; }
    const unsigned need = (unsigned)Kq - gt_tot;
    {
        LAS unsigned short* lq = LIST + q * 256; unsigned pos = base;
#pragma unroll
        for (int j = 0; j < 4; ++j) {
            unsigned m_ = mg[j];
            while (__builtin_amdgcn_ballot_w64(m_ != 0u) != 0ull) {
                if (m_ != 0u) { const int bt = 31 - __builtin_clz(m_); const int hf = bt >> 4, i = 16 * j + 15 - (bt & 15); const int grp = i >> 3, jj = (i >> 1) & 3, r = 2 * (i & 1) + hf;
                    lq[pos] = (unsigned short)(16 * (w + 32 * grp + 8 * jj) + 4 * kq + r); ++pos; m_ &= ~(1u << bt); }
            }
            unsigned e_ = me[j];
            while (__builtin_amdgcn_ballot_w64(e_ != 0u) != 0ull) {
                if (e_ != 0u) { const int bt = 31 - __builtin_clz(e_); const int hf = bt >> 4, i = 16 * j + 15 - (bt & 15); const int grp = i >> 3, jj = (i >> 1) & 3, r = 2 * (i & 1) + hf;
                    const unsigned slot = __hip_atomic_fetch_add(&TCNT[q], 1u, __ATOMIC_RELAXED, __HIP_MEMORY_SCOPE_WORKGROUP);
                    if (slot < (unsigned)TIE_CAP) TLIST[q * TIE_CAP + slot] = (unsigned short)(16 * (w + 32 * grp + 8 * jj) + 4 * kq + r);
                    e_ &= ~(1u << bt); }
            }
        }
    }
    __syncthreads();
    if (stages < 4) return;
    PROF_E(23); PROF_B(24);
    {
        LAS unsigned char* tk = lds + DS_TK + w * 4096;
        unsigned nt0 = TCNT[w], nt1 = TCNT[w + 8]; nt0 = nt0 < (unsigned)TIE_CAP ? nt0 : (unsigned)TIE_CAP; nt1 = nt1 < (unsigned)TIE_CAP ? nt1 : (unsigned)TIE_CAP;
        const bool fast = (nt0 <= (unsigned)TIE_FAST) && (nt1 <= (unsigned)TIE_FAST);
        if (fast) {
            u32x4 kr[4];
#pragma unroll
            for (int i = 0; i < 4; ++i) { const int qi = i >> 1, ti = 8 * (i & 1) + (lane >> 3); const unsigned nt = qi ? nt1 : nt0; const unsigned key = ((unsigned)ti < nt) ? TLIST[(w + 8 * qi) * TIE_CAP + ti] : 0u;
                kr[i] = *(const u32x4*)(KIDX + (size_t)key * 64 + 8 * (lane & 7)); }
#pragma unroll
            for (int i = 0; i < 4; ++i) *(LAS u32x4*)(tk + i * 1024 + lane * 16) = kr[i];
            asm volatile("s_waitcnt lgkmcnt(0)" ::: "memory");
        }
        for (int qi = 0; qi < 2; ++qi) {
            const int ql = w + 8 * qi;
            const unsigned ntie = qi ? nt1 : nt0;
            const unsigned gtq = __shfl(gt_tot, ql), needq = __shfl(need, ql);
            const int hh = lane & 15, jj = lane >> 4;
            const LAS unsigned char* qb = lds + DS_QI + hh * 2048 + ql * 128; const unsigned swq = (unsigned)((ql >> 1) & 7);
            const float wh = WQ[ql * 16 + hh];
            for (unsigned g0 = 0; g0 < ntie; g0 += 4) {
                const unsigned ti = g0 + jj; const unsigned key = (ti < ntie) ? TLIST[ql * TIE_CAP + ti] : 0u;
                float dt = 0.f;
#pragma unroll
                for (int c = 0; c < 8; ++c) {
                    h16x8 kv; if (fast) kv = *(const LAS h16x8*)(tk + qi * 2048 + (ti & 15) * 128 + 16 * c); else kv = *(const h16x8*)(KIDX + (size_t)key * 64 + 8 * c);
                    const h16x8 qv = *(const LAS h16x8*)(qb + 16 * ((unsigned)c ^ swq));
#pragma unroll
                    for (int e = 0; e < 8; e += 2) { const h16x2v a = {kv[e], kv[e + 1]}, bq = {qv[e], qv[e + 1]}; dt = __builtin_amdgcn_fdot2(a, bq, dt, false); } }
                float sc = wh * fmaxf(dt, 0.f);
                sc += __shfl_xor(sc, 1); sc += __shfl_xor(sc, 2); sc += __shfl_xor(sc, 4); sc += __shfl_xor(sc, 8);
                if (hh == 0 && ti < ntie) TSC[ql * TIE_CAP + ti] = sc + 0.0f;
            }
            asm volatile("s_waitcnt lgkmcnt(0)" ::: "memory");
            const float mys = (lane < (int)ntie) ? TSC[ql * TIE_CAP + lane] : -INFINITY; const unsigned myk = (lane < (int)ntie) ? TLIST[ql * TIE_CAP + lane] : 0xFFFFu;
            unsigned rank = 0u;
            for (unsigned o = 0; o < ntie; ++o) { const float so = TSC[ql * TIE_CAP + o]; const unsigned ko = TLIST[ql * TIE_CAP + o]; rank += (so > mys || (so == mys && ko < myk)) ? 1u : 0u; }
            if (lane < (int)ntie && rank < needq) LIST[ql * 256 + gtq + rank] = (unsigned short)myk;
            if (lane == 0) ((LAS int*)(lds + LDS_SCR + 256))[ql] = (int)(gtq + (needq < ntie ? needq : ntie));
        }
    }
    (void)eq_tot;
    __syncthreads();
    PROF_E(24);
}

__device__ __forceinline__ unsigned xb_xcc_id();
__device__ __forceinline__ void phase_dsa(const Params& P, LAS unsigned char* lds, int mode) {
    const int tid = threadIdx.x, lane = tid & 63, w = __builtin_amdgcn_readfirstlane(tid >> 6);
    unsigned* tick = (unsigned*)(P.ws + WS_CTL) + 2048 + (mode >> 8) * 64;
    LAS int* wi = (LAS int*)(lds + LDS_SCR + 512);
    const int pref = (int)(xb_xcc_id() >> 1) & 3;
    for (;;) {
        __syncthreads();
        if (tid == 0) { int got = -1;
            for (int a = 0; a < 4 && got < 0; ++a) { const int bb = (pref + a) & 3; const unsigned t = __hip_atomic_fetch_add(tick + bb * 16, 1u, __ATOMIC_RELAXED, __HIP_MEMORY_SCOPE_AGENT); if (t < 64u) got = bb * 64 + (int)t; }
            wi[0] = got; }
        __syncthreads();
        const int item = wi[0];
        if (item < 0) break;
        const int b = item >> 6, j = item & 63;
        for (int ui = 0; ui < 4; ++ui) {
            const int uq = (ui == 0) ? j : (ui == 1) ? 127 - j : (ui == 2) ? 128 + j : 255 - j;
            if (mode & 1) dsa_select_unit(P, lds, b, uq, (mode >> 4) & 15);
            if (mode & 2) for (int qi = 0; qi < 2; ++qi) { const int ql = w + 8 * qi, t = 16 * uq + ql;
                sparse_attn_query(P, lds, w, lane, b, b * SEQ + t, ((const LAS int*)(lds + LDS_SCR + 256))[ql], (const LAS unsigned short*)(lds + DS_LIST) + ql * 256); }
            __syncthreads();
        }
    }
}

#define XB_TMO      128
#define XB_XCNT(j)  (256  + 64 * (j))
#define XB_XSUB(j)  (1280 + 64 * (j))
#define XB_XGEN(j)  (2304 + 64 * (j))
#define XB_TOP      3328
#define XB_TOPGEN   3392
#define XCD_BAR_WORDS 3456
#define XB_SPIN_CAP (1u << 22)
__device__ __forceinline__ unsigned xb_ld(unsigned* p)              { return __hip_atomic_load(p, __ATOMIC_RELAXED, __HIP_MEMORY_SCOPE_AGENT); }
__device__ __forceinline__ unsigned xb_add(unsigned* p, unsigned v) { return __hip_atomic_fetch_add(p, v, __ATOMIC_RELAXED, __HIP_MEMORY_SCOPE_AGENT); }
__device__ __forceinline__ unsigned xb_xcc_id() { return (unsigned)__builtin_amdgcn_s_getreg((3 << 11) | 20) & 0xFu; }
#define XB_SPIN(cond, bar) do { unsigned _sp = 0; while (cond) { __builtin_amdgcn_s_sleep(1); \
    if ((++_sp & 255u) == 0u) { if (xb_ld(&(bar)[XB_TMO])) break; if (_sp > XB_SPIN_CAP) { atomicAdd(&(bar)[XB_TMO], 1u); break; } } } } while (0)
struct XcdBarrier { unsigned* bar; unsigned x; volatile LAS unsigned* st; };
__device__ __forceinline__ XcdBarrier xcd_barrier_post(unsigned* bar, volatile LAS unsigned* st) {
    XcdBarrier b; b.bar = bar; b.x = xb_xcc_id(); b.st = st;
    if (threadIdx.x == 0) (void)xb_add(&bar[XB_XCNT(b.x)], 1u);
    return b;
}
__device__ __forceinline__ void xcd_barrier_complete(unsigned* bar, unsigned x, unsigned& nloc, unsigned& nx) {
    const unsigned G = gridDim.x * gridDim.y * gridDim.z;
    unsigned sum, cnt, mine, sp = 0u;
    for (;;) {
        sum = 0u; cnt = 0u; mine = 0u;
#pragma unroll
        for (unsigned j = 0; j < 16; ++j) { const unsigned c = xb_ld(&bar[XB_XCNT(j)]); sum += c; cnt += (c > 0u) ? 1u : 0u; mine = (j == x) ? c : mine; }
        if (sum == G) break;
        __builtin_amdgcn_s_sleep(1);
        if ((++sp & 255u) == 0u) { if (xb_ld(&bar[XB_TMO])) break; if (sp > XB_SPIN_CAP) { atomicAdd(&bar[XB_TMO], 1u); break; } }
    }
    nloc = mine > 0u ? mine : 1u; nx = cnt > 0u ? cnt : 1u;
}
__device__ __forceinline__ void xcd_barrier(const XcdBarrier& b) {
    asm volatile("s_waitcnt vmcnt(0)" ::: "memory");
    __syncthreads();
    if (threadIdx.x == 0) {
        unsigned* bar = b.bar;
        __builtin_amdgcn_s_waitcnt(0);
        unsigned nloc = b.st[0], nx = b.st[1];
        if (nloc == 0u) { xcd_barrier_complete(bar, b.x, nloc, nx); b.st[0] = nloc; b.st[1] = nx; }
        const unsigned old = xb_add(&bar[XB_XSUB(b.x)], 1u);
        const unsigned gen = old / nloc;
        if (old + 1u == (gen + 1u) * nloc) {
            __builtin_amdgcn_fence(__ATOMIC_RELEASE, "agent");
            asm volatile("s_waitcnt vmcnt(0)" ::: "memory");
            const unsigned og = xb_add(&bar[XB_TOP], 1u);
            const unsigned tg = og / nx;
            if (og + 1u == (tg + 1u) * nx) xb_add(&bar[XB_TOPGEN], 1u);
            else XB_SPIN(xb_ld(&bar[XB_TOPGEN]) == tg, bar);
            __builtin_amdgcn_fence(__ATOMIC_ACQUIRE, "agent");
            xb_add(&bar[XB_XGEN(b.x)], 1u);
            asm volatile("s_waitcnt vmcnt(0)" ::: "memory");
        } else {
            XB_SPIN(xb_ld(&bar[XB_XGEN(b.x)]) == gen, bar);
            __builtin_amdgcn_fence(__ATOMIC_ACQUIRE, "agent");
            asm volatile("s_waitcnt vmcnt(0)" ::: "memory");
        }
    }
    __syncthreads();
}

#ifndef MK_N_LAUNCHES
#define MK_N_LAUNCHES 1
#endif
constexpr int N_PHASES = 8;
extern __shared__ __attribute__((aligned(16))) unsigned char dyn_lds[];
__global__ void __launch_bounds__(NTHR, 2) hybrid_fwd(Params P) {
    LAS unsigned char* lds = (LAS unsigned char*)dyn_lds;
    volatile LAS unsigned* MISC = (volatile LAS unsigned*)(lds + LDS_SCR);
    for (int u = threadIdx.x; u < (LDS_BYTES - LDS_SCR) / 4; u += NTHR) MISC[u] = 0u;
    __syncthreads();
    XcdBarrier bar = xcd_barrier_post((unsigned*)(P.ws + WS_CTL) + 4096 + P.ph_lo * XCD_BAR_WORDS, MISC + 8);
    const int lo = P.ph_lo, hi = P.ph_hi;
#ifndef PHASE_MASK
#define PHASE_MASK 0xFF
#endif
#define IN(k) (((PHASE_MASK >> (k)) & 1) && lo <= (k) && (k) < hi)
#define SEAM(k) do { if (IN(k) && IN((k) + 1)) xcd_barrier(bar); } while (0)
#ifndef REPEAT_MASK
#define REPEAT_MASK 0
#endif
#define REP(k) for (int rep_ = 0; rep_ < 1 + ((REPEAT_MASK >> (k)) & 1); ++rep_, (rep_ < 1 + ((REPEAT_MASK >> (k)) & 1) ? xcd_barrier(bar) : (void)0))
    if (IN(0)) REP(0) phase_prologue(P, lds);
    SEAM(0);
    if (IN(1)) REP(1) phase_h(P, lds);
    SEAM(1);
    if (IN(2)) REP(2) {
        pg8::Gemm g{(const h16*)(P.ws + WS_H), (const h16*)(P.ws + WS_W1T), T, NW1, DM, DM, DM, 0}; pg8::StaticOrder S; S.init(T, NW1, gridDim.x, blockIdx.x);
        EpiProj E{(h16*)(P.ws + WS_CQ), (h16*)(P.ws + WS_KVC), (h16*)(P.ws + WS_SGA), (h16*)(P.ws + WS_QB), (h16*)(P.ws + WS_KB), (h16*)(P.ws + WS_VB), (h16*)(P.ws + WS_SGB),
                  (float*)(P.ws + WS_SMALL), (float*)(P.ws + WS_SSQ), (const float*)(P.ws + WS_ROPE32)};
        pg8::gemm_phase(lds, g, S, E);
    }
    SEAM(2);
    if (IN(3)) {
        phase_rowops(P);
        REP(3) {
        { pg8::Gemm g{(const h16*)(P.ws + WS_CQ), (const h16*)(P.ws + WS_WQT), T, NQ, 512, 512, 512, 0}; pg8::StaticOrder S; S.init(T, NQ, gridDim.x, blockIdx.x);
          EpiQ E{(h16*)(P.ws + WS_QLAT), (h16*)(P.ws + WS_QROPE), (h16*)(P.ws + WS_QIDX), (const float*)(P.ws + WS_SSQ), (const float*)(P.ws + WS_ROPE32), (const float*)(P.ws + WS_ROPE16)};
          pg8::gemm_phase(lds, g, S, E); }
        __syncthreads();
        REP(8) phase_dilated_part(P, lds);
        }
    }
    SEAM(3);
#if DSA_PROBE == 0
    if (IN(4)) { phase_dsa(P, lds, 3 | 0x90); __syncthreads(); REP(4) phase_dilated_last(P, lds); }
#else
    if (IN(4)) { phase_dilated_last(P, lds); xcd_barrier(bar); phase_dsa(P, lds, 3 | 0x90); xcd_barrier(bar); phase_dsa(P, lds, 0x100 | (DSA_PROBE == 1 ? (3 | 0x90) : (1 | ((DSA_PROBE == 6 ? 1 : DSA_PROBE) << 4)))); }
#endif
    SEAM(4);
    if (IN(5)) REP(5) {
        pg8::Gemm g{(const h16*)(P.ws + WS_OLAT), (const h16*)(P.ws + WS_WUVT), T, 1024, 512, 2048, 512, 512}; pg8::StaticOrder S; S.init(T, 1024, gridDim.x, blockIdx.x);
        EpiOA E{(h16*)(P.ws + WS_OAB), (const h16*)(P.ws + WS_SGA)};
        pg8::gemm_phase(lds, g, S, E);
    }
    SEAM(5);
    if (IN(6)) REP(6) {
        pg8::Gemm g{(const h16*)(P.ws + WS_OAB), (const h16*)(P.ws + WS_WOT), T, DM, DM, DM, DM, 0}; pg8::StaticOrder S; S.init(T, DM, gridDim.x, blockIdx.x);
        EpiY E{(h16*)(P.ws + WS_Y), (float*)(P.ws + WS_SSY)};
        pg8::gemm_phase(lds, g, S, E);
    }
    SEAM(6);
    if (IN(7)) REP(7) phase_final(P, lds);
    if (PROF_SEL >= 0 && threadIdx.x == 0) { const unsigned long long t0 = __builtin_amdgcn_s_memrealtime(), d = *(LAS unsigned long long*)(lds + LDS_SCR + 136);
        while (__builtin_amdgcn_s_memrealtime() - t0 < d) __builtin_amdgcn_s_sleep(8); }
#undef IN
#undef SEAM
}

extern "C" void kernel_launch(void* const* d_in, const int* in_sizes, int n_in, void* d_out, int out_size, void* d_ws, size_t ws_size, hipStream_t stream) {
    static int grid = 0;
    if (grid == 0) {
        if (n_in != 14 || in_sizes[0] != T * DM || out_size != T * DM || ws_size < WS_END) { fprintf(stderr, "kernel_launch: unexpected shapes (n_in %d, in0 %d, out %d, ws %zu)\n", n_in, n_in > 0 ? in_sizes[0] : -1, out_size, ws_size); grid = -1; return; }
        int dev = 0, cus = 0, per_cu = 0;
        if (hipGetDevice(&dev) != hipSuccess || hipDeviceGetAttribute(&cus, hipDeviceAttributeMultiprocessorCount, dev) != hipSuccess) { grid = -1; return; }
        if (hipFuncSetAttribute((const void*)hybrid_fwd, hipFuncAttributeMaxDynamicSharedMemorySize, LDS_BYTES) != hipSuccess) { fprintf(stderr, "kernel_launch: hipFuncSetAttribute failed\n"); grid = -1; return; }
        if (hipOccupancyMaxActiveBlocksPerMultiprocessor(&per_cu, (const void*)hybrid_fwd, NTHR, LDS_BYTES) != hipSuccess || per_cu < 1) { fprintf(stderr, "kernel_launch: occupancy query says %d blocks per CU\n", per_cu); }
        (void)hipGetLastError();
        grid = cus;
    }
    if (grid < 0) return;
    (void)hipMemsetAsync((char*)d_ws + WS_CTL, 0, 1 * MiB, stream);
    Params P{};
    P.x = (const float*)d_in[0]; P.c = (const float*)d_in[1]; P.w_ada = (const float*)d_in[2]; P.b_ada = (const float*)d_in[3]; P.g_pre = (const float*)d_in[4]; P.g_post = (const float*)d_in[5];
    P.w_in = (const float*)d_in[6]; P.g_q = (const float*)d_in[7]; P.g_kv = (const float*)d_in[8]; P.w_uq = (const float*)d_in[9]; P.w_uq_idx = (const float*)d_in[10]; P.w_uk = (const float*)d_in[11];
    P.w_uv = (const float*)d_in[12]; P.w_out = (const float*)d_in[13]; P.out = (float*)d_out; P.ws = (unsigned char*)d_ws;
#if MK_N_LAUNCHES == 1
    P.ph_lo = 0; P.ph_hi = N_PHASES;
    hipLaunchKernelGGL(hybrid_fwd, dim3(grid), dim3(NTHR), LDS_BYTES, stream, P);
#else
    for (int k = 0; k < N_PHASES; ++k) { P.ph_lo = k; P.ph_hi = k + 1; hipLaunchKernelGGL(hybrid_fwd, dim3(grid), dim3(NTHR), LDS_BYTES, stream, P); }
#endif
}
```

```cpp
#include <hip/hip_runtime.h>
#include <cstdint>
#include <cstdio>
#include <cmath>

#define LAS __attribute__((address_space(3)))
typedef _Float16 h16;
typedef _Float16 h16x2 __attribute__((ext_vector_type(2)));
typedef _Float16 h16x4 __attribute__((ext_vector_type(4)));
typedef _Float16 h16x8 __attribute__((ext_vector_type(8)));
typedef float f32x2 __attribute__((ext_vector_type(2)));
typedef float f32x4 __attribute__((ext_vector_type(4)));
typedef unsigned u32x2 __attribute__((ext_vector_type(2)));
typedef unsigned u32x4 __attribute__((ext_vector_type(4)));

constexpr int NB = 4, SEQ = 4096, T = NB * SEQ, DM = 2048;
constexpr int NW1 = 6144;
constexpr int NQ = 3328;
constexpr int KVW = 288;
constexpr float EPS = 1e-6f;
constexpr float SCQ = 0.08838834764831845f * 1.4426950408889634f;

constexpr size_t MiB = 1u << 20;
constexpr size_t WS_CTL = 0;
constexpr size_t WS_MODP = 1 * MiB;
constexpr size_t WS_ROPE32 = 2 * MiB;
constexpr size_t WS_ROPE16 = 2 * MiB + 512 * 1024;
constexpr size_t WS_SSQ = 3 * MiB;
constexpr size_t WS_SSY = 4 * MiB;
constexpr size_t WS_W1T = 8 * MiB;
constexpr size_t WS_WQT = 32 * MiB;
constexpr size_t WS_WUVT = 36 * MiB;
constexpr size_t WS_WOT = 38 * MiB;
constexpr size_t WS_KVC = 46 * MiB;
constexpr size_t WS_KIDX = 55 * MiB;
constexpr size_t WS_WIDX = 57 * MiB;
constexpr size_t WS_SMALL = 58 * MiB;
constexpr size_t WS_CQ = 66 * MiB;
constexpr size_t WS_SGA = 82 * MiB;
constexpr size_t WS_OAB = 114 * MiB;
constexpr size_t WS_QLAT = 178 * MiB;
constexpr size_t WS_QROPE = 242 * MiB;
constexpr size_t WS_QIDX = 250 * MiB;
constexpr size_t WS_H = 282 * MiB;
constexpr size_t WS_OP4 = 282 * MiB;
constexpr size_t WS_OP16 = 314 * MiB;
constexpr size_t WS_QB = 346 * MiB;
constexpr size_t WS_KB = 378 * MiB;
constexpr size_t WS_VB = 410 * MiB;
constexpr size_t WS_SGB = 442 * MiB;
constexpr size_t WS_END = 474 * MiB;
constexpr size_t WS_LSEP = 6 * MiB;
#ifndef DSA_PROBE
#define DSA_PROBE 0
#endif
constexpr size_t WS_OLAT = DSA_PROBE ? 346 * MiB : 178 * MiB;
constexpr size_t WS_Y = 178 * MiB;

struct Params {
    const float *x, *c, *w_ada, *b_ada, *g_pre, *g_post, *w_in, *g_q, *g_kv, *w_uq, *w_uq_idx, *w_uk, *w_uv, *w_out;
    float* out; unsigned char* ws;
    int ph_lo, ph_hi;
};

__device__ __forceinline__ unsigned pk2h(float a, float b) { h16x2 t = {(h16)a, (h16)b}; return __builtin_bit_cast(unsigned, t); }
__device__ __forceinline__ float siluf(float v) { return v * __builtin_amdgcn_rcpf(1.0f + __builtin_amdgcn_exp2f(-1.4426950408889634f * v)); }
__device__ __forceinline__ float wave_sum(float v) {
#pragma unroll
    for (int o = 1; o < 64; o <<= 1) v += __shfl_xor(v, o);
    return v;
}
__device__ __forceinline__ float wave_max(float v) {
#pragma unroll
    for (int o = 1; o < 64; o <<= 1) v = fmaxf(v, __shfl_xor(v, o));
    return v;
}

constexpr int NTHR = 512, NWAVE = 8;
constexpr int LDS_SCR = 159744;
constexpr int LDS_BYTES = LDS_SCR + 4096;
#ifndef PROF_SEL
#define PROF_SEL -1
#endif
#ifndef PROF_BLK
#define PROF_BLK 37
#endif
#define PROF_B(k) do { if ((k) == PROF_SEL && threadIdx.x == 0) { *(LAS unsigned long long*)(lds + LDS_SCR + 128) = __builtin_amdgcn_s_memrealtime(); } } while (0)
#define PROF_E(k) do { if ((k) == PROF_SEL && threadIdx.x == 0) { *(LAS unsigned long long*)(lds + LDS_SCR + 136) += __builtin_amdgcn_s_memrealtime() - *(LAS unsigned long long*)(lds + LDS_SCR + 128); } } while (0)

namespace pg8 {
constexpr int BM = 256, BK = 64, HALF = 128, HTB = HALF * BK * 2, STAGE_BYTES = 8 * HTB, NXCD = 8, WGM = 8;
__host__ __device__ __forceinline__ int lds_byte(int r, int c) { const int st = (r >> 4) * 2 + (c >> 5), rr = r & 15, cc = c & 31, ob = rr * 64 + cc * 2; return st * 1024 + (ob ^ (((ob >> 9) & 1) << 5)); }
__host__ __device__ __forceinline__ void stage_rc(int b, int& R, int& C) { const int st = b / 1024, sb = b % 1024, swz = sb ^ (((sb >> 9) & 1) << 5); R = (st >> 1) * 16 + swz / 64; C = (st & 1) * 32 + (swz % 64) / 2; }
__host__ __device__ __forceinline__ int perm32(int rho) { const int n = rho >> 4, i = rho & 15; return 8 * (i >> 2) + 4 * n + (i & 3); }

struct Unit { int pm, pn; };
struct Gemm { const h16* A; const h16* Bt; int M, N, K, lda, ldb, a_pn_off; };

struct StaticOrder {
    int nM, nN, nwg, G, c;
    __device__ void init(int M, int N, int G_, int c_) { nM = M / BM; nN = N / BM; nwg = nM * nN; G = __builtin_amdgcn_readfirstlane(G_); c = __builtin_amdgcn_readfirstlane(c_); }
    __device__ bool next(int i, Unit& u) const {
        const int L = __builtin_amdgcn_readfirstlane(i * G + c); if (L >= nwg) return false;
        int wgid = L; { const int q = nwg / NXCD, r = nwg % NXCD, xcd = wgid % NXCD, off = wgid / NXCD; wgid = (xcd < r ? xcd * (q + 1) : r * (q + 1) + (xcd - r) * q) + off; }
        const int nig = WGM * nN, gid = wgid / nig, fm = gid * WGM, gsz = (nM - fm) < WGM ? (nM - fm) : WGM;
        u.pm = __builtin_amdgcn_readfirstlane(fm + ((wgid % nig) % gsz)); u.pn = __builtin_amdgcn_readfirstlane((wgid % nig) / gsz); return true;
    }
};

template <class Epi>
__device__ __forceinline__ void gemm_phase(LAS unsigned char* lds, const Gemm g, const StaticOrder& S, const Epi& E) {
    const int tid = threadIdx.x, wid = __builtin_amdgcn_readfirstlane(tid >> 6), lane = tid & 63, wr = wid >> 2, wc = wid & 3, fr = lane & 15, fq = lane >> 4;
    const int K = g.K, nt = K / BK;
    unsigned voffA[2], voffB[2];
#pragma unroll
    for (int i = 0; i < 2; ++i) { int R, C; stage_rc(tid * 16 + i * 8192, R, C); const int Rb = (R & ~31) + perm32(R & 31);
        voffA[i] = (unsigned)(R * g.lda + C) * 2u; voffB[i] = (unsigned)(Rb * g.ldb + C) * 2u; }
    const size_t kstep = (size_t)(BK * 2);
    const size_t hstepA = (size_t)HALF * g.lda * 2, hstepB = (size_t)HALF * g.ldb * 2;
    const size_t tstepA = 2 * hstepA, tstepB = 2 * hstepB;
    const unsigned ldsw = (unsigned)wid * 1024u;
    const int aoff = lds_byte(wr * 64 + fr, fq * 8), boff = lds_byte(wc * 32 + fr, fq * 8);
#define PG8_SA(b, h) (((b) * 2 + (h)) * HTB)
#define PG8_SB(b, h) ((4 + (b) * 2 + (h)) * HTB)
#define PG8_STAGE(bufoff, gbase, voff) do { _Pragma("unroll") for (int _i = 0; _i < 2; ++_i) \
        __builtin_amdgcn_global_load_lds((const unsigned*)((const char*)(gbase) + (voff)[_i]), (LAS unsigned*)(lds + (bufoff) + ldsw + _i * 8192), 16, 0, 0); } while (0)
#define PG8_LDA(dst, b, h) do { _Pragma("unroll") for (int m = 0; m < 4; ++m) _Pragma("unroll") for (int k = 0; k < 2; ++k) dst[m][k] = *(const LAS h16x8*)(lds + PG8_SA(b, h) + aoff + m * 2048 + k * 1024); } while (0)
#define PG8_LDB(dst, b, h) do { _Pragma("unroll") for (int n = 0; n < 2; ++n) _Pragma("unroll") for (int k = 0; k < 2; ++k) dst[n][k] = *(const LAS h16x8*)(lds + PG8_SB(b, h) + boff + n * 2048 + k * 1024); } while (0)
#define PG8_MMA(ai, bj, At, Bt) do { __builtin_amdgcn_s_setprio(1); _Pragma("unroll") for (int m = 0; m < 4; ++m) _Pragma("unroll") for (int n = 0; n < 2; ++n) _Pragma("unroll") for (int k = 0; k < 2; ++k) \
        acc[ai][bj][m][n] = __builtin_amdgcn_mfma_f32_16x16x32_f16(Bt[n][k], At[m][k], acc[ai][bj][m][n], 0, 0, 0); __builtin_amdgcn_s_setprio(0); } while (0)
#define PG8_WAIT_V(n) asm volatile("s_waitcnt vmcnt(" #n ")" ::: "memory")
#define PG8_WAIT_L(n) asm volatile("s_waitcnt lgkmcnt(" #n ")" ::: "memory")
#define PG8_BAR __builtin_amdgcn_s_barrier()
#define PG8_SCHED __builtin_amdgcn_sched_barrier(0)
    Unit cur, nxt; int ui = 0;
    if (!S.next(0, cur)) return;
    PROF_B(Epi::PROF_ID);
    f32x4 acc[2][2][4][2];
#pragma unroll
    for (int a = 0; a < 2; ++a)
#pragma unroll
        for (int b = 0; b < 2; ++b)
#pragma unroll
            for (int m = 0; m < 4; ++m)
#pragma unroll
                for (int n = 0; n < 2; ++n) acc[a][b][m][n] = (f32x4){0.f, 0.f, 0.f, 0.f};
    h16x8 At[4][2], B0[2][2], B1[2][2];
    const char* cA = (const char*)g.A + (size_t)cur.pm * tstepA + (size_t)cur.pn * g.a_pn_off * 2; const char* cB = (const char*)g.Bt + (size_t)cur.pn * tstepB;
    PG8_STAGE(PG8_SB(0, 0), cB, voffB); PG8_STAGE(PG8_SB(0, 1), cB + hstepB, voffB); PG8_STAGE(PG8_SA(0, 0), cA, voffA); PG8_STAGE(PG8_SA(0, 1), cA + hstepA, voffA);
    if (wr == 1) PG8_BAR;
    PG8_WAIT_V(2); PG8_BAR;
    PG8_STAGE(PG8_SB(1, 0), cB + kstep, voffB); PG8_STAGE(PG8_SA(1, 0), cA + kstep, voffA); PG8_STAGE(PG8_SB(1, 1), cB + hstepB + kstep, voffB);
    PG8_WAIT_V(6); PG8_BAR;
    for (;;) {
        const bool has_next = S.next(ui + 1, nxt);
        const char* nA = has_next ? (const char*)g.A + (size_t)nxt.pm * tstepA + (size_t)nxt.pn * g.a_pn_off * 2 : cA; const char* nB = has_next ? (const char*)g.Bt + (size_t)nxt.pn * tstepB : cB;
        for (int t = 0; t < nt; t += 2) {
            const bool last = (t == nt - 2);
            const char* a1 = cA + (size_t)(t + 1) * kstep;
            const char* a2 = last ? nA : cA + (size_t)(t + 2) * kstep; const char* b2 = last ? nB : cB + (size_t)(t + 2) * kstep;
            const char* a3 = a2 + kstep; const char* b3 = b2 + kstep;
            PG8_LDB(B0, 0, 0); PG8_LDB(B1, 0, 1); PG8_SCHED; PG8_LDA(At, 0, 0); PG8_STAGE(PG8_SA(1, 1), a1 + hstepA, voffA);
            PG8_WAIT_V(8); PG8_WAIT_L(0); PG8_BAR; PG8_MMA(0, 0, At, B0); PG8_MMA(0, 1, At, B1); PG8_BAR; PG8_SCHED;
            PG8_LDA(At, 0, 1); PG8_STAGE(PG8_SB(0, 0), b2, voffB); PG8_STAGE(PG8_SB(0, 1), b2 + hstepB, voffB); PG8_STAGE(PG8_SA(0, 0), a2, voffA);
            PG8_WAIT_V(8); PG8_WAIT_L(0); PG8_BAR; PG8_MMA(1, 0, At, B0); PG8_MMA(1, 1, At, B1); PG8_BAR; PG8_SCHED;
            PG8_LDB(B0, 1, 0); PG8_LDB(B1, 1, 1); PG8_SCHED; PG8_LDA(At, 1, 0); PG8_STAGE(PG8_SA(0, 1), a2 + hstepA, voffA);
            PG8_WAIT_V(8); PG8_WAIT_L(0); PG8_BAR; PG8_MMA(0, 0, At, B0); PG8_MMA(0, 1, At, B1); PG8_BAR; PG8_SCHED;
            PG8_LDA(At, 1, 1); PG8_STAGE(PG8_SB(1, 0), b3, voffB); PG8_STAGE(PG8_SB(1, 1), b3 + hstepB, voffB); PG8_STAGE(PG8_SA(1, 0), a3, voffA);
            PG8_WAIT_V(8); PG8_WAIT_L(0); PG8_BAR; PG8_MMA(1, 0, At, B0); PG8_MMA(1, 1, At, B1); PG8_BAR; PG8_SCHED;
        }
        if (wr == 0) PG8_BAR;
        PROF_E(Epi::PROF_ID); PROF_B(Epi::PROF_ID + 1);
        { const int cls_ = (Epi::PROF_ID == 40) ? (cur.pn < 2 ? 60 : cur.pn < 4 ? 61 : (cur.pn < 8 || cur.pn >= 20) ? 62 : cur.pn < 16 ? 63 : 64) : (Epi::PROF_ID == 42 ? (cur.pn == 0 ? 65 : cur.pn < 9 ? 66 : 67) : 0);
          if (cls_ == PROF_SEL) PROF_B(PROF_SEL);
          E(acc, cur, wr, wc, fr, fq);
          if (cls_ == PROF_SEL) PROF_E(PROF_SEL); }
        PROF_E(Epi::PROF_ID + 1); PROF_B(Epi::PROF_ID);
        if (!has_next) break;
#pragma unroll
        for (int a = 0; a < 2; ++a)
#pragma unroll
            for (int b = 0; b < 2; ++b)
#pragma unroll
                for (int m = 0; m < 4; ++m)
#pragma unroll
                    for (int n = 0; n < 2; ++n) acc[a][b][m][n] = (f32x4){0.f, 0.f, 0.f, 0.f};
        cur = nxt; cA = nA; cB = nB; ++ui;
        if (wr == 1) PG8_BAR;
    }
    PG8_WAIT_V(0);
    PG8_BAR;
#undef PG8_SA
#undef PG8_SB
#undef PG8_STAGE
#undef PG8_LDA
#undef PG8_LDB
#undef PG8_MMA
#undef PG8_WAIT_V
#undef PG8_WAIT_L
#undef PG8_BAR
#undef PG8_SCHED
}
}

using pg8::Unit;
__device__ __forceinline__ u32x4 pack8(const f32x4 a, const f32x4 b) { u32x4 w; w.x = pk2h(a[0], a[1]); w.y = pk2h(a[2], a[3]); w.z = pk2h(b[0], b[1]); w.w = pk2h(b[2], b[3]); return w; }

__device__ __forceinline__ float xlane32(float v, bool upper) { const auto r = __builtin_amdgcn_permlane32_swap(__float_as_uint(v), __float_as_uint(v), false, false); return __uint_as_float(upper ? r[0] : r[1]); }
__device__ __forceinline__ float xlane16(float v, bool oddrow) { const auto r = __builtin_amdgcn_permlane16_swap(__float_as_uint(v), __float_as_uint(v), false, false); return __uint_as_float(oddrow ? r[0] : r[1]); }
__device__ __forceinline__ void rope8(f32x4& v0, f32x4& v1, const f32x4 (&t)[4], const f32x4 p0, const f32x4 p1, float sg) {
#pragma unroll
    for (int e = 0; e < 4; ++e) { const float c0 = t[e >> 1][2 * (e & 1)], s0 = t[e >> 1][2 * (e & 1) + 1], c1 = t[2 + (e >> 1)][2 * (e & 1)], s1 = t[2 + (e >> 1)][2 * (e & 1) + 1];
        v0[e] = v0[e] * c0 + sg * p0[e] * s0; v1[e] = v1[e] * c1 + sg * p1[e] * s1; }
}
struct EpiProj {
    static constexpr int PROF_ID = 40;
    h16 *CQ, *KVC, *SGA, *QB, *KB, *VB, *SGB; float *SMALL, *SSQ; const float* rope32;
    __device__ __forceinline__ void operator()(const f32x4 (&acc)[2][2][4][2], const Unit& u, int wr, int wc, int fr_in, int fq_in) const {
        int fr = fr_in, fq = fq_in; asm volatile("" : "+v"(fr), "+v"(fq));
        const int pn = u.pn;
        const int rowb = u.pm * 256 + wr * 64 + fr;
        if (pn >= 8 && pn < 16 && wc == 0) {
            const bool isq = pn < 12; const float sc = isq ? SCQ : 1.0f, sg = (fq < 2) ? -1.f : 1.f; const bool upper = fq >= 2;
            h16* dst = (isq ? QB + (pn - 8) * 256 : KB + (pn - 12) * 256) + fq * 8;
            const float* tb = rope32 + 16 * (fq & 1);
            f32x4 ta[4], tn[4];
#define EP_LDT(t, g) do { const int pos_ = (rowb + 128 * ((g) >> 2) + 16 * ((g) & 3)) & (SEQ - 1); _Pragma("unroll") for (int k_ = 0; k_ < 4; ++k_) t[k_] = *(const f32x4*)(tb + (size_t)pos_ * 32 + 4 * k_); } while (0)
            EP_LDT(ta, 0);
#pragma unroll
            for (int g = 0; g < 8; ++g) {
                if (g < 7) { if (g & 1) EP_LDT(ta, g + 1); else EP_LDT(tn, g + 1); }
                const int ai = g >> 2, m = g & 3; const int row = rowb + 128 * ai + 16 * m;
#pragma unroll
                for (int bj = 0; bj < 2; ++bj) { f32x4 v0 = acc[ai][bj][m][0], v1 = acc[ai][bj][m][1], p0, p1;
#pragma unroll
                    for (int e = 0; e < 4; ++e) { p0[e] = xlane32(v0[e], upper); p1[e] = xlane32(v1[e], upper); }
                    if (g & 1) rope8(v0, v1, tn, p0, p1, sg); else rope8(v0, v1, ta, p0, p1, sg);
                    v0 = v0 * sc; v1 = v1 * sc;
                    *(u32x4*)(dst + (size_t)row * 1024 + bj * 128) = pack8(v0, v1); }
            }
#undef EP_LDT
            return;
        }
#pragma unroll
        for (int ai = 0; ai < 2; ++ai)
#pragma unroll
            for (int m = 0; m < 4; ++m) {
                const int row = rowb + ai * 128 + m * 16;
                if (pn < 2) {
                    float s = 0.f;
#pragma unroll
                    for (int bj = 0; bj < 2; ++bj) { const f32x4 v0 = acc[ai][bj][m][0], v1 = acc[ai][bj][m][1];
                        s += (v0[0] * v0[0] + v0[1] * v0[1]) + (v0[2] * v0[2] + v0[3] * v0[3]) + (v1[0] * v1[0] + v1[1] * v1[1]) + (v1[2] * v1[2] + v1[3] * v1[3]);
                        *(u32x4*)(CQ + (size_t)row * 512 + pn * 256 + bj * 128 + wc * 32 + fq * 8) = pack8(v0, v1); }
                    s += __shfl_xor(s, 16); s += __shfl_xor(s, 32);
                    if (fq == 0) SSQ[(size_t)row * 8 + pn * 4 + wc] = s;
                } else if (pn == 2) {
#pragma unroll
                    for (int bj = 0; bj < 2; ++bj) *(u32x4*)(KVC + (size_t)row * KVW + bj * 128 + wc * 32 + fq * 8) = pack8(acc[ai][bj][m][0], acc[ai][bj][m][1]);
                } else if (pn == 3) {
                    float* p = SMALL + (size_t)row * 128 + wc * 32 + fq * 8;
                    *(f32x4*)p = acc[ai][0][m][0]; *(f32x4*)(p + 4) = acc[ai][0][m][1];
                } else if (pn < 8 || pn >= 20) {
                    h16* dst = (pn < 8 ? SGA + (pn - 4) * 256 : SGB + (pn - 20) * 256) + (size_t)row * 1024 + wc * 32 + fq * 8;
#pragma unroll
                    for (int bj = 0; bj < 2; ++bj) { f32x4 v0 = acc[ai][bj][m][0], v1 = acc[ai][bj][m][1];
#pragma unroll
                        for (int e = 0; e < 4; ++e) { v0[e] = siluf(v0[e]); v1[e] = siluf(v1[e]); }
                        *(u32x4*)(dst + bj * 128) = pack8(v0, v1); }
                } else if (pn >= 16) {
                    h16* dst = VB + (size_t)row * 1024 + (pn - 16) * 256 + wc * 32 + fq * 8;
#pragma unroll
                    for (int bj = 0; bj < 2; ++bj) *(u32x4*)(dst + bj * 128) = pack8(acc[ai][bj][m][0], acc[ai][bj][m][1]);
                } else {
                    const bool isq = pn < 12; const float sc = isq ? SCQ : 1.0f;
                    h16* dst = (isq ? QB + (pn - 8) * 256 : KB + (pn - 12) * 256) + (size_t)row * 1024 + wc * 32 + fq * 8;
#pragma unroll
                    for (int bj = 0; bj < 2; ++bj) *(u32x4*)(dst + bj * 128) = pack8(acc[ai][bj][m][0] * sc, acc[ai][bj][m][1] * sc);
                }
            }
    }
};

struct EpiQ {
    static constexpr int PROF_ID = 42;
    h16 *QLAT, *QROPE, *QIDX; const float *SSQ, *rope32, *rope16;
    __device__ __forceinline__ void operator()(const f32x4 (&acc)[2][2][4][2], const Unit& u, int wr, int wc, int fr_in, int fq_in) const {
        int fr = fr_in, fq = fq_in; asm volatile("" : "+v"(fr), "+v"(fq));
        const int pn = u.pn;
        const int rowb = u.pm * 256 + wr * 64 + fr;
        if (pn >= 1 && pn < 9) {
            float rs[8];
#pragma unroll
            for (int gb = 0; gb < 8; gb += 4) {
                f32x4 sa_[4], sb_[4];
#pragma unroll
                for (int g = 0; g < 4; ++g) { const int row = rowb + 128 * ((gb + g) >> 2) + 16 * (g & 3); sa_[g] = *(const f32x4*)(SSQ + (size_t)row * 8); sb_[g] = *(const f32x4*)(SSQ + (size_t)row * 8 + 4); }
#pragma unroll
                for (int g = 0; g < 4; ++g) rs[gb + g] = __builtin_amdgcn_rsqf((((sa_[g][0] + sa_[g][1]) + (sa_[g][2] + sa_[g][3])) + ((sb_[g][0] + sb_[g][1]) + (sb_[g][2] + sb_[g][3]))) * (1.0f / 512.0f) + EPS);
            }
#pragma unroll
            for (int g = 0; g < 8; ++g) { const int ai = g >> 2, m = g & 3; const int row = rowb + 128 * ai + 16 * m; const float sc = rs[g] * SCQ;
#pragma unroll
                for (int bj = 0; bj < 2; ++bj)
                    *(u32x4*)(QLAT + ((size_t)row * 8 + (pn - 1)) * 256 + bj * 128 + wc * 32 + fq * 8) = pack8(acc[ai][bj][m][0] * sc, acc[ai][bj][m][1] * sc); }
            return;
        }
        const bool rope_q = (pn == 0), rope_i = (pn >= 9) && ((wc & 1) == 0);
        const float* tb = rope_q ? rope32 + 16 * (fq & 1) : rope16;
        const int tstride = rope_q ? 32 : 16;
#pragma unroll
        for (int am = 0; am < 4; ++am) { const int ai = am >> 1, mb = 2 * (am & 1);
            f32x4 tt[2][4];
            float rs2[2];
#pragma unroll
            for (int mm = 0; mm < 2; ++mm) { const int row = rowb + ai * 128 + (mb + mm) * 16;
                const f32x4 sa_ = *(const f32x4*)(SSQ + (size_t)row * 8), sb_ = *(const f32x4*)(SSQ + (size_t)row * 8 + 4);
                if (rope_q || rope_i) {
#pragma unroll
                    for (int k = 0; k < 4; ++k) tt[mm][k] = *(const f32x4*)(tb + (size_t)(row & (SEQ - 1)) * tstride + 4 * k); }
                rs2[mm] = __builtin_amdgcn_rsqf((((sa_[0] + sa_[1]) + (sa_[2] + sa_[3])) + ((sb_[0] + sb_[1]) + (sb_[2] + sb_[3]))) * (1.0f / 512.0f) + EPS); }
#pragma unroll
            for (int mm = 0; mm < 2; ++mm) { const int m = mb + mm;
                const int row = rowb + ai * 128 + m * 16;
                const float rstd = rs2[mm];
#pragma unroll
                for (int bj = 0; bj < 2; ++bj) { f32x4 v0 = acc[ai][bj][m][0] * rstd, v1 = acc[ai][bj][m][1] * rstd;
                    if (pn == 0) {
                        f32x4 p0, p1;
#pragma unroll
                        for (int e = 0; e < 4; ++e) { p0[e] = xlane32(v0[e], fq >= 2); p1[e] = xlane32(v1[e], fq >= 2); }
                        rope8(v0, v1, tt[mm], p0, p1, (fq < 2) ? -1.f : 1.f);
                        v0 = v0 * SCQ; v1 = v1 * SCQ;
                        *(u32x4*)(QROPE + ((size_t)row * 8 + (4 * bj + wc)) * 32 + fq * 8) = pack8(v0, v1);
                    } else {
                        if ((wc & 1) == 0) {
                            f32x4 p0, p1, r0 = v0, r1 = v1;
#pragma unroll
                            for (int e = 0; e < 4; ++e) { p0[e] = xlane16(v0[e], (fq & 1) != 0); p1[e] = xlane16(v1[e], (fq & 1) != 0); }
                            rope8(r0, r1, tt[mm], p0, p1, (fq == 0) ? -1.f : 1.f);
                            if (fq < 2) { v0 = r0; v1 = r1; }
                        }
                        *(u32x4*)(QIDX + (size_t)row * 1024 + (pn - 9) * 256 + bj * 128 + wc * 32 + fq * 8) = pack8(v0, v1);
                    } }
            }
            asm volatile("" ::: "memory");
        }
    }
};

struct EpiOA {
    static constexpr int PROF_ID = 44;
    h16* OAB; const h16* SGA;
    __device__ __forceinline__ void operator()(const f32x4 (&acc)[2][2][4][2], const Unit& u, int wr, int wc, int fr_in, int fq_in) const {
        int fr = fr_in, fq = fq_in; asm volatile("" : "+v"(fr), "+v"(fq));
#pragma unroll
        for (int ai = 0; ai < 2; ++ai)
#pragma unroll
            for (int m = 0; m < 4; ++m) {
                const int row = u.pm * 256 + ai * 128 + wr * 64 + m * 16 + fr;
#pragma unroll
                for (int bj = 0; bj < 2; ++bj) { const int col = u.pn * 256 + bj * 128 + wc * 32 + fq * 8;
                    const h16x8 g = *(const h16x8*)(SGA + (size_t)row * 1024 + col);
                    f32x4 v0 = acc[ai][bj][m][0], v1 = acc[ai][bj][m][1];
#pragma unroll
                    for (int e = 0; e < 4; ++e) { v0[e] *= (float)g[e]; v1[e] *= (float)g[4 + e]; }
                    *(u32x4*)(OAB + (size_t)row * 2048 + col) = pack8(v0, v1); }
            }
    }
};

struct EpiY {
    static constexpr int PROF_ID = 46;
    h16* Y; float* SSY;
    __device__ __forceinline__ void operator()(const f32x4 (&acc)[2][2][4][2], const Unit& u, int wr, int wc, int fr_in, int fq_in) const {
        int fr = fr_in, fq = fq_in; asm volatile("" : "+v"(fr), "+v"(fq));
#pragma unroll
        for (int ai = 0; ai < 2; ++ai)
#pragma unroll
            for (int m = 0; m < 4; ++m) {
                const int row = u.pm * 256 + ai * 128 + wr * 64 + m * 16 + fr;
                float s = 0.f;
#pragma unroll
                for (int bj = 0; bj < 2; ++bj) { const f32x4 v0 = acc[ai][bj][m][0], v1 = acc[ai][bj][m][1];
                    s += (v0[0] * v0[0] + v0[1] * v0[1]) + (v0[2] * v0[2] + v0[3] * v0[3]) + (v1[0] * v1[0] + v1[1] * v1[1]) + (v1[2] * v1[2] + v1[3] * v1[3]);
                    *(u32x4*)(Y + (size_t)row * 2048 + u.pn * 256 + bj * 128 + wc * 32 + fq * 8) = pack8(v0, v1); }
                s += __shfl_xor(s, 16); s += __shfl_xor(s, 32);
                if (fq == 0) SSY[(size_t)row * 32 + u.pn * 4 + wc] = s;
            }
    }
};


__device__ __forceinline__ void p0_mod_unit(const Params& P, int unit, LAS unsigned char* lds) {
    const int tid = threadIdx.x, lane = tid & 63, w = tid >> 6, kc = unit / 24, cc = unit % 24;
    LAS float* sc = (LAS float*)lds;
    LAS float* red = (LAS float*)(lds + 4096);
    for (int i = tid; i < 1024; i += NTHR) { const int b = i >> 8, kk = i & 255; sc[i] = siluf(P.c[b * DM + kc * 256 + kk]); }
    __syncthreads();
    f32x4 acc[4];
#pragma unroll
    for (int b = 0; b < 4; ++b) acc[b] = (f32x4){0.f, 0.f, 0.f, 0.f};
    const float* wp = P.w_ada + (size_t)(kc * 256 + w * 32) * 6144 + cc * 256 + 4 * lane;
#pragma unroll 16
    for (int i = 0; i < 32; ++i) { const f32x4 wv = __builtin_nontemporal_load((const f32x4*)(wp + (size_t)i * 6144));
#pragma unroll
        for (int b = 0; b < 4; ++b) acc[b] += wv * sc[b * 256 + w * 32 + i]; }
#pragma unroll
    for (int b = 0; b < 4; ++b) *(LAS f32x4*)(red + (w * 4 + b) * 256 + 4 * lane) = acc[b];
    __syncthreads();
    float* MODP = (float*)(P.ws + WS_MODP);
    for (int o = tid; o < 1024; o += NTHR) { const int b = o >> 8, j = o & 255; float s = 0.f;
#pragma unroll
        for (int ww = 0; ww < 8; ++ww) s += red[(ww * 4 + b) * 256 + j];
        MODP[(size_t)(kc * 4 + b) * 6144 + cc * 256 + j] = s; }
    __syncthreads();
}
template <class SrcCol>
__device__ __forceinline__ void transpose_item(const float* W, int ldw, const float* kscale, h16* WT, int ldt, int k0, int n0, SrcCol srccol, LAS float* scr, int lane) {
    const int n4 = 4 * (lane & 15), s = srccol(n0 + n4);
    f32x4 tv[16];
#pragma unroll
    for (int i = 0; i < 16; ++i) { const int k = 4 * i + (lane >> 4); tv[i] = (s >= 0) ? __builtin_nontemporal_load((const f32x4*)(W + (size_t)(k0 + k) * ldw + s)) : (f32x4){0.f, 0.f, 0.f, 0.f}; }
#pragma unroll
    for (int i = 0; i < 16; ++i) { const int k = 4 * i + (lane >> 4); f32x4 v = tv[i];
        if (kscale) v = v * kscale[k0 + k];
        *(LAS f32x4*)(scr + k * 64 + (n4 ^ (((k >> 3) & 7) << 2))) = v; }
    asm volatile("s_waitcnt lgkmcnt(0)" ::: "memory");
    const int c = lane & 7;
#pragma unroll
    for (int j = 0; j < 8; ++j) { const int n = (lane >> 3) + 8 * j; const LAS float* sp = scr + (8 * c) * 64 + (n ^ (c << 2));
        u32x4 o; o.x = pk2h(sp[0 * 64], sp[1 * 64]); o.y = pk2h(sp[2 * 64], sp[3 * 64]); o.z = pk2h(sp[4 * 64], sp[5 * 64]); o.w = pk2h(sp[6 * 64], sp[7 * 64]);
        *(u32x4*)(WT + (size_t)(n0 + n) * ldt + k0 + 8 * c) = o; }
    asm volatile("s_waitcnt lgkmcnt(0)" ::: "memory");
}
struct SrcW1 { __device__ int operator()(int n) const { return n < 880 ? n : (n < 1024 ? -1 : n - 144); } };
struct SrcId { __device__ int operator()(int n) const { return n; } };
struct SrcQRope { __device__ int operator()(int n) const { return (n >> 5) * 128 + (n & 31); } };

__device__ __forceinline__ void p0_fold_unit(const Params& P, int unit, LAS unsigned char* lds) {
    const int tid = threadIdx.x, h = unit >> 5, kb = (unit >> 2) & 7, rq = unit & 3;
    LAS float* wuk = (LAS float*)lds;
    LAS float* wuq = (LAS float*)(lds + 24576);
    for (int i = tid; i < 96 * 64; i += NTHR) { const int nn = i >> 6, r = i & 63; wuk[i] = P.w_uk[((size_t)h * 96 + nn) * 256 + rq * 64 + r]; }
    for (int i = tid; i < 64 * 96; i += NTHR) { const int k = i / 96, nn = i % 96; wuq[i] = P.w_uq[(size_t)(kb * 64 + k) * 1024 + h * 128 + 32 + nn]; }
    __syncthreads();
    const int r = tid & 63, kg = __builtin_amdgcn_readfirstlane(tid >> 6);
    float acc[8];
#pragma unroll
    for (int i = 0; i < 8; ++i) acc[i] = 0.f;
#pragma unroll 2
    for (int nn = 0; nn < 96; nn += 4) { const float b0 = wuk[nn * 64 + r], b1 = wuk[(nn + 1) * 64 + r], b2 = wuk[(nn + 2) * 64 + r], b3 = wuk[(nn + 3) * 64 + r];
#pragma unroll
        for (int i = 0; i < 8; ++i) { const f32x4 a = *(const LAS f32x4*)(wuq + (kg * 8 + i) * 96 + nn); acc[i] += (a[0] * b0 + a[1] * b1) + (a[2] * b2 + a[3] * b3); } }
    h16* dst = (h16*)(P.ws + WS_WQT) + (size_t)(256 + h * 256 + rq * 64 + r) * 512 + kb * 64 + kg * 8;
    const float* gq = P.g_q + kb * 64 + kg * 8;
    u32x4 o; o.x = pk2h(acc[0] * gq[0], acc[1] * gq[1]); o.y = pk2h(acc[2] * gq[2], acc[3] * gq[3]); o.z = pk2h(acc[4] * gq[4], acc[5] * gq[5]); o.w = pk2h(acc[6] * gq[6], acc[7] * gq[7]);
    *(u32x4*)dst = o;
    __syncthreads();
}
__device__ __forceinline__ void phase_prologue(const Params& P, LAS unsigned char* lds) {
    const int tid = threadIdx.x, lane = tid & 63, w = tid >> 6, G = gridDim.x, bid = blockIdx.x;
    PROF_B(50);
    for (int u = bid; u < 192; u += G) p0_mod_unit(P, u, lds);
    PROF_E(50); PROF_B(51);
    for (int u = bid; u < 256; u += G) p0_fold_unit(P, u, lds);
    PROF_E(51); PROF_B(52);
    {
        float* r32 = (float*)(P.ws + WS_ROPE32); float* r16 = (float*)(P.ws + WS_ROPE16);
        for (int e = bid * NTHR + tid; e < SEQ * 24; e += G * NTHR) {
            const int pos = e / 24, i = e % 24;
            const float inv = (i < 16) ? (float)pow(500000.0, -(double)i / 16.0) : (float)pow(500000.0, -(double)(i - 16) / 8.0);
            const float ang = (float)pos * inv;
            const float cv = (float)cos((double)ang), sv = (float)sin((double)ang);
            if (i < 16) { r32[((size_t)pos * 16 + i) * 2] = cv; r32[((size_t)pos * 16 + i) * 2 + 1] = sv; }
            else { r16[((size_t)pos * 8 + (i - 16)) * 2] = cv; r16[((size_t)pos * 8 + (i - 16)) * 2 + 1] = sv; }
        }
    }
    {
        h16* WUVT = (h16*)(P.ws + WS_WUVT);
        for (int e = bid * NTHR + tid; e < 1024 * 32; e += G * NTHR) { const int n = e >> 5, c8 = e & 31, hh = n >> 7; const int k = ((hh & 1) ? 0 : 256) + c8 * 8;
            *(u32x4*)(WUVT + (size_t)n * 512 + k) = (u32x4){0u, 0u, 0u, 0u}; }
    }
    PROF_E(52); PROF_B(53);
    LAS float* scr = (LAS float*)(lds + w * 16384);
    const int gw = bid * NWAVE + w, NGW = G * NWAVE;
    constexpr int I_W1 = 32 * 96, I_QR = 8 * 4, I_QI = 8 * 16, I_UV = 8 * 4 * 2, I_WO = 32 * 32;
    for (int it = gw; it < I_W1 + I_QR + I_QI + I_UV + I_WO; it += NGW) {
        int r = it;
        if (r < I_W1) { transpose_item(P.w_in, 6000, nullptr, (h16*)(P.ws + WS_W1T), 2048, (r / 96) * 64, (r % 96) * 64, SrcW1(), scr, lane); continue; } r -= I_W1;
        if (r < I_QR) { transpose_item(P.w_uq, 1024, P.g_q, (h16*)(P.ws + WS_WQT), 512, (r / 4) * 64, (r % 4) * 64, SrcQRope(), scr, lane); continue; } r -= I_QR;
        if (r < I_QI) { transpose_item(P.w_uq_idx, 1024, P.g_q, (h16*)(P.ws + WS_WQT) + (size_t)2304 * 512, 512, (r / 16) * 64, (r % 16) * 64, SrcId(), scr, lane); continue; } r -= I_QI;
        if (r < I_UV) { const int hh = r >> 3, kb = (r >> 1) & 3, nb = r & 1;
            transpose_item(P.w_uv + (size_t)hh * 256 * 128, 128, nullptr, (h16*)(P.ws + WS_WUVT) + (size_t)(hh * 128) * 512 + 256 * (hh & 1), 512, kb * 64, nb * 64, SrcId(), scr, lane); continue; } r -= I_UV;
        transpose_item(P.w_out, 2048, nullptr, (h16*)(P.ws + WS_WOT), 2048, (r / 32) * 64, (r % 32) * 64, SrcId(), scr, lane);
    }
    PROF_E(53);
}

__device__ __forceinline__ void load_mod(const Params& P, int b, int off, LAS float* dst, bool plus1) {
    const float* MODP = (const float*)(P.ws + WS_MODP);
    for (int j = threadIdx.x; j < 2048; j += NTHR) { float s = P.b_ada[off + j];
#pragma unroll
        for (int kc = 0; kc < 8; ++kc) s += MODP[(size_t)(kc * 4 + b) * 6144 + off + j];
        dst[j] = plus1 ? 1.0f + s : s; }
}
__device__ __forceinline__ void phase_h(const Params& P, LAS unsigned char* lds) {
    const int tid = threadIdx.x, lane = tid & 63, w = tid >> 6;
    LAS float* shift = (LAS float*)lds; LAS float* scale1 = (LAS float*)(lds + 8192);
    h16* H = (h16*)(P.ws + WS_H);
    for (int ch = blockIdx.x; ch < 256; ch += gridDim.x) {
        const int b = ch >> 6;
        __syncthreads();
        load_mod(P, b, 0, shift, false); load_mod(P, b, 2048, scale1, true);
        __syncthreads();
        for (int i = 0; i < 8; ++i) {
            const int row = ch * 64 + w * 8 + i;
            const float* xr = P.x + (size_t)row * DM + 4 * lane;
            f32x4 v[8]; float ss = 0.f;
#pragma unroll
            for (int j = 0; j < 8; ++j) { v[j] = *(const f32x4*)(xr + 256 * j); ss += (v[j][0] * v[j][0] + v[j][1] * v[j][1]) + (v[j][2] * v[j][2] + v[j][3] * v[j][3]); }
            const float rstd = 1.0f / sqrtf(wave_sum(ss) * (1.0f / DM) + EPS);
#pragma unroll
            for (int j = 0; j < 8; ++j) { const int col = 4 * lane + 256 * j; const f32x4 g = *(const f32x4*)(P.g_pre + col);
                const f32x4 s1 = *(const LAS f32x4*)(scale1 + col), sh = *(const LAS f32x4*)(shift + col);
                const f32x4 o = v[j] * rstd * g * s1 + sh; u32x2 pk; pk.x = pk2h(o[0], o[1]); pk.y = pk2h(o[2], o[3]);
                *(u32x2*)(H + (size_t)row * DM + col) = pk; }
        }
    }
}
__device__ __forceinline__ void phase_rowops(const Params& P) {
    const int tid = threadIdx.x, lane = tid & 63, w = tid >> 6;
    h16* KVC = (h16*)(P.ws + WS_KVC); h16* KIDX = (h16*)(P.ws + WS_KIDX); float* WIDX = (float*)(P.ws + WS_WIDX);
    const float* SMALL = (const float*)(P.ws + WS_SMALL); const float* r32 = (const float*)(P.ws + WS_ROPE32); const float* r16 = (const float*)(P.ws + WS_ROPE16);
    for (int row = blockIdx.x * NWAVE + w; row < T; row += gridDim.x * NWAVE) {
        const int pos = row & (SEQ - 1);
        h16* kr = KVC + (size_t)row * KVW;
        const h16x4 raw = *(const h16x4*)(kr + 4 * lane);
        float v[4]; float ss = 0.f;
#pragma unroll
        for (int e = 0; e < 4; ++e) { v[e] = (float)raw[e]; ss += v[e] * v[e]; }
        const float rstd = 1.0f / sqrtf(wave_sum(ss) * (1.0f / 256.0f) + EPS);
        const f32x4 g = *(const f32x4*)(P.g_kv + 4 * lane);
        u32x2 pk; pk.x = pk2h(v[0] * rstd * g[0], v[1] * rstd * g[1]); pk.y = pk2h(v[2] * rstd * g[2], v[3] * rstd * g[3]);
        *(u32x2*)(kr + 4 * lane) = pk;
        const float* sm = SMALL + (size_t)row * 128;
        if (lane < 32) {
            const int i = lane & 15; const float x1 = sm[i], x2 = sm[i + 16]; const float cv = r32[((size_t)pos * 16 + i) * 2], sv = r32[((size_t)pos * 16 + i) * 2 + 1];
            kr[256 + lane] = (h16)(lane < 16 ? x1 * cv - x2 * sv : x2 * cv + x1 * sv);
        }
        {
            float o = sm[32 + lane];
            if (lane < 16) { const int i = lane & 7; const float x1 = sm[32 + i], x2 = sm[32 + i + 8]; const float cv = r16[((size_t)pos * 8 + i) * 2], sv = r16[((size_t)pos * 8 + i) * 2 + 1];
                o = lane < 8 ? x1 * cv - x2 * sv : x2 * cv + x1 * sv; }
            KIDX[(size_t)row * 64 + lane] = (h16)o;
        }
        if (lane < 16) WIDX[(size_t)row * 16 + lane] = sm[96 + lane] * (1.0f / 32.0f);
    }
}
__device__ __forceinline__ void phase_final(const Params& P, LAS unsigned char* lds) {
    const int tid = threadIdx.x, lane = tid & 63, w = tid >> 6;
    LAS float* gate = (LAS float*)lds;
    const h16* Y = (const h16*)(P.ws + WS_Y); const float* SSY = (const float*)(P.ws + WS_SSY);
    for (int ch = blockIdx.x; ch < 256; ch += gridDim.x) {
        const int b = ch >> 6;
        __syncthreads();
        load_mod(P, b, 4096, gate, false);
        __syncthreads();
        for (int i = 0; i < 8; i += 2) {
            const int row0 = ch * 64 + w * 8 + i;
            float ss = SSY[(size_t)row0 * 32 + lane];
#pragma unroll
            for (int o = 1; o < 32; o <<= 1) ss += __shfl_xor(ss, o);
            const float rstd_mine = __builtin_amdgcn_rsqf(ss * (1.0f / DM) + EPS);
            const float rstd0 = __shfl(rstd_mine, 0), rstd1 = __shfl(rstd_mine, 32);
            f32x4 xv[2][8]; h16x4 yv[2][8];
#pragma unroll
            for (int rr = 0; rr < 2; ++rr)
#pragma unroll
                for (int j = 0; j < 8; ++j) { const int col = 4 * lane + 256 * j;
                    xv[rr][j] = __builtin_nontemporal_load((const f32x4*)(P.x + (size_t)(row0 + rr) * DM + col)); yv[rr][j] = *(const h16x4*)(Y + (size_t)(row0 + rr) * DM + col); }
#pragma unroll
            for (int rr = 0; rr < 2; ++rr) { const float rstd = rr ? rstd1 : rstd0;
#pragma unroll
                for (int j = 0; j < 8; ++j) { const int col = 4 * lane + 256 * j;
                    const f32x4 g = *(const f32x4*)(P.g_post + col), gt = *(const LAS f32x4*)(gate + col);
                    f32x4 o;
#pragma unroll
                    for (int e = 0; e < 4; ++e) o[e] = xv[rr][j][e] + gt[e] * ((float)yv[rr][j][e] * rstd * g[e]);
                    __builtin_nontemporal_store(o, (f32x4*)(P.out + (size_t)(row0 + rr) * DM + col)); } }
        }
    }
}


constexpr int SP_PITCH = 592;
constexpr int SP_BUF = 32 * SP_PITCH;
constexpr int SP_LIST = 8 * SP_BUF;
__device__ __forceinline__ void sparse_attn_query(const Params& P, LAS unsigned char* lds, int wid, int lane, int b, int row, int kvalid, const LAS unsigned short* list);
typedef float f32x16 __attribute__((ext_vector_type(16)));
typedef short s16x4 __attribute__((ext_vector_type(4)));
__device__ __forceinline__ unsigned imgb_off(unsigned row, unsigned ch) { return 256u * row + 16u * (ch ^ (((row & 3u) << 2) | ((row >> 2) & 3u))); }
constexpr int DIL_STG = 98304, DIL_LSE = DIL_STG + 8 * 4608;
__device__ __forceinline__ void dil_load(u32x4 (&rg)[12], const h16* src_bh, int m0, int dil, int res, int tid) {
#pragma unroll
    for (int p = 0; p < 12; ++p) {
        const int kk = p * 32 + (tid >> 4); int j = m0 - 128 + kk; j = j < 0 ? 0 : j;
        const unsigned sw = (unsigned)(((kk & 3) << 2) | ((kk >> 2) & 3));
        rg[p] = *(const u32x4*)(src_bh + (size_t)(j * dil + res) * 1024 + 8 * ((unsigned)(tid & 15) ^ sw));
    }
}
__device__ __forceinline__ void dil_write(LAS unsigned char* lds, const u32x4 (&rg)[12], int tid) {
#pragma unroll
    for (int p = 0; p < 12; ++p) *(LAS u32x4*)(lds + p * 8192 + tid * 16) = rg[p];
}
struct DilUnit { int dil, pslot, b, h, res, blk; };
template <bool LAST>
__device__ __forceinline__ void dilated_unit(const Params& P, LAS unsigned char* lds, const DilUnit u, u32x4 (&kv)[12], const DilUnit nxt, bool has_next) {
    const int dil = u.dil, pslot = u.pslot, b = u.b, h = u.h, res = u.res, blk = u.blk;
    const int tid = threadIdx.x, lane = tid & 63, wid = __builtin_amdgcn_readfirstlane(tid >> 6), n = lane & 31, hi = lane >> 5;
    const int m0 = blk * 256;
    const size_t bh = (size_t)b * SEQ * 1024 + h * 128;
    const h16* QBp = (const h16*)(P.ws + WS_QB) + bh; const h16* VBp = (const h16*)(P.ws + WS_VB) + bh;
    PROF_B(10);
    dil_write(lds, kv, tid);
    dil_load(kv, VBp, m0, dil, res, tid);
    h16x8 qf[8];
    { const h16* qp = QBp + (size_t)((m0 + 32 * wid + n) * dil + res) * 1024 + 8 * hi;
#pragma unroll
      for (int ks = 0; ks < 8; ++ks) qf[ks] = *(const h16x8*)(qp + 16 * ks); }
    __syncthreads();
    PROF_E(10); PROF_B(11);
    f32x16 sa[5];
#pragma unroll
    for (int ti = 0; ti < 5; ++ti) {
#pragma unroll
        for (int r = 0; r < 16; ++r) sa[ti][r] = 0.f;
#pragma unroll
        for (int ks = 0; ks < 8; ++ks) { const h16x8 kf = *(const LAS h16x8*)(lds + imgb_off(32 * (wid + ti) + n, 2 * ks + hi));
            sa[ti] = __builtin_amdgcn_mfma_f32_32x32x16_f16(kf, qf[ks], sa[ti], 0, 0, 0); }
    }
    PROF_E(11); PROF_B(12);
    const int jmin = 128 - m0;
    float mx = -INFINITY;
#pragma unroll
    for (int ti = 0; ti < 5; ++ti)
#pragma unroll
        for (int r = 0; r < 16; ++r) { const int kin = (r & 3) + 8 * (r >> 2) + 4 * hi; bool ok = (32 * (wid + ti) + kin) >= jmin;
            if (ti == 0) ok = ok && (kin >= n); if (ti == 4) ok = ok && (kin <= n);
            const float s = ok ? sa[ti][r] : -INFINITY; sa[ti][r] = s; mx = fmaxf(mx, s); }
    mx = fmaxf(mx, __shfl_xor(mx, 32));
    float l = 0.f;
#pragma unroll
    for (int ti = 0; ti < 5; ++ti)
#pragma unroll
        for (int r = 0; r < 16; ++r) { const float p = __builtin_amdgcn_exp2f(sa[ti][r] - mx); sa[ti][r] = p; l += p; }
    l += __shfl_xor(l, 32);
    h16x8 pf[5][2];
#pragma unroll
    for (int ti = 0; ti < 5; ++ti)
#pragma unroll
        for (int s = 0; s < 2; ++s)
#pragma unroll
            for (int jj = 0; jj < 8; ++jj) pf[ti][s][jj] = (h16)sa[ti][8 * s + jj];
    PROF_E(12); PROF_B(13);
    __syncthreads();
    dil_write(lds, kv, tid);
    if (has_next) dil_load(kv, (const h16*)(P.ws + WS_KB) + (size_t)nxt.b * SEQ * 1024 + nxt.h * 128, nxt.blk * 256, nxt.dil, nxt.res, tid);
    __syncthreads();
    PROF_E(13); PROF_B(14);
    f32x16 oa[4];
#pragma unroll
    for (int c = 0; c < 4; ++c)
#pragma unroll
        for (int r = 0; r < 16; ++r) oa[c][r] = 0.f;
    const int dgrp = (lane >> 4) & 1, q4 = (lane & 15) >> 2, p4 = lane & 3;
#pragma unroll
    for (int ti = 0; ti < 5; ++ti)
#pragma unroll
        for (int s = 0; s < 2; ++s) {
#pragma unroll
            for (int c = 0; c < 4; ++c) {
                const unsigned row0 = 32 * (wid + ti) + 16 * s + 4 * hi + q4, ch = 4 * c + 2 * dgrp + (p4 >> 1);
                const s16x4 t0 = __builtin_amdgcn_ds_read_tr16_b64_v4i16((LAS s16x4*)(lds + imgb_off(row0, ch) + 8 * (p4 & 1)));
                const s16x4 t1 = __builtin_amdgcn_ds_read_tr16_b64_v4i16((LAS s16x4*)(lds + imgb_off(row0 + 8, ch) + 8 * (p4 & 1)));
                typedef short s16x8 __attribute__((ext_vector_type(8)));
                const s16x8 v8 = {t0[0], t0[1], t0[2], t0[3], t1[0], t1[1], t1[2], t1[3]};
                oa[c] = __builtin_amdgcn_mfma_f32_32x32x16_f16(__builtin_bit_cast(h16x8, v8), pf[ti][s], oa[c], 0, 0, 0);
            }
        }
    PROF_E(14); PROF_B(15);
    const float invl = 1.0f / l, lse = mx + __builtin_amdgcn_logf(l);
    LAS unsigned char* stg = lds + DIL_STG + wid * 4608;
    LAS float* lsew = (LAS float*)(lds + DIL_LSE) + wid * 32;
    float* LSEP = (float*)(P.ws + WS_LSEP);
    const int pos_n = (m0 + 32 * wid + n) * dil + res;
    if (LAST) { if (hi == 0) lsew[n] = lse; }
    else if (hi == 0) LSEP[((size_t)pslot * T + (size_t)b * SEQ + pos_n) * 8 + h] = lse;
#pragma unroll
    for (int half = 0; half < 2; ++half) {
#pragma unroll
        for (int cc = 0; cc < 2; ++cc)
#pragma unroll
            for (int rg = 0; rg < 4; ++rg) { const f32x16& o = oa[2 * half + cc]; u32x2 w2; w2.x = pk2h(o[4 * rg] * invl, o[4 * rg + 1] * invl); w2.y = pk2h(o[4 * rg + 2] * invl, o[4 * rg + 3] * invl);
                *(LAS u32x2*)(stg + n * 144 + 2 * (32 * cc + 8 * rg + 4 * hi)) = w2; }
        h16x8 m4[4], m16[4], mg[4]; float ml4[4], ml16[4];
        if (LAST) {
#pragma unroll
            for (int i = 0; i < 4; ++i) { const int rowl = (lane >> 3) + 8 * i; const size_t grow = (size_t)b * SEQ + (size_t)((m0 + 32 * wid + rowl) * dil + res); const size_t coff = (size_t)h * 128 + 64 * half + 8 * (lane & 7);
                m4[i] = *(const h16x8*)((const h16*)(P.ws + WS_OP4) + grow * 1024 + coff); m16[i] = *(const h16x8*)((const h16*)(P.ws + WS_OP16) + grow * 1024 + coff);
                mg[i] = *(const h16x8*)((const h16*)(P.ws + WS_SGB) + grow * 1024 + coff); ml4[i] = LSEP[grow * 8 + h]; ml16[i] = LSEP[((size_t)T + grow) * 8 + h]; }
        }
        asm volatile("s_waitcnt lgkmcnt(0)" ::: "memory");
#pragma unroll
        for (int i = 0; i < 4; ++i) {
            const int rowl = (lane >> 3) + 8 * i, ch = lane & 7;
            const u32x4 v = *(const LAS u32x4*)(stg + rowl * 144 + 16 * ch);
            const size_t grow = (size_t)b * SEQ + (size_t)((m0 + 32 * wid + rowl) * dil + res);
            const size_t coff = (size_t)h * 128 + 64 * half + 8 * ch;
            if (!LAST) { *(u32x4*)((h16*)(P.ws + (pslot ? WS_OP16 : WS_OP4)) + grow * 1024 + coff) = v; }
            else {
                const float l1 = lsew[rowl], l4 = ml4[i], l16 = ml16[i];
                const float mm = fmaxf(l1, fmaxf(l4, l16));
                const float w1 = __builtin_amdgcn_exp2f(l1 - mm), w4 = __builtin_amdgcn_exp2f(l4 - mm), w16 = __builtin_amdgcn_exp2f(l16 - mm), iw = 1.0f / (w1 + w4 + w16);
                const h16x8 o1 = __builtin_bit_cast(h16x8, v);
                float r8[8];
#pragma unroll
                for (int e = 0; e < 8; ++e) r8[e] = (w1 * (float)o1[e] + w4 * (float)m4[i][e] + w16 * (float)m16[i][e]) * iw * (float)mg[i][e];
                u32x4 ov; ov.x = pk2h(r8[0], r8[1]); ov.y = pk2h(r8[2], r8[3]); ov.z = pk2h(r8[4], r8[5]); ov.w = pk2h(r8[6], r8[7]);
                *(u32x4*)((h16*)(P.ws + WS_OAB) + grow * 2048 + 1024 + coff) = ov;
            }
        }
        asm volatile("s_waitcnt lgkmcnt(0)" ::: "memory");
    }
    __syncthreads();
    PROF_E(15);
}
__device__ __forceinline__ DilUnit dil_part_unit(int idx) {
    const int cfg = idx >> 9, w_ = idx & 511, xcd = w_ & 7, lu = w_ >> 3, bhh = xcd * 4 + (lu >> 4), rb = lu & 15;
    DilUnit u; u.b = bhh >> 3; u.h = bhh & 7;
    if (cfg == 0) { u.dil = 4; u.pslot = 0; u.res = rb & 3; u.blk = rb >> 2; } else { u.dil = 16; u.pslot = 1; u.res = rb; u.blk = 0; }
    return u;
}
__device__ __forceinline__ DilUnit dil_last_unit(int idx) {
    const int xcd = idx & 7, lu = idx >> 3, bhh = xcd * 4 + (lu >> 4);
    DilUnit u; u.b = bhh >> 3; u.h = bhh & 7; u.dil = 1; u.pslot = 0; u.res = 0; u.blk = lu & 15;
    return u;
}
__device__ __forceinline__ void phase_dilated_part(const Params& P, LAS unsigned char* lds) {
    int idx = blockIdx.x; if (idx >= 1024) return;
    u32x4 kv[12];
    DilUnit u = dil_part_unit(idx);
    dil_load(kv, (const h16*)(P.ws + WS_KB) + (size_t)u.b * SEQ * 1024 + u.h * 128, u.blk * 256, u.dil, u.res, threadIdx.x);
    for (;;) {
        const int nidx = idx + gridDim.x; const bool hn = nidx < 1024; const DilUnit nu = dil_part_unit(hn ? nidx : idx);
        dilated_unit<false>(P, lds, u, kv, nu, hn);
        if (!hn) break;
        idx = nidx; u = nu;
    }
}
__device__ __forceinline__ void phase_dilated_last(const Params& P, LAS unsigned char* lds) {
    int idx = blockIdx.x; if (idx >= 512) return;
    u32x4 kv[12];
    DilUnit u = dil_last_unit(idx);
    dil_load(kv, (const h16*)(P.ws + WS_KB) + (size_t)u.b * SEQ * 1024 + u.h * 128, u.blk * 256, u.dil, u.res, threadIdx.x);
    for (;;) {
        const int nidx = idx + gridDim.x; const bool hn = nidx < 512; const DilUnit nu = dil_last_unit(hn ? nidx : idx);
        dilated_unit<true>(P, lds, u, kv, nu, hn);
        if (!hn) break;
        idx = nidx; u = nu;
    }
}

__device__ __forceinline__ void sparse_attn_query(const Params& P, LAS unsigned char* lds, int wid, int lane_in, int b, int row, int kvalid, const LAS unsigned short* list) {
    int lane = lane_in; asm volatile("" : "+v"(lane));
    LAS unsigned char* buf = lds + wid * SP_BUF;
    const int n = lane & 15, g = lane >> 4, q4 = n >> 2, p4 = n & 3, sub = lane >> 2, c4 = lane & 3;
    PROF_B(30);
    h16x8 qf[9];
    {
        const h16* ql = (const h16*)(P.ws + WS_QLAT) + ((size_t)row * 8 + (n & 7)) * 256 + 8 * g;
        const h16* qr = (const h16*)(P.ws + WS_QROPE) + ((size_t)row * 8 + (n & 7)) * 32 + 8 * g;
        const h16x8 z = {(h16)0.f, (h16)0.f, (h16)0.f, (h16)0.f, (h16)0.f, (h16)0.f, (h16)0.f, (h16)0.f};
#pragma unroll
        for (int ks = 0; ks < 8; ++ks) { const h16x8 v = *(const h16x8*)(ql + 32 * ks); qf[ks] = (n < 8) ? v : z; }
        { const h16x8 v = *(const h16x8*)qr; qf[8] = (n < 8) ? v : z; }
    }
    f32x4 oacc[16];
#pragma unroll
    for (int dt = 0; dt < 16; ++dt) oacc[dt] = (f32x4){0.f, 0.f, 0.f, 0.f};
    float m = -INFINITY, l = 0.f;
    const unsigned char* kvb = P.ws + WS_KVC + (size_t)b * SEQ * (KVW * 2) + 16 * c4;
    u32x4 stg[18];
#define SP_ISSUE(step_) do { unsigned i0 = list[32 * (step_) + sub], i1 = list[32 * (step_) + 16 + sub]; i0 = (i0 == 0xFFFFu) ? 0u : i0; i1 = (i1 == 0xFFFFu) ? 0u : i1; \
        const unsigned char* r0 = kvb + (size_t)i0 * 576; const unsigned char* r1 = kvb + (size_t)i1 * 576; \
        _Pragma("unroll") for (int cg = 0; cg < 9; ++cg) { stg[2 * cg] = *(const u32x4*)(r0 + 64 * cg); stg[2 * cg + 1] = *(const u32x4*)(r1 + 64 * cg); } } while (0)
    SP_ISSUE(0);
    PROF_E(30);
    for (int step = 0; step < 8; ++step) {
        PROF_B(31);
#pragma unroll
        for (int cg = 0; cg < 9; ++cg) { *(LAS u32x4*)(buf + SP_PITCH * sub + 64 * cg + 16 * c4) = stg[2 * cg]; *(LAS u32x4*)(buf + SP_PITCH * (16 + sub) + 64 * cg + 16 * c4) = stg[2 * cg + 1]; }
        if (step < 7) SP_ISSUE(step + 1);
        asm volatile("s_waitcnt lgkmcnt(0)" ::: "memory");
        PROF_E(31); PROF_B(32);
        __builtin_amdgcn_s_setprio(1);
        f32x4 s0 = (f32x4){0.f, 0.f, 0.f, 0.f}, s1 = (f32x4){0.f, 0.f, 0.f, 0.f};
#pragma unroll
        for (int ks = 0; ks < 9; ++ks) {
            const h16x8 a0 = *(const LAS h16x8*)(buf + SP_PITCH * n + 64 * ks + 16 * g), a1 = *(const LAS h16x8*)(buf + SP_PITCH * (16 + n) + 64 * ks + 16 * g);
            s0 = __builtin_amdgcn_mfma_f32_16x16x32_f16(a0, qf[ks], s0, 0, 0, 0); s1 = __builtin_amdgcn_mfma_f32_16x16x32_f16(a1, qf[ks], s1, 0, 0, 0);
        }
        PROF_E(32); PROF_B(33);
        float mx = -INFINITY;
#pragma unroll
        for (int r = 0; r < 4; ++r) { const int lp = 32 * step + 4 * g + r;
            s0[r] = (lp < kvalid) ? s0[r] : -INFINITY; s1[r] = (lp + 16 < kvalid) ? s1[r] : -INFINITY; mx = fmaxf(mx, fmaxf(s0[r], s1[r])); }
        mx = fmaxf(mx, __shfl_xor(mx, 16)); mx = fmaxf(mx, __shfl_xor(mx, 32));
        if (__builtin_amdgcn_ballot_w64(mx > m + 8.0f) != 0ull) {
            const float mnew = fmaxf(m, mx), alpha = __builtin_amdgcn_exp2f(m - mnew);
            m = mnew; l *= alpha;
#pragma unroll
            for (int dt = 0; dt < 16; ++dt) oacc[dt] = oacc[dt] * alpha;
        }
        h16x8 pf;
#pragma unroll
        for (int r = 0; r < 4; ++r) { const float p0 = __builtin_amdgcn_exp2f(s0[r] - m), p1 = __builtin_amdgcn_exp2f(s1[r] - m); l += p0 + p1; pf[r] = (h16)p0; pf[4 + r] = (h16)p1; }
        PROF_E(33); PROF_B(34);
#pragma unroll
        for (int dt = 0; dt < 16; ++dt) {
            const s16x4 t0 = __builtin_amdgcn_ds_read_tr16_b64_v4i16((LAS s16x4*)(buf + SP_PITCH * (4 * g + q4) + 32 * dt + 8 * p4));
            const s16x4 t1 = __builtin_amdgcn_ds_read_tr16_b64_v4i16((LAS s16x4*)(buf + SP_PITCH * (16 + 4 * g + q4) + 32 * dt + 8 * p4));
            typedef short s16x8 __attribute__((ext_vector_type(8)));
            const s16x8 v8 = {t0[0], t0[1], t0[2], t0[3], t1[0], t1[1], t1[2], t1[3]};
            oacc[dt] = __builtin_amdgcn_mfma_f32_16x16x32_f16(__builtin_bit_cast(h16x8, v8), pf, oacc[dt], 0, 0, 0);
        }
        __builtin_amdgcn_s_setprio(0);
        asm volatile("s_waitcnt lgkmcnt(0)" ::: "memory");
        PROF_E(34);
    }
#undef SP_ISSUE
    PROF_B(35);
    l += __shfl_xor(l, 16); l += __shfl_xor(l, 32);
    const float inv = 1.0f / l;
    if (n < 8) {
        h16* op = (h16*)(P.ws + WS_OLAT) + ((size_t)row * 8 + n) * 256 + 4 * g;
#pragma unroll
        for (int dt = 0; dt < 16; ++dt) { u32x2 w2; w2.x = pk2h(oacc[dt][0] * inv, oacc[dt][1] * inv); w2.y = pk2h(oacc[dt][2] * inv, oacc[dt][3] * inv); *(u32x2*)(op + 16 * dt) = w2; }
    }
    PROF_E(35);
}

constexpr int DS_QI = 0;
constexpr int DS_WQ = 36864;
constexpr int DS_CNTB = DS_WQ + 1024;
constexpr int DS_CGT = DS_CNTB + 1024;
constexpr int DS_CEQ = DS_CGT + 512;
constexpr int DS_PCNT = DS_CEQ + 512;
constexpr int DS_TCNT = DS_PCNT + 2048;
constexpr int DS_TLIST = DS_TCNT + 64;
constexpr int DS_TSC = DS_TLIST + 2048;
constexpr int DS_TK = DS_TSC + 4096;
constexpr int DS_LIST = SP_LIST;
constexpr int TIE_CAP = 64, TIE_FAST = 16;
__device__ __forceinline__ unsigned sortable_hi16(float s) { const unsigned bits = __float_as_uint(s + 0.0f); return ((bits & 0x80000000u) ? ~bits : (bits | 0x80000000u)) >> 16; }
typedef _Float16 h16x2v __attribute__((ext_vector_type(2)));
__device__ __forceinline__ unsigned pk_count_gt(unsigned acc, unsigned v, unsigned cm1pk) {
    unsigned d;
    asm("v_pk_sub_u16 %1, %2, %3 clamp\n\tv_pk_min_u16 %1, %1, %4\n\tv_pk_add_u16 %0, %0, %1" : "+v"(acc), "=&v"(d) : "v"(v), "v"(cm1pk), "v"(0x00010001u));
    return acc;
}
__device__ __forceinline__ unsigned pk_mask_gt(unsigned m, unsigned v, unsigned cm1pk) {
    unsigned d;
    asm("v_pk_sub_u16 %1, %2, %3 clamp\n\tv_pk_min_u16 %1, %1, %4\n\tv_lshl_or_b32 %0, %0, 1, %1" : "+v"(m), "=&v"(d) : "v"(v), "v"(cm1pk), "v"(0x00010001u));
    return m;
}
__device__ __forceinline__ unsigned wave_sum_u(unsigned v) {
    v += (unsigned)__builtin_amdgcn_update_dpp(0, (int)v, 0xB1, 0xF, 0xF, true);
    v += (unsigned)__builtin_amdgcn_update_dpp(0, (int)v, 0x4E, 0xF, 0xF, true);
    v += (unsigned)__builtin_amdgcn_update_dpp(0, (int)v, 0x141, 0xF, 0xF, true);
    v += (unsigned)__builtin_amdgcn_update_dpp(0, (int)v, 0x140, 0xF, 0xF, true);
    { const auto r = __builtin_amdgcn_permlane16_swap(v, v, false, false); v = r[0] + r[1]; }
    { const auto r = __builtin_amdgcn_permlane32_swap(v, v, false, false); v = r[0] + r[1]; }
    return v;
}
__device__ __forceinline__ void dsa_score_group(LAS unsigned char* lds, const h16x8 (&kf)[4][2], int grp, int w, int q, int kq, int tq, int ntile, unsigned (&c8)[8]) {
    const unsigned sw = (unsigned)((q >> 1) & 7);
    const LAS float* WQ = (const LAS float*)(lds + DS_WQ);
    const LAS unsigned char* qrow = lds + DS_QI + q * 128;
    const unsigned o0 = 16u * ((unsigned)kq ^ sw), o1 = 16u * ((unsigned)(4 + kq) ^ sw);
    const f32x4 zero4 = {0.f, 0.f, 0.f, 0.f};
    f32x4 acc[4];
    {
        const h16x8 a0 = *(const LAS h16x8*)(qrow + 16 * 2048 + o0), a1 = *(const LAS h16x8*)(qrow + 16 * 2048 + o1), b0 = *(const LAS h16x8*)(qrow + 17 * 2048 + o0), b1 = *(const LAS h16x8*)(qrow + 17 * 2048 + o1);
#pragma unroll
        for (int j = 0; j < 4; ++j) { acc[j] = __builtin_amdgcn_mfma_f32_16x16x32_f16(kf[j][0], a0, zero4, 0, 0, 0); acc[j] = __builtin_amdgcn_mfma_f32_16x16x32_f16(kf[j][1], a1, acc[j], 0, 0, 0);
            acc[j] = __builtin_amdgcn_mfma_f32_16x16x32_f16(kf[j][0], b0, acc[j], 0, 0, 0); acc[j] = __builtin_amdgcn_mfma_f32_16x16x32_f16(kf[j][1], b1, acc[j], 0, 0, 0); }
    }
#define DSA_MM(lg, qa, qb) do { _Pragma("unroll") for (int j = 0; j < 4; ++j) lg[j] = __builtin_amdgcn_mfma_f32_16x16x32_f16(kf[j][0], qa, zero4, 0, 0, 0); \
        _Pragma("unroll") for (int j = 0; j < 4; ++j) lg[j] = __builtin_amdgcn_mfma_f32_16x16x32_f16(kf[j][1], qb, lg[j], 0, 0, 0); } while (0)
#define DSA_ACC(lg, wv) do { _Pragma("unroll") for (int j = 0; j < 4; ++j) _Pragma("unroll") for (int r = 0; r < 4; ++r) \
        asm volatile("v_fma_f32 %0, |%1|, %2, %0" : "+v"(acc[j][r]) : "v"(lg[j][r]), "v"(wv)); } while (0)
    f32x4 lgA[4], lgB[4];
    h16x8 qa0 = *(const LAS h16x8*)(qrow + o0), qa1 = *(const LAS h16x8*)(qrow + o1); float wa = WQ[q * 16];
    h16x8 qb0 = *(const LAS h16x8*)(qrow + 2048 + o0), qb1 = *(const LAS h16x8*)(qrow + 2048 + o1); float wb = WQ[q * 16 + 1];
    DSA_MM(lgA, qa0, qa1);
    for (int h = 0; h < 16; h += 2) {
        __builtin_amdgcn_sched_barrier(0);
        DSA_MM(lgB, qb0, qb1);
        const int h2 = (h + 2) & 15, h3 = (h + 3) & 15;
        qa0 = *(const LAS h16x8*)(qrow + h2 * 2048 + o0); qa1 = *(const LAS h16x8*)(qrow + h2 * 2048 + o1); const float wa2 = WQ[q * 16 + h2];
        __builtin_amdgcn_sched_barrier(0);
        DSA_ACC(lgA, wa);
        __builtin_amdgcn_sched_barrier(0);
        if (h < 14) DSA_MM(lgA, qa0, qa1);
        qb0 = *(const LAS h16x8*)(qrow + h3 * 2048 + o0); qb1 = *(const LAS h16x8*)(qrow + h3 * 2048 + o1); const float wb2 = WQ[q * 16 + h3];
        __builtin_amdgcn_sched_barrier(0);
        if (h >= 14) asm volatile("s_nop 7\n\ts_nop 7" ::: );
        DSA_ACC(lgB, wb);
        wa = wa2; wb = wb2;
    }
#undef DSA_MM
#undef DSA_ACC
    const int tt0 = w + 32 * grp;
#pragma unroll
    for (int j = 0; j < 4; ++j) { const int tt = tt0 + 8 * j; unsigned c4[4];
#pragma unroll
        for (int r = 0; r < 4; ++r) { const int k = 16 * tt + 4 * kq + r; c4[r] = (tt < ntile && k <= tq) ? sortable_hi16(acc[j][r]) : 0u; }
        c8[j * 2] = c4[0] | (c4[1] << 16); c8[j * 2 + 1] = c4[2] | (c4[3] << 16); }
}

__device__ __forceinline__ void dsa_select_unit(const Params& P, LAS unsigned char* lds, int b, int uq, int stages = 9) {
    int tid = threadIdx.x; asm volatile("" : "+v"(tid));
    const int lane = tid & 63, w = __builtin_amdgcn_readfirstlane(tid >> 6), q = lane & 15, kq = lane >> 4;
    const int t0 = 16 * uq, row0 = b * SEQ + t0, tq = t0 + q, ntile = uq + 1, Kq = (tq + 1 < 256) ? tq + 1 : 256;
    const h16* QIDX = (const h16*)(P.ws + WS_QIDX); const h16* KIDX = (const h16*)(P.ws + WS_KIDX) + (size_t)b * SEQ * 64; const float* WIDX = (const float*)(P.ws + WS_WIDX);
    LAS float* WQ = (LAS float*)(lds + DS_WQ); LAS unsigned* CNTB = (LAS unsigned*)(lds + DS_CNTB); LAS unsigned* CGT = (LAS unsigned*)(lds + DS_CGT); LAS unsigned* CEQ = (LAS unsigned*)(lds + DS_CEQ);
    LAS unsigned* PCNT = (LAS unsigned*)(lds + DS_PCNT); LAS unsigned* TCNT = (LAS unsigned*)(lds + DS_TCNT); LAS unsigned short* TLIST = (LAS unsigned short*)(lds + DS_TLIST);
    LAS float* TSC = (LAS float*)(lds + DS_TSC); LAS unsigned short* LIST = (LAS unsigned short*)(lds + DS_LIST);
    PROF_B(20);
#pragma unroll
    for (int i = 0; i < 4; ++i) { const int pc = 4 * w + i, head = pc >> 1, r = 8 * (pc & 1) + (lane >> 3), c = lane & 7;
        __builtin_amdgcn_global_load_lds((const unsigned*)(QIDX + (size_t)(row0 + r) * 1024 + head * 64 + 8 * (c ^ ((r >> 1) & 7))), (LAS unsigned*)(lds + DS_QI + pc * 1024), 16, 0, 0); }
    {
        const int r = tid >> 5, d2 = tid & 31; float a0 = 0.f, a1 = 0.f;
        const h16* qp = QIDX + (size_t)(row0 + r) * 1024 + 2 * d2; const float* wp = WIDX + (size_t)(row0 + r) * 16;
#pragma unroll
        for (int h = 0; h < 16; ++h) { const h16x2v qv = *(const h16x2v*)(qp + h * 64); const float wv = wp[h]; a0 += wv * (float)qv[0]; a1 += wv * (float)qv[1]; }
        const h16 h0 = (h16)a0, h1 = (h16)a1; const h16 l0 = (h16)(a0 - (float)h0), l1 = (h16)(a1 - (float)h1);
        const unsigned off = r * 128 + 16 * ((unsigned)(d2 >> 2) ^ (unsigned)((r >> 1) & 7)) + 4 * (d2 & 3);
        const h16x2v hv = {h0, h1}, lv = {l0, l1};
        *(LAS h16x2v*)(lds + DS_QI + 16 * 2048 + off) = hv; *(LAS h16x2v*)(lds + DS_QI + 17 * 2048 + off) = lv;
    }
    if (tid < 256) WQ[tid] = WIDX[(size_t)(row0 + (tid >> 4)) * 16 + (tid & 15)];
    if (tid < 16) TCNT[tid] = 0u;
    *(LAS u32x4*)(lds + DS_LIST + tid * 16) = (u32x4){0xFFFFFFFFu, 0xFFFFFFFFu, 0xFFFFFFFFu, 0xFFFFFFFFu};
    asm volatile("s_waitcnt vmcnt(0)" ::: "memory");
    __syncthreads();
    PROF_E(20); PROF_B(21);
    unsigned cs[64];
#pragma unroll
    for (int i = 0; i < 64; ++i) cs[i] = 0u;
    h16x8 kfA[4][2], kfB[4][2];
#define DSA_LOADK(kf, grp_) do { _Pragma("unroll") for (int j = 0; j < 4; ++j) { const int tt = w + 32 * (grp_) + 8 * j, ttc = tt < ntile ? tt : ntile - 1; \
        const h16* kp = KIDX + (size_t)(16 * ttc + q) * 64 + 8 * kq; kf[j][0] = *(const h16x8*)kp; kf[j][1] = *(const h16x8*)(kp + 32); } } while (0)
    DSA_LOADK(kfA, 0);
    for (int gp = 0; gp < 4; ++gp) {
        if (w + 64 * gp >= ntile) break;
        DSA_LOADK(kfB, 2 * gp + 1);
        unsigned ca[8], cb[8];
        dsa_score_group(lds, kfA, 2 * gp, w, q, kq, tq, ntile, ca);
        if (gp < 3) DSA_LOADK(kfA, 2 * gp + 2);
        if (w + 64 * gp + 32 < ntile) dsa_score_group(lds, kfB, 2 * gp + 1, w, q, kq, tq, ntile, cb);
        else {
#pragma unroll
            for (int i = 0; i < 8; ++i) cb[i] = 0u;
        }
#define CS_PUT(G) case G: _Pragma("unroll") for (int i = 0; i < 8; ++i) { cs[G * 16 + i] = ca[i]; cs[G * 16 + 8 + i] = cb[i]; } break;
        switch (gp) { CS_PUT(0) CS_PUT(1) CS_PUT(2) default: _Pragma("unroll") for (int i = 0; i < 8; ++i) { cs[48 + i] = ca[i]; cs[56 + i] = cb[i]; } break; }
#undef CS_PUT
    }
#undef DSA_LOADK
    if (stages < 2) { unsigned x = 0; _Pragma("unroll") for (int i = 0; i < 64; ++i) x ^= cs[i]; asm volatile("" :: "v"(x)); __syncthreads(); return; }
    PROF_E(21); PROF_B(22);
    constexpr int RB_OFF = DS_TK, RB_PITCH = 8208;
    unsigned ks[64];
#pragma unroll
    for (int rnd = 0; rnd < 2; ++rnd) {
        if ((q >> 3) == rnd) {
#pragma unroll
            for (int i = 0; i < 64; ++i) { const int grp = i >> 3, jj = (i >> 1) & 3; const int key0 = 16 * (w + 32 * grp + 8 * jj) + 4 * kq + 2 * (i & 1);
                *(LAS unsigned*)(lds + RB_OFF + (q & 7) * RB_PITCH + key0 * 2) = cs[i]; }
        }
        __syncthreads();
        if ((w >> 2) == rnd) {
#pragma unroll
            for (int qi = 0; qi < 2; ++qi)
#pragma unroll
                for (int j = 0; j < 8; ++j) { const u32x4 v = *(const LAS u32x4*)(lds + RB_OFF + ((2 * w + qi) & 7) * RB_PITCH + (64 * j + lane) * 16);
                    ks[32 * qi + 4 * j] = v.x; ks[32 * qi + 4 * j + 1] = v.y; ks[32 * qi + 4 * j + 2] = v.z; ks[32 * qi + 4 * j + 3] = v.w; }
        }
        __syncthreads();
    }
    PROF_E(22); PROF_B(23);
    if (stages < 3) { unsigned x = 0; _Pragma("unroll") for (int i = 0; i < 64; ++i) x ^= ks[i]; asm volatile("" :: "v"(x)); __syncthreads(); return; }
    unsigned ntieq[2], needq[2], gtq[2];
#pragma unroll
    for (int qi = 0; qi < 2; ++qi) {
        const int ql = 2 * w + qi, K = (t0 + ql + 1 < 256) ? t0 + ql + 1 : 256;
        unsigned thr = 0u;
        for (int bit = 15; bit >= 0; --bit) {
            const unsigned cand = thr | (1u << bit), cm1 = (cand - 1u) * 0x00010001u; unsigned cp0 = 0u, cp1 = 0u, cp2 = 0u, cp3 = 0u;
#pragma unroll
            for (int i = 0; i < 32; i += 4) { cp0 = pk_count_gt(cp0, ks[32 * qi + i], cm1); cp1 = pk_count_gt(cp1, ks[32 * qi + i + 1], cm1); cp2 = pk_count_gt(cp2, ks[32 * qi + i + 2], cm1); cp3 = pk_count_gt(cp3, ks[32 * qi + i + 3], cm1); }
            const unsigned cp = (cp0 + cp1) + (cp2 + cp3);
            const unsigned tot = wave_sum_u((cp & 0xFFFFu) + (cp >> 16));
            if (tot >= (unsigned)K) thr = cand;
        }
        unsigned mg[2], me[2];
        { const unsigned t0p = thr * 0x00010001u, t1p = (thr - 1u) * 0x00010001u;
#pragma unroll
          for (int m = 0; m < 2; ++m) { unsigned g_ = 0u, e_ = 0u;
#pragma unroll
              for (int ii = 0; ii < 16; ++ii) { g_ = pk_mask_gt(g_, ks[32 * qi + 16 * m + ii], t0p); e_ = pk_mask_gt(e_, ks[32 * qi + 16 * m + ii], t1p); }
              mg[m] = g_; me[m] = e_ & ~g_; } }
        const unsigned cg = __popc(mg[0]) + __popc(mg[1]), ce = __popc(me[0]) + __popc(me[1]);
        unsigned pg = cg, pe = ce;
#pragma unroll
        for (int o = 1; o < 64; o <<= 1) { const unsigned ug = __shfl_up(pg, o), ue = __shfl_up(pe, o); if (lane >= o) { pg += ug; pe += ue; } }
        const unsigned gt_tot = __shfl(pg, 63), eq_tot = __shfl(pe, 63);
        unsigned pos = pg - cg, tpos = pe - ce;
        LAS unsigned short* lq = LIST + ql * 256;
#pragma unroll
        for (int m = 0; m < 2; ++m) {
            unsigned m_ = mg[m];
            while (__builtin_amdgcn_ballot_w64(m_ != 0u) != 0ull) {
                if (m_ != 0u) { const int bt = 31 - __builtin_clz(m_); const int hf = bt >> 4, i = 16 * m + 15 - (bt & 15);
                    lq[pos] = (unsigned short)(512 * (i >> 2) + 8 * lane + 2 * (i & 3) + hf); ++pos; m_ &= ~(1u << bt); }
            }
            unsigned e_ = me[m];
            while (__builtin_amdgcn_ballot_w64(e_ != 0u) != 0ull) {
                if (e_ != 0u) { const int bt = 31 - __builtin_clz(e_); const int hf = bt >> 4, i = 16 * m + 15 - (bt & 15);
                    if (tpos < (unsigned)TIE_CAP) TLIST[ql * TIE_CAP + tpos] = (unsigned short)(512 * (i >> 2) + 8 * lane + 2 * (i & 3) + hf);
                    ++tpos; e_ &= ~(1u << bt); }
            }
        }
        gtq[qi] = gt_tot; needq[qi] = (unsigned)K - gt_tot; ntieq[qi] = eq_tot < (unsigned)TIE_CAP ? eq_tot : (unsigned)TIE_CAP;
    }
    asm volatile("s_waitcnt lgkmcnt(0)" ::: "memory");
    PROF_E(23); PROF_B(24);
    if (stages < 4) { __syncthreads(); return; }
    {
        LAS unsigned char* tk = lds + DS_TK + w * 4096;
        const unsigned nt0 = ntieq[0], nt1 = ntieq[1];
        const bool fast = (nt0 <= (unsigned)TIE_FAST) && (nt1 <= (unsigned)TIE_FAST);
        __syncthreads();
        if (fast) {
            u32x4 kr[4];
#pragma unroll
            for (int i = 0; i < 4; ++i) { const int qi = i >> 1, ti = 8 * (i & 1) + (lane >> 3); const unsigned nt = qi ? nt1 : nt0; const unsigned key = ((unsigned)ti < nt) ? TLIST[(2 * w + qi) * TIE_CAP + ti] : 0u;
                kr[i] = *(const u32x4*)(KIDX + (size_t)key * 64 + 8 * (lane & 7)); }
#pragma unroll
            for (int i = 0; i < 4; ++i) *(LAS u32x4*)(tk + i * 1024 + lane * 16) = kr[i];
            asm volatile("s_waitcnt lgkmcnt(0)" ::: "memory");
        }
#pragma unroll
        for (int qi = 0; qi < 2; ++qi) {
            const int ql = 2 * w + qi;
            const unsigned ntie = qi ? nt1 : nt0, gtv = gtq[qi], needv = needq[qi];
            const int hh = lane & 15, jj = lane >> 4;
            const LAS unsigned char* qb = lds + DS_QI + hh * 2048 + ql * 128; const unsigned swq = (unsigned)((ql >> 1) & 7);
            const float wh = WQ[ql * 16 + hh];
            for (unsigned g0 = 0; g0 < ntie; g0 += 4) {
                const unsigned ti = g0 + jj; const unsigned key = (ti < ntie) ? TLIST[ql * TIE_CAP + ti] : 0u;
                float dt = 0.f;
#pragma unroll
                for (int c = 0; c < 8; ++c) {
                    h16x8 kv; if (fast) kv = *(const LAS h16x8*)(tk + qi * 2048 + (ti & 15) * 128 + 16 * c); else kv = *(const h16x8*)(KIDX + (size_t)key * 64 + 8 * c);
                    const h16x8 qv = *(const LAS h16x8*)(qb + 16 * ((unsigned)c ^ swq));
#pragma unroll
                    for (int e = 0; e < 8; e += 2) { const h16x2v a = {kv[e], kv[e + 1]}, bq = {qv[e], qv[e + 1]}; dt = __builtin_amdgcn_fdot2(a, bq, dt, false); } }
                float sc = wh * fmaxf(dt, 0.f);
                sc += __shfl_xor(sc, 1); sc += __shfl_xor(sc, 2); sc += __shfl_xor(sc, 4); sc += __shfl_xor(sc, 8);
                if (hh == 0 && ti < ntie) TSC[ql * TIE_CAP + ti] = sc + 0.0f;
            }
            asm volatile("s_waitcnt lgkmcnt(0)" ::: "memory");
            const float mys = (lane < (int)ntie) ? TSC[ql * TIE_CAP + lane] : -INFINITY; const unsigned myk = (lane < (int)ntie) ? TLIST[ql * TIE_CAP + lane] : 0xFFFFu;
            unsigned rank = 0u;
            for (unsigned o = 0; o < ntie; ++o) { const float so = TSC[ql * TIE_CAP + o]; const unsigned ko = TLIST[ql * TIE_CAP + o]; rank += (so > mys || (so == mys && ko < myk)) ? 1u : 0u; }
            if (lane < (int)ntie && rank < needv) LIST[ql * 256 + gtv + rank] = (unsigned short)myk;
            if (lane == 0) ((LAS int*)(lds + LDS_SCR + 256))[ql] = (int)(gtv + (needv < ntie ? needv : ntie));
        }
    }
    __syncthreads();
    PROF_E(24);
}

__device__ __forceinline__ unsigned xb_xcc_id();
__device__ __forceinline__ void phase_dsa(const Params& P, LAS unsigned char* lds, int mode) {
    const int tid = threadIdx.x, lane = tid & 63, w = __builtin_amdgcn_readfirstlane(tid >> 6);
    unsigned* tick = (unsigned*)(P.ws + WS_CTL) + 2048 + (mode >> 8) * 64;
    LAS int* wi = (LAS int*)(lds + LDS_SCR + 512);
    const int pref = (int)(xb_xcc_id() >> 1) & 3;
    for (;;) {
        __syncthreads();
        if (tid == 0) { int got = -1;
            for (int a = 0; a < 4 && got < 0; ++a) { const int bb = (pref + a) & 3; const unsigned t = __hip_atomic_fetch_add(tick + bb * 16, 1u, __ATOMIC_RELAXED, __HIP_MEMORY_SCOPE_AGENT); if (t < 64u) got = bb * 64 + (int)t; }
            wi[0] = got; }
        __syncthreads();
        const int item = wi[0];
        if (item < 0) break;
        const int b = item >> 6, j = item & 63;
        for (int ui = 0; ui < 4; ++ui) {
            const int uq = (ui == 0) ? j : (ui == 1) ? 127 - j : (ui == 2) ? 128 + j : 255 - j;
            if (mode & 1) dsa_select_unit(P, lds, b, uq, (mode >> 4) & 15);
            if (mode & 2) for (int qi = 0; qi < 2; ++qi) { const int ql = 2 * w + qi, t = 16 * uq + ql;
                sparse_attn_query(P, lds, w, lane, b, b * SEQ + t, ((const LAS int*)(lds + LDS_SCR + 256))[ql], (const LAS unsigned short*)(lds + DS_LIST) + ql * 256); }
            __syncthreads();
        }
    }
}

#define XB_TMO      128
#define XB_XCNT(j)  (256  + 64 * (j))
#define XB_XSUB(j)  (1280 + 64 * (j))
#define XB_XGEN(j)  (2304 + 64 * (j))
#define XB_TOP      3328
#define XB_TOPGEN   3392
#define XCD_BAR_WORDS 3456
#define XB_SPIN_CAP (1u << 22)
__device__ __forceinline__ unsigned xb_ld(unsigned* p)              { return __hip_atomic_load(p, __ATOMIC_RELAXED, __HIP_MEMORY_SCOPE_AGENT); }
__device__ __forceinline__ unsigned xb_add(unsigned* p, unsigned v) { return __hip_atomic_fetch_add(p, v, __ATOMIC_RELAXED, __HIP_MEMORY_SCOPE_AGENT); }
__device__ __forceinline__ unsigned xb_xcc_id() { return (unsigned)__builtin_amdgcn_s_getreg((3 << 11) | 20) & 0xFu; }
#define XB_SPIN(cond, bar) do { unsigned _sp = 0; while (cond) { __builtin_amdgcn_s_sleep(1); \
    if ((++_sp & 255u) == 0u) { if (xb_ld(&(bar)[XB_TMO])) break; if (_sp > XB_SPIN_CAP) { atomicAdd(&(bar)[XB_TMO], 1u); break; } } } } while (0)
struct XcdBarrier { unsigned* bar; unsigned x; volatile LAS unsigned* st; };
__device__ __forceinline__ XcdBarrier xcd_barrier_post(unsigned* bar, volatile LAS unsigned* st) {
    XcdBarrier b; b.bar = bar; b.x = xb_xcc_id(); b.st = st;
    if (threadIdx.x == 0) (void)xb_add(&bar[XB_XCNT(b.x)], 1u);
    return b;
}
__device__ __forceinline__ void xcd_barrier_complete(unsigned* bar, unsigned x, unsigned& nloc, unsigned& nx) {
    const unsigned G = gridDim.x * gridDim.y * gridDim.z;
    unsigned sum, cnt, mine, sp = 0u;
    for (;;) {
        sum = 0u; cnt = 0u; mine = 0u;
#pragma unroll
        for (unsigned j = 0; j < 16; ++j) { const unsigned c = xb_ld(&bar[XB_XCNT(j)]); sum += c; cnt += (c > 0u) ? 1u : 0u; mine = (j == x) ? c : mine; }
        if (sum == G) break;
        __builtin_amdgcn_s_sleep(1);
        if ((++sp & 255u) == 0u) { if (xb_ld(&bar[XB_TMO])) break; if (sp > XB_SPIN_CAP) { atomicAdd(&bar[XB_TMO], 1u); break; } }
    }
    nloc = mine > 0u ? mine : 1u; nx = cnt > 0u ? cnt : 1u;
}
__device__ __forceinline__ void xcd_barrier(const XcdBarrier& b) {
    asm volatile("s_waitcnt vmcnt(0)" ::: "memory");
    __syncthreads();
    if (threadIdx.x == 0) {
        unsigned* bar = b.bar;
        __builtin_amdgcn_s_waitcnt(0);
        unsigned nloc = b.st[0], nx = b.st[1];
        if (nloc == 0u) { xcd_barrier_complete(bar, b.x, nloc, nx); b.st[0] = nloc; b.st[1] = nx; }
        const unsigned old = xb_add(&bar[XB_XSUB(b.x)], 1u);
        const unsigned gen = old / nloc;
        if (old + 1u == (gen + 1u) * nloc) {
            __builtin_amdgcn_fence(__ATOMIC_RELEASE, "agent");
            asm volatile("s_waitcnt vmcnt(0)" ::: "memory");
            const unsigned og = xb_add(&bar[XB_TOP], 1u);
            const unsigned tg = og / nx;
            if (og + 1u == (tg + 1u) * nx) xb_add(&bar[XB_TOPGEN], 1u);
            else XB_SPIN(xb_ld(&bar[XB_TOPGEN]) == tg, bar);
            __builtin_amdgcn_fence(__ATOMIC_ACQUIRE, "agent");
            xb_add(&bar[XB_XGEN(b.x)], 1u);
            asm volatile("s_waitcnt vmcnt(0)" ::: "memory");
        } else {
            XB_SPIN(xb_ld(&bar[XB_XGEN(b.x)]) == gen, bar);
            __builtin_amdgcn_fence(__ATOMIC_ACQUIRE, "agent");
            asm volatile("s_waitcnt vmcnt(0)" ::: "memory");
        }
    }
    __syncthreads();
}

#ifndef MK_N_LAUNCHES
#define MK_N_LAUNCHES 1
#endif
constexpr int N_PHASES = 8;
extern __shared__ __attribute__((aligned(16))) unsigned char dyn_lds[];
__global__ void __launch_bounds__(NTHR, 2) hybrid_fwd(Params P) {
    LAS unsigned char* lds = (LAS unsigned char*)dyn_lds;
    volatile LAS unsigned* MISC = (volatile LAS unsigned*)(lds + LDS_SCR);
    for (int u = threadIdx.x; u < (LDS_BYTES - LDS_SCR) / 4; u += NTHR) MISC[u] = 0u;
    __syncthreads();
    XcdBarrier bar = xcd_barrier_post((unsigned*)(P.ws + WS_CTL) + 4096 + P.ph_lo * XCD_BAR_WORDS, MISC + 8);
    const int lo = P.ph_lo, hi = P.ph_hi;
#ifndef PHASE_MASK
#define PHASE_MASK 0xFF
#endif
#define IN(k) (((PHASE_MASK >> (k)) & 1) && lo <= (k) && (k) < hi)
#define SEAM(k) do { if (IN(k) && IN((k) + 1)) xcd_barrier(bar); } while (0)
#ifndef REPEAT_MASK
#define REPEAT_MASK 0
#endif
#define REP(k) for (int rep_ = 0; rep_ < 1 + ((REPEAT_MASK >> (k)) & 1); ++rep_, (rep_ < 1 + ((REPEAT_MASK >> (k)) & 1) ? xcd_barrier(bar) : (void)0))
    if (IN(0)) REP(0) phase_prologue(P, lds);
    SEAM(0);
    if (IN(1)) REP(1) phase_h(P, lds);
    SEAM(1);
    if (IN(2)) REP(2) {
        pg8::Gemm g{(const h16*)(P.ws + WS_H), (const h16*)(P.ws + WS_W1T), T, NW1, DM, DM, DM, 0}; pg8::StaticOrder S; S.init(T, NW1, gridDim.x, blockIdx.x);
        EpiProj E{(h16*)(P.ws + WS_CQ), (h16*)(P.ws + WS_KVC), (h16*)(P.ws + WS_SGA), (h16*)(P.ws + WS_QB), (h16*)(P.ws + WS_KB), (h16*)(P.ws + WS_VB), (h16*)(P.ws + WS_SGB),
                  (float*)(P.ws + WS_SMALL), (float*)(P.ws + WS_SSQ), (const float*)(P.ws + WS_ROPE32)};
        pg8::gemm_phase(lds, g, S, E);
    }
    SEAM(2);
    if (IN(3)) {
        phase_rowops(P);
        REP(3) {
        { pg8::Gemm g{(const h16*)(P.ws + WS_CQ), (const h16*)(P.ws + WS_WQT), T, NQ, 512, 512, 512, 0}; pg8::StaticOrder S; S.init(T, NQ, gridDim.x, blockIdx.x);
          EpiQ E{(h16*)(P.ws + WS_QLAT), (h16*)(P.ws + WS_QROPE), (h16*)(P.ws + WS_QIDX), (const float*)(P.ws + WS_SSQ), (const float*)(P.ws + WS_ROPE32), (const float*)(P.ws + WS_ROPE16)};
          pg8::gemm_phase(lds, g, S, E); }
        __syncthreads();
        REP(8) phase_dilated_part(P, lds);
        }
    }
    SEAM(3);
#if DSA_PROBE == 0
    if (IN(4)) { phase_dsa(P, lds, 3 | 0x90); __syncthreads(); REP(4) phase_dilated_last(P, lds); }
#else
    if (IN(4)) { phase_dilated_last(P, lds); xcd_barrier(bar); phase_dsa(P, lds, 3 | 0x90); xcd_barrier(bar); phase_dsa(P, lds, 0x100 | (DSA_PROBE == 1 ? (3 | 0x90) : (1 | ((DSA_PROBE == 6 ? 1 : DSA_PROBE) << 4)))); }
#endif
    SEAM(4);
    if (IN(5)) REP(5) {
        pg8::Gemm g{(const h16*)(P.ws + WS_OLAT), (const h16*)(P.ws + WS_WUVT), T, 1024, 512, 2048, 512, 512}; pg8::StaticOrder S; S.init(T, 1024, gridDim.x, blockIdx.x);
        EpiOA E{(h16*)(P.ws + WS_OAB), (const h16*)(P.ws + WS_SGA)};
        pg8::gemm_phase(lds, g, S, E);
    }
    SEAM(5);
    if (IN(6)) REP(6) {
        pg8::Gemm g{(const h16*)(P.ws + WS_OAB), (const h16*)(P.ws + WS_WOT), T, DM, DM, DM, DM, 0}; pg8::StaticOrder S; S.init(T, DM, gridDim.x, blockIdx.x);
        EpiY E{(h16*)(P.ws + WS_Y), (float*)(P.ws + WS_SSY)};
        pg8::gemm_phase(lds, g, S, E);
    }
    SEAM(6);
    if (IN(7)) REP(7) phase_final(P, lds);
    if (PROF_SEL >= 0 && threadIdx.x == 0) { const unsigned long long t0 = __builtin_amdgcn_s_memrealtime(), d = *(LAS unsigned long long*)(lds + LDS_SCR + 136);
        while (__builtin_amdgcn_s_memrealtime() - t0 < d) __builtin_amdgcn_s_sleep(8); }
#undef IN
#undef SEAM
}

extern "C" void kernel_launch(void* const* d_in, const int* in_sizes, int n_in, void* d_out, int out_size, void* d_ws, size_t ws_size, hipStream_t stream) {
    static int grid = 0;
    if (grid == 0) {
        if (n_in != 14 || in_sizes[0] != T * DM || out_size != T * DM || ws_size < WS_END) { fprintf(stderr, "kernel_launch: unexpected shapes (n_in %d, in0 %d, out %d, ws %zu)\n", n_in, n_in > 0 ? in_sizes[0] : -1, out_size, ws_size); grid = -1; return; }
        int dev = 0, cus = 0, per_cu = 0;
        if (hipGetDevice(&dev) != hipSuccess || hipDeviceGetAttribute(&cus, hipDeviceAttributeMultiprocessorCount, dev) != hipSuccess) { grid = -1; return; }
        if (hipFuncSetAttribute((const void*)hybrid_fwd, hipFuncAttributeMaxDynamicSharedMemorySize, LDS_BYTES) != hipSuccess) { fprintf(stderr, "kernel_launch: hipFuncSetAttribute failed\n"); grid = -1; return; }
        if (hipOccupancyMaxActiveBlocksPerMultiprocessor(&per_cu, (const void*)hybrid_fwd, NTHR, LDS_BYTES) != hipSuccess || per_cu < 1) { fprintf(stderr, "kernel_launch: occupancy query says %d blocks per CU\n", per_cu); }
        (void)hipGetLastError();
        grid = cus;
    }
    if (grid < 0) return;
    (void)hipMemsetAsync((char*)d_ws + WS_CTL, 0, 1 * MiB, stream);
    Params P{};
    P.x = (const float*)d_in[0]; P.c = (const float*)d_in[1]; P.w_ada = (const float*)d_in[2]; P.b_ada = (const float*)d_in[3]; P.g_pre = (const float*)d_in[4]; P.g_post = (const float*)d_in[5];
    P.w_in = (const float*)d_in[6]; P.g_q = (const float*)d_in[7]; P.g_kv = (const float*)d_in[8]; P.w_uq = (const float*)d_in[9]; P.w_uq_idx = (const float*)d_in[10]; P.w_uk = (const float*)d_in[11];
    P.w_uv = (const float*)d_in[12]; P.w_out = (const float*)d_in[13]; P.out = (float*)d_out; P.ws = (unsigned char*)d_ws;
#if MK_N_LAUNCHES == 1
    P.ph_lo = 0; P.ph_hi = N_PHASES;
    hipLaunchKernelGGL(hybrid_fwd, dim3(grid), dim3(NTHR), LDS_BYTES, stream, P);
#else
    for (int k = 0; k < N_PHASES; ++k) { P.ph_lo = k; P.ph_hi = k + 1; hipLaunchKernelGGL(hybrid_fwd, dim3(grid), dim3(NTHR), LDS_BYTES, stream, P); }
#endif
}
```

```cpp
#include <hip/hip_runtime.h>
#include <cstdint>
#include <cstdio>
#include <cmath>

#define LAS __attribute__((address_space(3)))
typedef _Float16 h16;
typedef _Float16 h16x2 __attribute__((ext_vector_type(2)));
typedef _Float16 h16x4 __attribute__((ext_vector_type(4)));
typedef _Float16 h16x8 __attribute__((ext_vector_type(8)));
typedef float f32x2 __attribute__((ext_vector_type(2)));
typedef float f32x4 __attribute__((ext_vector_type(4)));
typedef unsigned u32x2 __attribute__((ext_vector_type(2)));
typedef unsigned u32x4 __attribute__((ext_vector_type(4)));

constexpr int NB = 4, SEQ = 4096, T = NB * SEQ, DM = 2048;
constexpr int NW1 = 6144;
constexpr int NQ = 3328;
constexpr int KVW = 288;
constexpr float EPS = 1e-6f;
constexpr float SCQ = 0.08838834764831845f * 1.4426950408889634f;

constexpr size_t MiB = 1u << 20;
constexpr size_t WS_CTL = 0;
constexpr size_t WS_MODP = 1 * MiB;
constexpr size_t WS_ROPE32 = 2 * MiB;
constexpr size_t WS_ROPE16 = 2 * MiB + 512 * 1024;
constexpr size_t WS_SSQ = 3 * MiB;
constexpr size_t WS_SSY = 4 * MiB;
constexpr size_t WS_W1T = 8 * MiB;
constexpr size_t WS_WQT = 32 * MiB;
constexpr size_t WS_WUVT = 36 * MiB;
constexpr size_t WS_WOT = 38 * MiB;
constexpr size_t WS_KVC = 46 * MiB;
constexpr size_t WS_KIDX = 55 * MiB;
constexpr size_t WS_WIDX = 57 * MiB;
constexpr size_t WS_SMALL = 58 * MiB;
constexpr size_t WS_CQ = 66 * MiB;
constexpr size_t WS_SGA = 82 * MiB;
constexpr size_t WS_OAB = 114 * MiB;
constexpr size_t WS_QLAT = 178 * MiB;
constexpr size_t WS_QROPE = 242 * MiB;
constexpr size_t WS_QIDX = 250 * MiB;
constexpr size_t WS_H = 282 * MiB;
constexpr size_t WS_OP4 = 282 * MiB;
constexpr size_t WS_OP16 = 314 * MiB;
constexpr size_t WS_QB = 346 * MiB;
constexpr size_t WS_KB = 378 * MiB;
constexpr size_t WS_VB = 410 * MiB;
constexpr size_t WS_SGB = 442 * MiB;
constexpr size_t WS_END = 474 * MiB;
constexpr size_t WS_LSEP = 6 * MiB;
#ifndef DSA_PROBE
#define DSA_PROBE 0
#endif
constexpr size_t WS_OLAT = DSA_PROBE ? 346 * MiB : 178 * MiB;
constexpr size_t WS_Y = 178 * MiB;

struct Params {
    const float *x, *c, *w_ada, *b_ada, *g_pre, *g_post, *w_in, *g_q, *g_kv, *w_uq, *w_uq_idx, *w_uk, *w_uv, *w_out;
    float* out; unsigned char* ws;
    int ph_lo, ph_hi;
};

__device__ __forceinline__ unsigned pk2h(float a, float b) { h16x2 t = {(h16)a, (h16)b}; return __builtin_bit_cast(unsigned, t); }
__device__ __forceinline__ float siluf(float v) { return v * __builtin_amdgcn_rcpf(1.0f + __builtin_amdgcn_exp2f(-1.4426950408889634f * v)); }
__device__ __forceinline__ float wave_sum(float v) {
#pragma unroll
    for (int o = 1; o < 64; o <<= 1) v += __shfl_xor(v, o);
    return v;
}
__device__ __forceinline__ float wave_max(float v) {
#pragma unroll
    for (int o = 1; o < 64; o <<= 1) v = fmaxf(v, __shfl_xor(v, o));
    return v;
}

constexpr int NTHR = 512, NWAVE = 8;
constexpr int LDS_SCR = 159744;
constexpr int LDS_BYTES = LDS_SCR + 4096;
#ifndef PROF_SEL
#define PROF_SEL -1
#endif
#ifndef PROF_BLK
#define PROF_BLK 37
#endif
#define PROF_B(k) do { if ((k) == PROF_SEL && threadIdx.x == 0) { *(LAS unsigned long long*)(lds + LDS_SCR + 128) = __builtin_amdgcn_s_memrealtime(); } } while (0)
#define PROF_E(k) do { if ((k) == PROF_SEL && threadIdx.x == 0) { *(LAS unsigned long long*)(lds + LDS_SCR + 136) += __builtin_amdgcn_s_memrealtime() - *(LAS unsigned long long*)(lds + LDS_SCR + 128); } } while (0)

namespace pg8 {
constexpr int BM = 256, BK = 64, HALF = 128, HTB = HALF * BK * 2, STAGE_BYTES = 8 * HTB, NXCD = 8, WGM = 8;
__host__ __device__ __forceinline__ int lds_byte(int r, int c) { const int st = (r >> 4) * 2 + (c >> 5), rr = r & 15, cc = c & 31, ob = rr * 64 + cc * 2; return st * 1024 + (ob ^ (((ob >> 9) & 1) << 5)); }
__host__ __device__ __forceinline__ void stage_rc(int b, int& R, int& C) { const int st = b / 1024, sb = b % 1024, swz = sb ^ (((sb >> 9) & 1) << 5); R = (st >> 1) * 16 + swz / 64; C = (st & 1) * 32 + (swz % 64) / 2; }
__host__ __device__ __forceinline__ int perm32(int rho) { const int n = rho >> 4, i = rho & 15; return 8 * (i >> 2) + 4 * n + (i & 3); }

struct Unit { int pm, pn; };
struct Gemm { const h16* A; const h16* Bt; int M, N, K, lda, ldb, a_pn_off; };

struct StaticOrder {
    int nM, nN, nwg, G, c;
    __device__ void init(int M, int N, int G_, int c_) { nM = M / BM; nN = N / BM; nwg = nM * nN; G = __builtin_amdgcn_readfirstlane(G_); c = __builtin_amdgcn_readfirstlane(c_); }
    __device__ bool next(int i, Unit& u) const {
        const int L = __builtin_amdgcn_readfirstlane(i * G + c); if (L >= nwg) return false;
        int wgid = L; { const int q = nwg / NXCD, r = nwg % NXCD, xcd = wgid % NXCD, off = wgid / NXCD; wgid = (xcd < r ? xcd * (q + 1) : r * (q + 1) + (xcd - r) * q) + off; }
        const int nig = WGM * nN, gid = wgid / nig, fm = gid * WGM, gsz = (nM - fm) < WGM ? (nM - fm) : WGM;
        u.pm = __builtin_amdgcn_readfirstlane(fm + ((wgid % nig) % gsz)); u.pn = __builtin_amdgcn_readfirstlane((wgid % nig) / gsz); return true;
    }
};

template <class Epi>
__device__ __forceinline__ void gemm_phase(LAS unsigned char* lds, const Gemm g, const StaticOrder& S, const Epi& E) {
    const int tid = threadIdx.x, wid = __builtin_amdgcn_readfirstlane(tid >> 6), lane = tid & 63, wr = wid >> 2, wc = wid & 3, fr = lane & 15, fq = lane >> 4;
    const int K = g.K, nt = K / BK;
    unsigned voffA[2], voffB[2];
#pragma unroll
    for (int i = 0; i < 2; ++i) { int R, C; stage_rc(tid * 16 + i * 8192, R, C); const int Rb = (R & ~31) + perm32(R & 31);
        voffA[i] = (unsigned)(R * g.lda + C) * 2u; voffB[i] = (unsigned)(Rb * g.ldb + C) * 2u; }
    const size_t kstep = (size_t)(BK * 2);
    const size_t hstepA = (size_t)HALF * g.lda * 2, hstepB = (size_t)HALF * g.ldb * 2;
    const size_t tstepA = 2 * hstepA, tstepB = 2 * hstepB;
    const unsigned ldsw = (unsigned)wid * 1024u;
    const int aoff = lds_byte(wr * 64 + fr, fq * 8), boff = lds_byte(wc * 32 + fr, fq * 8);
#define PG8_SA(b, h) (((b) * 2 + (h)) * HTB)
#define PG8_SB(b, h) ((4 + (b) * 2 + (h)) * HTB)
#define PG8_STAGE(bufoff, gbase, voff) do { _Pragma("unroll") for (int _i = 0; _i < 2; ++_i) \
        __builtin_amdgcn_global_load_lds((const unsigned*)((const char*)(gbase) + (voff)[_i]), (LAS unsigned*)(lds + (bufoff) + ldsw + _i * 8192), 16, 0, 0); } while (0)
#define PG8_LDA(dst, b, h) do { _Pragma("unroll") for (int m = 0; m < 4; ++m) _Pragma("unroll") for (int k = 0; k < 2; ++k) dst[m][k] = *(const LAS h16x8*)(lds + PG8_SA(b, h) + aoff + m * 2048 + k * 1024); } while (0)
#define PG8_LDB(dst, b, h) do { _Pragma("unroll") for (int n = 0; n < 2; ++n) _Pragma("unroll") for (int k = 0; k < 2; ++k) dst[n][k] = *(const LAS h16x8*)(lds + PG8_SB(b, h) + boff + n * 2048 + k * 1024); } while (0)
#define PG8_MMA(ai, bj, At, Bt) do { __builtin_amdgcn_s_setprio(1); _Pragma("unroll") for (int m = 0; m < 4; ++m) _Pragma("unroll") for (int n = 0; n < 2; ++n) _Pragma("unroll") for (int k = 0; k < 2; ++k) \
        acc[ai][bj][m][n] = __builtin_amdgcn_mfma_f32_16x16x32_f16(Bt[n][k], At[m][k], acc[ai][bj][m][n], 0, 0, 0); __builtin_amdgcn_s_setprio(0); } while (0)
#define PG8_WAIT_V(n) asm volatile("s_waitcnt vmcnt(" #n ")" ::: "memory")
#define PG8_WAIT_L(n) asm volatile("s_waitcnt lgkmcnt(" #n ")" ::: "memory")
#define PG8_BAR __builtin_amdgcn_s_barrier()
#define PG8_SCHED __builtin_amdgcn_sched_barrier(0)
    Unit cur, nxt; int ui = 0;
    if (!S.next(0, cur)) return;
    PROF_B(Epi::PROF_ID);
    f32x4 acc[2][2][4][2];
#pragma unroll
    for (int a = 0; a < 2; ++a)
#pragma unroll
        for (int b = 0; b < 2; ++b)
#pragma unroll
            for (int m = 0; m < 4; ++m)
#pragma unroll
                for (int n = 0; n < 2; ++n) acc[a][b][m][n] = (f32x4){0.f, 0.f, 0.f, 0.f};
    h16x8 At[4][2], B0[2][2], B1[2][2];
    const char* cA = (const char*)g.A + (size_t)cur.pm * tstepA + (size_t)cur.pn * g.a_pn_off * 2; const char* cB = (const char*)g.Bt + (size_t)cur.pn * tstepB;
    PG8_STAGE(PG8_SB(0, 0), cB, voffB); PG8_STAGE(PG8_SB(0, 1), cB + hstepB, voffB); PG8_STAGE(PG8_SA(0, 0), cA, voffA); PG8_STAGE(PG8_SA(0, 1), cA + hstepA, voffA);
    if (wr == 1) PG8_BAR;
    PG8_WAIT_V(2); PG8_BAR;
    PG8_STAGE(PG8_SB(1, 0), cB + kstep, voffB); PG8_STAGE(PG8_SA(1, 0), cA + kstep, voffA); PG8_STAGE(PG8_SB(1, 1), cB + hstepB + kstep, voffB);
    PG8_WAIT_V(6); PG8_BAR;
    for (;;) {
        const bool has_next = S.next(ui + 1, nxt);
        const char* nA = has_next ? (const char*)g.A + (size_t)nxt.pm * tstepA + (size_t)nxt.pn * g.a_pn_off * 2 : cA; const char* nB = has_next ? (const char*)g.Bt + (size_t)nxt.pn * tstepB : cB;
        for (int t = 0; t < nt; t += 2) {
            const bool last = (t == nt - 2);
            const char* a1 = cA + (size_t)(t + 1) * kstep;
            const char* a2 = last ? nA : cA + (size_t)(t + 2) * kstep; const char* b2 = last ? nB : cB + (size_t)(t + 2) * kstep;
            const char* a3 = a2 + kstep; const char* b3 = b2 + kstep;
            PG8_LDB(B0, 0, 0); PG8_LDB(B1, 0, 1); PG8_SCHED; PG8_LDA(At, 0, 0); PG8_STAGE(PG8_SA(1, 1), a1 + hstepA, voffA);
            PG8_WAIT_V(8); PG8_WAIT_L(0); PG8_BAR; PG8_MMA(0, 0, At, B0); PG8_MMA(0, 1, At, B1); PG8_BAR; PG8_SCHED;
            PG8_LDA(At, 0, 1); PG8_STAGE(PG8_SB(0, 0), b2, voffB); PG8_STAGE(PG8_SB(0, 1), b2 + hstepB, voffB); PG8_STAGE(PG8_SA(0, 0), a2, voffA);
            PG8_WAIT_V(8); PG8_WAIT_L(0); PG8_BAR; PG8_MMA(1, 0, At, B0); PG8_MMA(1, 1, At, B1); PG8_BAR; PG8_SCHED;
            PG8_LDB(B0, 1, 0); PG8_LDB(B1, 1, 1); PG8_SCHED; PG8_LDA(At, 1, 0); PG8_STAGE(PG8_SA(0, 1), a2 + hstepA, voffA);
            PG8_WAIT_V(8); PG8_WAIT_L(0); PG8_BAR; PG8_MMA(0, 0, At, B0); PG8_MMA(0, 1, At, B1); PG8_BAR; PG8_SCHED;
            PG8_LDA(At, 1, 1); PG8_STAGE(PG8_SB(1, 0), b3, voffB); PG8_STAGE(PG8_SB(1, 1), b3 + hstepB, voffB); PG8_STAGE(PG8_SA(1, 0), a3, voffA);
            PG8_WAIT_V(8); PG8_WAIT_L(0); PG8_BAR; PG8_MMA(1, 0, At, B0); PG8_MMA(1, 1, At, B1); PG8_BAR; PG8_SCHED;
        }
        if (wr == 0) PG8_BAR;
        PROF_E(Epi::PROF_ID); PROF_B(Epi::PROF_ID + 1);
        { const int cls_ = (Epi::PROF_ID == 40) ? (cur.pn < 2 ? 60 : cur.pn < 4 ? 61 : (cur.pn < 8 || cur.pn >= 20) ? 62 : cur.pn < 16 ? 63 : 64) : (Epi::PROF_ID == 42 ? (cur.pn == 0 ? 65 : cur.pn < 9 ? 66 : 67) : 0);
          if (cls_ == PROF_SEL) PROF_B(PROF_SEL);
          E(acc, cur, wr, wc, fr, fq);
          if (cls_ == PROF_SEL) PROF_E(PROF_SEL); }
        PROF_E(Epi::PROF_ID + 1); PROF_B(Epi::PROF_ID);
        if (!has_next) break;
#pragma unroll
        for (int a = 0; a < 2; ++a)
#pragma unroll
            for (int b = 0; b < 2; ++b)
#pragma unroll
                for (int m = 0; m < 4; ++m)
#pragma unroll
                    for (int n = 0; n < 2; ++n) acc[a][b][m][n] = (f32x4){0.f, 0.f, 0.f, 0.f};
        cur = nxt; cA = nA; cB = nB; ++ui;
        if (wr == 1) PG8_BAR;
    }
    PG8_WAIT_V(0);
    PG8_BAR;
#undef PG8_SA
#undef PG8_SB
#undef PG8_STAGE
#undef PG8_LDA
#undef PG8_LDB
#undef PG8_MMA
#undef PG8_WAIT_V
#undef PG8_WAIT_L
#undef PG8_BAR
#undef PG8_SCHED
}
}

using pg8::Unit;
__device__ __forceinline__ u32x4 pack8(const f32x4 a, const f32x4 b) { u32x4 w; w.x = pk2h(a[0], a[1]); w.y = pk2h(a[2], a[3]); w.z = pk2h(b[0], b[1]); w.w = pk2h(b[2], b[3]); return w; }

__device__ __forceinline__ float xlane32(float v, bool upper) { const auto r = __builtin_amdgcn_permlane32_swap(__float_as_uint(v), __float_as_uint(v), false, false); return __uint_as_float(upper ? r[0] : r[1]); }
__device__ __forceinline__ float xlane16(float v, bool oddrow) { const auto r = __builtin_amdgcn_permlane16_swap(__float_as_uint(v), __float_as_uint(v), false, false); return __uint_as_float(oddrow ? r[0] : r[1]); }
__device__ __forceinline__ void rope8(f32x4& v0, f32x4& v1, const f32x4 (&t)[4], const f32x4 p0, const f32x4 p1, float sg) {
#pragma unroll
    for (int e = 0; e < 4; ++e) { const float c0 = t[e >> 1][2 * (e & 1)], s0 = t[e >> 1][2 * (e & 1) + 1], c1 = t[2 + (e >> 1)][2 * (e & 1)], s1 = t[2 + (e >> 1)][2 * (e & 1) + 1];
        v0[e] = v0[e] * c0 + sg * p0[e] * s0; v1[e] = v1[e] * c1 + sg * p1[e] * s1; }
}
struct EpiProj {
    static constexpr int PROF_ID = 40;
    h16 *CQ, *KVC, *SGA, *QB, *KB, *VB, *SGB; float *SMALL, *SSQ; const float* rope32;
    __device__ __forceinline__ void operator()(const f32x4 (&acc)[2][2][4][2], const Unit& u, int wr, int wc, int fr_in, int fq_in) const {
        int fr = fr_in, fq = fq_in; asm volatile("" : "+v"(fr), "+v"(fq));
        const int pn = u.pn;
        const int rowb = u.pm * 256 + wr * 64 + fr;
        if (pn >= 8 && pn < 16 && wc == 0) {
            const bool isq = pn < 12; const float sc = isq ? SCQ : 1.0f, sg = (fq < 2) ? -1.f : 1.f; const bool upper = fq >= 2;
            h16* dst = (isq ? QB + (pn - 8) * 256 : KB + (pn - 12) * 256) + fq * 8;
            const float* tb = rope32 + 16 * (fq & 1);
            f32x4 ta[4], tn[4];
#define EP_LDT(t, g) do { const int pos_ = (rowb + 128 * ((g) >> 2) + 16 * ((g) & 3)) & (SEQ - 1); _Pragma("unroll") for (int k_ = 0; k_ < 4; ++k_) t[k_] = *(const f32x4*)(tb + (size_t)pos_ * 32 + 4 * k_); } while (0)
            EP_LDT(ta, 0);
#pragma unroll
            for (int g = 0; g < 8; ++g) {
                if (g < 7) { if (g & 1) EP_LDT(ta, g + 1); else EP_LDT(tn, g + 1); }
                const int ai = g >> 2, m = g & 3; const int row = rowb + 128 * ai + 16 * m;
#pragma unroll
                for (int bj = 0; bj < 2; ++bj) { f32x4 v0 = acc[ai][bj][m][0], v1 = acc[ai][bj][m][1], p0, p1;
#pragma unroll
                    for (int e = 0; e < 4; ++e) { p0[e] = xlane32(v0[e], upper); p1[e] = xlane32(v1[e], upper); }
                    if (g & 1) rope8(v0, v1, tn, p0, p1, sg); else rope8(v0, v1, ta, p0, p1, sg);
                    v0 = v0 * sc; v1 = v1 * sc;
                    *(u32x4*)(dst + (size_t)row * 1024 + bj * 128) = pack8(v0, v1); }
            }
#undef EP_LDT
            return;
        }
#pragma unroll
        for (int ai = 0; ai < 2; ++ai)
#pragma unroll
            for (int m = 0; m < 4; ++m) {
                const int row = rowb + ai * 128 + m * 16;
                if (pn < 2) {
                    float s = 0.f;
#pragma unroll
                    for (int bj = 0; bj < 2; ++bj) { const f32x4 v0 = acc[ai][bj][m][0], v1 = acc[ai][bj][m][1];
                        s += (v0[0] * v0[0] + v0[1] * v0[1]) + (v0[2] * v0[2] + v0[3] * v0[3]) + (v1[0] * v1[0] + v1[1] * v1[1]) + (v1[2] * v1[2] + v1[3] * v1[3]);
                        *(u32x4*)(CQ + (size_t)row * 512 + pn * 256 + bj * 128 + wc * 32 + fq * 8) = pack8(v0, v1); }
                    s += __shfl_xor(s, 16); s += __shfl_xor(s, 32);
                    if (fq == 0) SSQ[(size_t)row * 8 + pn * 4 + wc] = s;
                } else if (pn == 2) {
#pragma unroll
                    for (int bj = 0; bj < 2; ++bj) *(u32x4*)(KVC + (size_t)row * KVW + bj * 128 + wc * 32 + fq * 8) = pack8(acc[ai][bj][m][0], acc[ai][bj][m][1]);
                } else if (pn == 3) {
                    float* p = SMALL + (size_t)row * 128 + wc * 32 + fq * 8;
                    *(f32x4*)p = acc[ai][0][m][0]; *(f32x4*)(p + 4) = acc[ai][0][m][1];
                } else if (pn < 8 || pn >= 20) {
                    h16* dst = (pn < 8 ? SGA + (pn - 4) * 256 : SGB + (pn - 20) * 256) + (size_t)row * 1024 + wc * 32 + fq * 8;
#pragma unroll
                    for (int bj = 0; bj < 2; ++bj) { f32x4 v0 = acc[ai][bj][m][0], v1 = acc[ai][bj][m][1];
#pragma unroll
                        for (int e = 0; e < 4; ++e) { v0[e] = siluf(v0[e]); v1[e] = siluf(v1[e]); }
                        *(u32x4*)(dst + bj * 128) = pack8(v0, v1); }
                } else if (pn >= 16) {
                    h16* dst = VB + (size_t)row * 1024 + (pn - 16) * 256 + wc * 32 + fq * 8;
#pragma unroll
                    for (int bj = 0; bj < 2; ++bj) *(u32x4*)(dst + bj * 128) = pack8(acc[ai][bj][m][0], acc[ai][bj][m][1]);
                } else {
                    const bool isq = pn < 12; const float sc = isq ? SCQ : 1.0f;
                    h16* dst = (isq ? QB + (pn - 8) * 256 : KB + (pn - 12) * 256) + (size_t)row * 1024 + wc * 32 + fq * 8;
#pragma unroll
                    for (int bj = 0; bj < 2; ++bj) *(u32x4*)(dst + bj * 128) = pack8(acc[ai][bj][m][0] * sc, acc[ai][bj][m][1] * sc);
                }
            }
    }
};

struct EpiQ {
    static constexpr int PROF_ID = 42;
    h16 *QLAT, *QROPE, *QIDX; const float *SSQ, *rope32, *rope16;
    __device__ __forceinline__ void operator()(const f32x4 (&acc)[2][2][4][2], const Unit& u, int wr, int wc, int fr_in, int fq_in) const {
        int fr = fr_in, fq = fq_in; asm volatile("" : "+v"(fr), "+v"(fq));
        const int pn = u.pn;
        const int rowb = u.pm * 256 + wr * 64 + fr;
        if (pn >= 1 && pn < 9) {
            float rs[8];
#pragma unroll
            for (int gb = 0; gb < 8; gb += 4) {
                f32x4 sa_[4], sb_[4];
#pragma unroll
                for (int g = 0; g < 4; ++g) { const int row = rowb + 128 * ((gb + g) >> 2) + 16 * (g & 3); sa_[g] = *(const f32x4*)(SSQ + (size_t)row * 8); sb_[g] = *(const f32x4*)(SSQ + (size_t)row * 8 + 4); }
#pragma unroll
                for (int g = 0; g < 4; ++g) rs[gb + g] = __builtin_amdgcn_rsqf((((sa_[g][0] + sa_[g][1]) + (sa_[g][2] + sa_[g][3])) + ((sb_[g][0] + sb_[g][1]) + (sb_[g][2] + sb_[g][3]))) * (1.0f / 512.0f) + EPS);
            }
#pragma unroll
            for (int g = 0; g < 8; ++g) { const int ai = g >> 2, m = g & 3; const int row = rowb + 128 * ai + 16 * m; const float sc = rs[g] * SCQ;
#pragma unroll
                for (int bj = 0; bj < 2; ++bj)
                    *(u32x4*)(QLAT + ((size_t)row * 8 + (pn - 1)) * 256 + bj * 128 + wc * 32 + fq * 8) = pack8(acc[ai][bj][m][0] * sc, acc[ai][bj][m][1] * sc); }
            return;
        }
        const bool rope_q = (pn == 0), rope_i = (pn >= 9) && ((wc & 1) == 0);
        const float* tb = rope_q ? rope32 + 16 * (fq & 1) : rope16;
        const int tstride = rope_q ? 32 : 16;
#pragma unroll
        for (int am = 0; am < 4; ++am) { const int ai = am >> 1, mb = 2 * (am & 1);
            f32x4 tt[2][4];
            float rs2[2];
#pragma unroll
            for (int mm = 0; mm < 2; ++mm) { const int row = rowb + ai * 128 + (mb + mm) * 16;
                const f32x4 sa_ = *(const f32x4*)(SSQ + (size_t)row * 8), sb_ = *(const f32x4*)(SSQ + (size_t)row * 8 + 4);
                if (rope_q || rope_i) {
#pragma unroll
                    for (int k = 0; k < 4; ++k) tt[mm][k] = *(const f32x4*)(tb + (size_t)(row & (SEQ - 1)) * tstride + 4 * k); }
                rs2[mm] = __builtin_amdgcn_rsqf((((sa_[0] + sa_[1]) + (sa_[2] + sa_[3])) + ((sb_[0] + sb_[1]) + (sb_[2] + sb_[3]))) * (1.0f / 512.0f) + EPS); }
#pragma unroll
            for (int mm = 0; mm < 2; ++mm) { const int m = mb + mm;
                const int row = rowb + ai * 128 + m * 16;
                const float rstd = rs2[mm];
#pragma unroll
                for (int bj = 0; bj < 2; ++bj) { f32x4 v0 = acc[ai][bj][m][0] * rstd, v1 = acc[ai][bj][m][1] * rstd;
                    if (pn == 0) {
                        f32x4 p0, p1;
#pragma unroll
                        for (int e = 0; e < 4; ++e) { p0[e] = xlane32(v0[e], fq >= 2); p1[e] = xlane32(v1[e], fq >= 2); }
                        rope8(v0, v1, tt[mm], p0, p1, (fq < 2) ? -1.f : 1.f);
                        v0 = v0 * SCQ; v1 = v1 * SCQ;
                        *(u32x4*)(QROPE + ((size_t)row * 8 + (4 * bj + wc)) * 32 + fq * 8) = pack8(v0, v1);
                    } else {
                        if ((wc & 1) == 0) {
                            f32x4 p0, p1, r0 = v0, r1 = v1;
#pragma unroll
                            for (int e = 0; e < 4; ++e) { p0[e] = xlane16(v0[e], (fq & 1) != 0); p1[e] = xlane16(v1[e], (fq & 1) != 0); }
                            rope8(r0, r1, tt[mm], p0, p1, (fq == 0) ? -1.f : 1.f);
                            if (fq < 2) { v0 = r0; v1 = r1; }
                        }
                        *(u32x4*)(QIDX + (size_t)row * 1024 + (pn - 9) * 256 + bj * 128 + wc * 32 + fq * 8) = pack8(v0, v1);
                    } }
            }
            asm volatile("" ::: "memory");
        }
    }
};

struct EpiOA {
    static constexpr int PROF_ID = 44;
    h16* OAB; const h16* SGA;
    __device__ __forceinline__ void operator()(const f32x4 (&acc)[2][2][4][2], const Unit& u, int wr, int wc, int fr_in, int fq_in) const {
        int fr = fr_in, fq = fq_in; asm volatile("" : "+v"(fr), "+v"(fq));
#pragma unroll
        for (int ai = 0; ai < 2; ++ai)
#pragma unroll
            for (int m = 0; m < 4; ++m) {
                const int row = u.pm * 256 + ai * 128 + wr * 64 + m * 16 + fr;
#pragma unroll
                for (int bj = 0; bj < 2; ++bj) { const int col = u.pn * 256 + bj * 128 + wc * 32 + fq * 8;
                    const h16x8 g = *(const h16x8*)(SGA + (size_t)row * 1024 + col);
                    f32x4 v0 = acc[ai][bj][m][0], v1 = acc[ai][bj][m][1];
#pragma unroll
                    for (int e = 0; e < 4; ++e) { v0[e] *= (float)g[e]; v1[e] *= (float)g[4 + e]; }
                    *(u32x4*)(OAB + (size_t)row * 2048 + col) = pack8(v0, v1); }
            }
    }
};

struct EpiY {
    static constexpr int PROF_ID = 46;
    h16* Y; float* SSY;
    __device__ __forceinline__ void operator()(const f32x4 (&acc)[2][2][4][2], const Unit& u, int wr, int wc, int fr_in, int fq_in) const {
        int fr = fr_in, fq = fq_in; asm volatile("" : "+v"(fr), "+v"(fq));
#pragma unroll
        for (int ai = 0; ai < 2; ++ai)
#pragma unroll
            for (int m = 0; m < 4; ++m) {
                const int row = u.pm * 256 + ai * 128 + wr * 64 + m * 16 + fr;
                float s = 0.f;
#pragma unroll
                for (int bj = 0; bj < 2; ++bj) { const f32x4 v0 = acc[ai][bj][m][0], v1 = acc[ai][bj][m][1];
                    s += (v0[0] * v0[0] + v0[1] * v0[1]) + (v0[2] * v0[2] + v0[3] * v0[3]) + (v1[0] * v1[0] + v1[1] * v1[1]) + (v1[2] * v1[2] + v1[3] * v1[3]);
                    *(u32x4*)(Y + (size_t)row * 2048 + u.pn * 256 + bj * 128 + wc * 32 + fq * 8) = pack8(v0, v1); }
                s += __shfl_xor(s, 16); s += __shfl_xor(s, 32);
                if (fq == 0) SSY[(size_t)row * 32 + u.pn * 4 + wc] = s;
            }
    }
};


__device__ __forceinline__ void p0_mod_unit(const Params& P, int unit, LAS unsigned char* lds) {
    const int tid = threadIdx.x, lane = tid & 63, w = tid >> 6, kc = unit / 24, cc = unit % 24;
    LAS float* sc = (LAS float*)lds;
    LAS float* red = (LAS float*)(lds + 4096);
    for (int i = tid; i < 1024; i += NTHR) { const int b = i >> 8, kk = i & 255; sc[i] = siluf(P.c[b * DM + kc * 256 + kk]); }
    __syncthreads();
    f32x4 acc[4];
#pragma unroll
    for (int b = 0; b < 4; ++b) acc[b] = (f32x4){0.f, 0.f, 0.f, 0.f};
    const float* wp = P.w_ada + (size_t)(kc * 256 + w * 32) * 6144 + cc * 256 + 4 * lane;
#pragma unroll 16
    for (int i = 0; i < 32; ++i) { const f32x4 wv = __builtin_nontemporal_load((const f32x4*)(wp + (size_t)i * 6144));
#pragma unroll
        for (int b = 0; b < 4; ++b) acc[b] += wv * sc[b * 256 + w * 32 + i]; }
#pragma unroll
    for (int b = 0; b < 4; ++b) *(LAS f32x4*)(red + (w * 4 + b) * 256 + 4 * lane) = acc[b];
    __syncthreads();
    float* MODP = (float*)(P.ws + WS_MODP);
    for (int o = tid; o < 1024; o += NTHR) { const int b = o >> 8, j = o & 255; float s = 0.f;
#pragma unroll
        for (int ww = 0; ww < 8; ++ww) s += red[(ww * 4 + b) * 256 + j];
        MODP[(size_t)(kc * 4 + b) * 6144 + cc * 256 + j] = s; }
    __syncthreads();
}
template <class SrcCol>
__device__ __forceinline__ void transpose_item(const float* W, int ldw, const float* kscale, h16* WT, int ldt, int k0, int n0, SrcCol srccol, LAS float* scr, int lane) {
    const int n4 = 4 * (lane & 15), s = srccol(n0 + n4);
    f32x4 tv[16];
#pragma unroll
    for (int i = 0; i < 16; ++i) { const int k = 4 * i + (lane >> 4); tv[i] = (s >= 0) ? __builtin_nontemporal_load((const f32x4*)(W + (size_t)(k0 + k) * ldw + s)) : (f32x4){0.f, 0.f, 0.f, 0.f}; }
#pragma unroll
    for (int i = 0; i < 16; ++i) { const int k = 4 * i + (lane >> 4); f32x4 v = tv[i];
        if (kscale) v = v * kscale[k0 + k];
        *(LAS f32x4*)(scr + k * 64 + (n4 ^ (((k >> 3) & 7) << 2))) = v; }
    asm volatile("s_waitcnt lgkmcnt(0)" ::: "memory");
    const int c = lane & 7;
#pragma unroll
    for (int j = 0; j < 8; ++j) { const int n = (lane >> 3) + 8 * j; const LAS float* sp = scr + (8 * c) * 64 + (n ^ (c << 2));
        u32x4 o; o.x = pk2h(sp[0 * 64], sp[1 * 64]); o.y = pk2h(sp[2 * 64], sp[3 * 64]); o.z = pk2h(sp[4 * 64], sp[5 * 64]); o.w = pk2h(sp[6 * 64], sp[7 * 64]);
        *(u32x4*)(WT + (size_t)(n0 + n) * ldt + k0 + 8 * c) = o; }
    asm volatile("s_waitcnt lgkmcnt(0)" ::: "memory");
}
struct SrcW1 { __device__ int operator()(int n) const { return n < 880 ? n : (n < 1024 ? -1 : n - 144); } };
struct SrcId { __device__ int operator()(int n) const { return n; } };
struct SrcQRope { __device__ int operator()(int n) const { return (n >> 5) * 128 + (n & 31); } };

__device__ __forceinline__ void p0_fold_unit(const Params& P, int unit, LAS unsigned char* lds) {
    const int tid = threadIdx.x, h = unit >> 5, kb = (unit >> 2) & 7, rq = unit & 3;
    LAS float* wuk = (LAS float*)lds;
    LAS float* wuq = (LAS float*)(lds + 24576);
    for (int i = tid; i < 96 * 64; i += NTHR) { const int nn = i >> 6, r = i & 63; wuk[i] = P.w_uk[((size_t)h * 96 + nn) * 256 + rq * 64 + r]; }
    for (int i = tid; i < 64 * 96; i += NTHR) { const int k = i / 96, nn = i % 96; wuq[i] = P.w_uq[(size_t)(kb * 64 + k) * 1024 + h * 128 + 32 + nn]; }
    __syncthreads();
    const int r = tid & 63, kg = __builtin_amdgcn_readfirstlane(tid >> 6);
    float acc[8];
#pragma unroll
    for (int i = 0; i < 8; ++i) acc[i] = 0.f;
#pragma unroll 2
    for (int nn = 0; nn < 96; nn += 4) { const float b0 = wuk[nn * 64 + r], b1 = wuk[(nn + 1) * 64 + r], b2 = wuk[(nn + 2) * 64 + r], b3 = wuk[(nn + 3) * 64 + r];
#pragma unroll
        for (int i = 0; i < 8; ++i) { const f32x4 a = *(const LAS f32x4*)(wuq + (kg * 8 + i) * 96 + nn); acc[i] += (a[0] * b0 + a[1] * b1) + (a[2] * b2 + a[3] * b3); } }
    h16* dst = (h16*)(P.ws + WS_WQT) + (size_t)(256 + h * 256 + rq * 64 + r) * 512 + kb * 64 + kg * 8;
    const float* gq = P.g_q + kb * 64 + kg * 8;
    u32x4 o; o.x = pk2h(acc[0] * gq[0], acc[1] * gq[1]); o.y = pk2h(acc[2] * gq[2], acc[3] * gq[3]); o.z = pk2h(acc[4] * gq[4], acc[5] * gq[5]); o.w = pk2h(acc[6] * gq[6], acc[7] * gq[7]);
    *(u32x4*)dst = o;
    __syncthreads();
}
__device__ __forceinline__ void phase_prologue(const Params& P, LAS unsigned char* lds) {
    const int tid = threadIdx.x, lane = tid & 63, w = tid >> 6, G = gridDim.x, bid = blockIdx.x;
    PROF_B(50);
    for (int u = bid; u < 192; u += G) p0_mod_unit(P, u, lds);
    PROF_E(50); PROF_B(51);
    for (int u = bid; u < 256; u += G) p0_fold_unit(P, u, lds);
    PROF_E(51); PROF_B(52);
    {
        float* r32 = (float*)(P.ws + WS_ROPE32); float* r16 = (float*)(P.ws + WS_ROPE16);
        for (int e = bid * NTHR + tid; e < SEQ * 24; e += G * NTHR) {
            const int pos = e / 24, i = e % 24;
            const float inv = (i < 16) ? (float)pow(500000.0, -(double)i / 16.0) : (float)pow(500000.0, -(double)(i - 16) / 8.0);
            const float ang = (float)pos * inv;
            const float cv = (float)cos((double)ang), sv = (float)sin((double)ang);
            if (i < 16) { r32[((size_t)pos * 16 + i) * 2] = cv; r32[((size_t)pos * 16 + i) * 2 + 1] = sv; }
            else { r16[((size_t)pos * 8 + (i - 16)) * 2] = cv; r16[((size_t)pos * 8 + (i - 16)) * 2 + 1] = sv; }
        }
    }
    {
        h16* WUVT = (h16*)(P.ws + WS_WUVT);
        for (int e = bid * NTHR + tid; e < 1024 * 32; e += G * NTHR) { const int n = e >> 5, c8 = e & 31, hh = n >> 7; const int k = ((hh & 1) ? 0 : 256) + c8 * 8;
            *(u32x4*)(WUVT + (size_t)n * 512 + k) = (u32x4){0u, 0u, 0u, 0u}; }
    }
    PROF_E(52); PROF_B(53);
    LAS float* scr = (LAS float*)(lds + w * 16384);
    const int gw = bid * NWAVE + w, NGW = G * NWAVE;
    constexpr int I_W1 = 32 * 96, I_QR = 8 * 4, I_QI = 8 * 16, I_UV = 8 * 4 * 2, I_WO = 32 * 32;
    for (int it = gw; it < I_W1 + I_QR + I_QI + I_UV + I_WO; it += NGW) {
        int r = it;
        if (r < I_W1) { transpose_item(P.w_in, 6000, nullptr, (h16*)(P.ws + WS_W1T), 2048, (r / 96) * 64, (r % 96) * 64, SrcW1(), scr, lane); continue; } r -= I_W1;
        if (r < I_QR) { transpose_item(P.w_uq, 1024, P.g_q, (h16*)(P.ws + WS_WQT), 512, (r / 4) * 64, (r % 4) * 64, SrcQRope(), scr, lane); continue; } r -= I_QR;
        if (r < I_QI) { transpose_item(P.w_uq_idx, 1024, P.g_q, (h16*)(P.ws + WS_WQT) + (size_t)2304 * 512, 512, (r / 16) * 64, (r % 16) * 64, SrcId(), scr, lane); continue; } r -= I_QI;
        if (r < I_UV) { const int hh = r >> 3, kb = (r >> 1) & 3, nb = r & 1;
            transpose_item(P.w_uv + (size_t)hh * 256 * 128, 128, nullptr, (h16*)(P.ws + WS_WUVT) + (size_t)(hh * 128) * 512 + 256 * (hh & 1), 512, kb * 64, nb * 64, SrcId(), scr, lane); continue; } r -= I_UV;
        transpose_item(P.w_out, 2048, nullptr, (h16*)(P.ws + WS_WOT), 2048, (r / 32) * 64, (r % 32) * 64, SrcId(), scr, lane);
    }
    PROF_E(53);
}

__device__ __forceinline__ void load_mod(const Params& P, int b, int off, LAS float* dst, bool plus1) {
    const float* MODP = (const float*)(P.ws + WS_MODP);
    int tid0 = threadIdx.x; asm volatile("" : "+v"(tid0));
    for (int j = tid0; j < 2048; j += NTHR) { float s = P.b_ada[off + j];
#pragma unroll
        for (int kc = 0; kc < 8; ++kc) s += MODP[(size_t)(kc * 4 + b) * 6144 + off + j];
        dst[j] = plus1 ? 1.0f + s : s; }
}
__device__ __forceinline__ void phase_h(const Params& P, LAS unsigned char* lds) {
    const int tid = threadIdx.x, lane = tid & 63, w = tid >> 6;
    LAS float* shift = (LAS float*)lds; LAS float* scale1 = (LAS float*)(lds + 8192);
    h16* H = (h16*)(P.ws + WS_H);
    for (int ch = blockIdx.x; ch < 256; ch += gridDim.x) {
        const int b = ch >> 6;
        __syncthreads();
        load_mod(P, b, 0, shift, false); load_mod(P, b, 2048, scale1, true);
        __syncthreads();
        for (int i = 0; i < 8; ++i) {
            const int row = ch * 64 + w * 8 + i;
            const float* xr = P.x + (size_t)row * DM + 4 * lane;
            f32x4 v[8]; float ss = 0.f;
#pragma unroll
            for (int j = 0; j < 8; ++j) { v[j] = *(const f32x4*)(xr + 256 * j); ss += (v[j][0] * v[j][0] + v[j][1] * v[j][1]) + (v[j][2] * v[j][2] + v[j][3] * v[j][3]); }
            const float rstd = 1.0f / sqrtf(wave_sum(ss) * (1.0f / DM) + EPS);
#pragma unroll
            for (int j = 0; j < 8; ++j) { const int col = 4 * lane + 256 * j; const f32x4 g = *(const f32x4*)(P.g_pre + col);
                const f32x4 s1 = *(const LAS f32x4*)(scale1 + col), sh = *(const LAS f32x4*)(shift + col);
                const f32x4 o = v[j] * rstd * g * s1 + sh; u32x2 pk; pk.x = pk2h(o[0], o[1]); pk.y = pk2h(o[2], o[3]);
                *(u32x2*)(H + (size_t)row * DM + col) = pk; }
        }
    }
}
__device__ __forceinline__ void phase_rowops(const Params& P) {
    const int tid = threadIdx.x, lane = tid & 63, w = tid >> 6;
    h16* KVC = (h16*)(P.ws + WS_KVC); h16* KIDX = (h16*)(P.ws + WS_KIDX); float* WIDX = (float*)(P.ws + WS_WIDX);
    const float* SMALL = (const float*)(P.ws + WS_SMALL); const float* r32 = (const float*)(P.ws + WS_ROPE32); const float* r16 = (const float*)(P.ws + WS_ROPE16);
    for (int row = blockIdx.x * NWAVE + w; row < T; row += gridDim.x * NWAVE) {
        const int pos = row & (SEQ - 1);
        h16* kr = KVC + (size_t)row * KVW;
        const h16x4 raw = *(const h16x4*)(kr + 4 * lane);
        float v[4]; float ss = 0.f;
#pragma unroll
        for (int e = 0; e < 4; ++e) { v[e] = (float)raw[e]; ss += v[e] * v[e]; }
        const float rstd = 1.0f / sqrtf(wave_sum(ss) * (1.0f / 256.0f) + EPS);
        const f32x4 g = *(const f32x4*)(P.g_kv + 4 * lane);
        u32x2 pk; pk.x = pk2h(v[0] * rstd * g[0], v[1] * rstd * g[1]); pk.y = pk2h(v[2] * rstd * g[2], v[3] * rstd * g[3]);
        *(u32x2*)(kr + 4 * lane) = pk;
        const float* sm = SMALL + (size_t)row * 128;
        if (lane < 32) {
            const int i = lane & 15; const float x1 = sm[i], x2 = sm[i + 16]; const float cv = r32[((size_t)pos * 16 + i) * 2], sv = r32[((size_t)pos * 16 + i) * 2 + 1];
            kr[256 + lane] = (h16)(lane < 16 ? x1 * cv - x2 * sv : x2 * cv + x1 * sv);
        }
        {
            float o = sm[32 + lane];
            if (lane < 16) { const int i = lane & 7; const float x1 = sm[32 + i], x2 = sm[32 + i + 8]; const float cv = r16[((size_t)pos * 8 + i) * 2], sv = r16[((size_t)pos * 8 + i) * 2 + 1];
                o = lane < 8 ? x1 * cv - x2 * sv : x2 * cv + x1 * sv; }
            KIDX[(size_t)row * 64 + lane] = (h16)o;
        }
        if (lane < 16) WIDX[(size_t)row * 16 + lane] = sm[96 + lane] * (1.0f / 32.0f);
    }
}
__device__ __forceinline__ void phase_final(const Params& P, LAS unsigned char* lds) {
    const int tid = threadIdx.x, lane = tid & 63, w = tid >> 6;
    LAS float* gate = (LAS float*)lds;
    const h16* Y = (const h16*)(P.ws + WS_Y); const float* SSY = (const float*)(P.ws + WS_SSY);
    for (int ch = blockIdx.x; ch < 256; ch += gridDim.x) {
        const int b = ch >> 6;
        __syncthreads();
        load_mod(P, b, 4096, gate, false);
        __syncthreads();
        for (int i = 0; i < 8; i += 2) {
            const int row0 = ch * 64 + w * 8 + i;
            float ss = SSY[(size_t)row0 * 32 + lane];
#pragma unroll
            for (int o = 1; o < 32; o <<= 1) ss += __shfl_xor(ss, o);
            const float rstd_mine = __builtin_amdgcn_rsqf(ss * (1.0f / DM) + EPS);
            const float rstd0 = __shfl(rstd_mine, 0), rstd1 = __shfl(rstd_mine, 32);
            f32x4 xv[2][8]; h16x4 yv[2][8];
#pragma unroll
            for (int rr = 0; rr < 2; ++rr)
#pragma unroll
                for (int j = 0; j < 8; ++j) { const int col = 4 * lane + 256 * j;
                    xv[rr][j] = __builtin_nontemporal_load((const f32x4*)(P.x + (size_t)(row0 + rr) * DM + col)); yv[rr][j] = *(const h16x4*)(Y + (size_t)(row0 + rr) * DM + col); }
#pragma unroll
            for (int rr = 0; rr < 2; ++rr) { const float rstd = rr ? rstd1 : rstd0;
#pragma unroll
                for (int j = 0; j < 8; ++j) { const int col = 4 * lane + 256 * j;
                    const f32x4 g = *(const f32x4*)(P.g_post + col), gt = *(const LAS f32x4*)(gate + col);
                    f32x4 o;
#pragma unroll
                    for (int e = 0; e < 4; ++e) o[e] = xv[rr][j][e] + gt[e] * ((float)yv[rr][j][e] * rstd * g[e]);
                    __builtin_nontemporal_store(o, (f32x4*)(P.out + (size_t)(row0 + rr) * DM + col)); } }
        }
    }
}


constexpr int SP_PITCH = 592;
constexpr int SP_BUF = 32 * SP_PITCH;
constexpr int SP_LIST = 8 * SP_BUF;
__device__ __forceinline__ void sparse_attn_query(const Params& P, LAS unsigned char* lds, int wid, int lane, int b, int row, int kvalid, const LAS unsigned short* list);
typedef float f32x16 __attribute__((ext_vector_type(16)));
typedef short s16x4 __attribute__((ext_vector_type(4)));
__device__ __forceinline__ unsigned imgb_off(unsigned row, unsigned ch) { return 256u * row + 16u * (ch ^ (((row & 3u) << 2) | ((row >> 2) & 3u))); }
constexpr int DIL_STG = 98304, DIL_LSE = DIL_STG + 8 * 4608;
__device__ __forceinline__ void dil_load(u32x4 (&rg)[12], const h16* src_bh, int m0, int dil, int res, int tid) {
#pragma unroll
    for (int p = 0; p < 12; ++p) {
        const int kk = p * 32 + (tid >> 4); int j = m0 - 128 + kk; j = j < 0 ? 0 : j;
        const unsigned sw = (unsigned)(((kk & 3) << 2) | ((kk >> 2) & 3));
        rg[p] = *(const u32x4*)(src_bh + (size_t)(j * dil + res) * 1024 + 8 * ((unsigned)(tid & 15) ^ sw));
    }
}
__device__ __forceinline__ void dil_write(LAS unsigned char* lds, const u32x4 (&rg)[12], int tid) {
#pragma unroll
    for (int p = 0; p < 12; ++p) *(LAS u32x4*)(lds + p * 8192 + tid * 16) = rg[p];
}
struct DilUnit { int dil, pslot, b, h, res, blk; };
template <bool LAST>
__device__ __forceinline__ void dilated_unit(const Params& P, LAS unsigned char* lds, const DilUnit u, u32x4 (&kv)[12], const DilUnit nxt, bool has_next) {
    const int dil = u.dil, pslot = u.pslot, b = u.b, h = u.h, res = u.res, blk = u.blk;
    const int tid = threadIdx.x, lane = tid & 63, wid = __builtin_amdgcn_readfirstlane(tid >> 6), n = lane & 31, hi = lane >> 5;
    const int m0 = blk * 256;
    const size_t bh = (size_t)b * SEQ * 1024 + h * 128;
    const h16* QBp = (const h16*)(P.ws + WS_QB) + bh; const h16* VBp = (const h16*)(P.ws + WS_VB) + bh;
    PROF_B(10);
    dil_write(lds, kv, tid);
    dil_load(kv, VBp, m0, dil, res, tid);
    h16x8 qf[8];
    { const h16* qp = QBp + (size_t)((m0 + 32 * wid + n) * dil + res) * 1024 + 8 * hi;
#pragma unroll
      for (int ks = 0; ks < 8; ++ks) qf[ks] = *(const h16x8*)(qp + 16 * ks); }
    __syncthreads();
    PROF_E(10); PROF_B(11);
    f32x16 sa[5];
#pragma unroll
    for (int ti = 0; ti < 5; ++ti) {
#pragma unroll
        for (int r = 0; r < 16; ++r) sa[ti][r] = 0.f;
#pragma unroll
        for (int ks = 0; ks < 8; ++ks) { const h16x8 kf = *(const LAS h16x8*)(lds + imgb_off(32 * (wid + ti) + n, 2 * ks + hi));
            sa[ti] = __builtin_amdgcn_mfma_f32_32x32x16_f16(kf, qf[ks], sa[ti], 0, 0, 0); }
    }
    PROF_E(11); PROF_B(12);
    const int jmin = 128 - m0;
    float mx = -INFINITY;
#pragma unroll
    for (int ti = 0; ti < 5; ++ti)
#pragma unroll
        for (int r = 0; r < 16; ++r) { const int kin = (r & 3) + 8 * (r >> 2) + 4 * hi; bool ok = (32 * (wid + ti) + kin) >= jmin;
            if (ti == 0) ok = ok && (kin >= n); if (ti == 4) ok = ok && (kin <= n);
            const float s = ok ? sa[ti][r] : -INFINITY; sa[ti][r] = s; mx = fmaxf(mx, s); }
    mx = fmaxf(mx, __shfl_xor(mx, 32));
    float l = 0.f;
#pragma unroll
    for (int ti = 0; ti < 5; ++ti)
#pragma unroll
        for (int r = 0; r < 16; ++r) { const float p = __builtin_amdgcn_exp2f(sa[ti][r] - mx); sa[ti][r] = p; l += p; }
    l += __shfl_xor(l, 32);
    h16x8 pf[5][2];
#pragma unroll
    for (int ti = 0; ti < 5; ++ti)
#pragma unroll
        for (int s = 0; s < 2; ++s)
#pragma unroll
            for (int jj = 0; jj < 8; ++jj) pf[ti][s][jj] = (h16)sa[ti][8 * s + jj];
    PROF_E(12); PROF_B(13);
    __syncthreads();
    dil_write(lds, kv, tid);
    if (has_next) dil_load(kv, (const h16*)(P.ws + WS_KB) + (size_t)nxt.b * SEQ * 1024 + nxt.h * 128, nxt.blk * 256, nxt.dil, nxt.res, tid);
    __syncthreads();
    PROF_E(13); PROF_B(14);
    f32x16 oa[4];
#pragma unroll
    for (int c = 0; c < 4; ++c)
#pragma unroll
        for (int r = 0; r < 16; ++r) oa[c][r] = 0.f;
    const int dgrp = (lane >> 4) & 1, q4 = (lane & 15) >> 2, p4 = lane & 3;
#pragma unroll
    for (int ti = 0; ti < 5; ++ti)
#pragma unroll
        for (int s = 0; s < 2; ++s) {
#pragma unroll
            for (int c = 0; c < 4; ++c) {
                const unsigned row0 = 32 * (wid + ti) + 16 * s + 4 * hi + q4, ch = 4 * c + 2 * dgrp + (p4 >> 1);
                const s16x4 t0 = __builtin_amdgcn_ds_read_tr16_b64_v4i16((LAS s16x4*)(lds + imgb_off(row0, ch) + 8 * (p4 & 1)));
                const s16x4 t1 = __builtin_amdgcn_ds_read_tr16_b64_v4i16((LAS s16x4*)(lds + imgb_off(row0 + 8, ch) + 8 * (p4 & 1)));
                typedef short s16x8 __attribute__((ext_vector_type(8)));
                const s16x8 v8 = {t0[0], t0[1], t0[2], t0[3], t1[0], t1[1], t1[2], t1[3]};
                oa[c] = __builtin_amdgcn_mfma_f32_32x32x16_f16(__builtin_bit_cast(h16x8, v8), pf[ti][s], oa[c], 0, 0, 0);
            }
        }
    PROF_E(14); PROF_B(15);
    const float invl = 1.0f / l, lse = mx + __builtin_amdgcn_logf(l);
    LAS unsigned char* stg = lds + DIL_STG + wid * 4608;
    LAS float* lsew = (LAS float*)(lds + DIL_LSE) + wid * 32;
    float* LSEP = (float*)(P.ws + WS_LSEP);
    const int pos_n = (m0 + 32 * wid + n) * dil + res;
    if (LAST) { if (hi == 0) lsew[n] = lse; }
    else if (hi == 0) LSEP[((size_t)pslot * T + (size_t)b * SEQ + pos_n) * 8 + h] = lse;
#pragma unroll
    for (int half = 0; half < 2; ++half) {
#pragma unroll
        for (int cc = 0; cc < 2; ++cc)
#pragma unroll
            for (int rg = 0; rg < 4; ++rg) { const f32x16& o = oa[2 * half + cc]; u32x2 w2; w2.x = pk2h(o[4 * rg] * invl, o[4 * rg + 1] * invl); w2.y = pk2h(o[4 * rg + 2] * invl, o[4 * rg + 3] * invl);
                *(LAS u32x2*)(stg + n * 144 + 2 * (32 * cc + 8 * rg + 4 * hi)) = w2; }
        h16x8 m4[4], m16[4], mg[4]; float ml4[4], ml16[4];
        if (LAST) {
#pragma unroll
            for (int i = 0; i < 4; ++i) { const int rowl = (lane >> 3) + 8 * i; const size_t grow = (size_t)b * SEQ + (size_t)((m0 + 32 * wid + rowl) * dil + res); const size_t coff = (size_t)h * 128 + 64 * half + 8 * (lane & 7);
                m4[i] = *(const h16x8*)((const h16*)(P.ws + WS_OP4) + grow * 1024 + coff); m16[i] = *(const h16x8*)((const h16*)(P.ws + WS_OP16) + grow * 1024 + coff);
                mg[i] = *(const h16x8*)((const h16*)(P.ws + WS_SGB) + grow * 1024 + coff); ml4[i] = LSEP[grow * 8 + h]; ml16[i] = LSEP[((size_t)T + grow) * 8 + h]; }
        }
        asm volatile("s_waitcnt lgkmcnt(0)" ::: "memory");
#pragma unroll
        for (int i = 0; i < 4; ++i) {
            const int rowl = (lane >> 3) + 8 * i, ch = lane & 7;
            const u32x4 v = *(const LAS u32x4*)(stg + rowl * 144 + 16 * ch);
            const size_t grow = (size_t)b * SEQ + (size_t)((m0 + 32 * wid + rowl) * dil + res);
            const size_t coff = (size_t)h * 128 + 64 * half + 8 * ch;
            if (!LAST) { *(u32x4*)((h16*)(P.ws + (pslot ? WS_OP16 : WS_OP4)) + grow * 1024 + coff) = v; }
            else {
                const float l1 = lsew[rowl], l4 = ml4[i], l16 = ml16[i];
                const float mm = fmaxf(l1, fmaxf(l4, l16));
                const float w1 = __builtin_amdgcn_exp2f(l1 - mm), w4 = __builtin_amdgcn_exp2f(l4 - mm), w16 = __builtin_amdgcn_exp2f(l16 - mm), iw = 1.0f / (w1 + w4 + w16);
                const h16x8 o1 = __builtin_bit_cast(h16x8, v);
                float r8[8];
#pragma unroll
                for (int e = 0; e < 8; ++e) r8[e] = (w1 * (float)o1[e] + w4 * (float)m4[i][e] + w16 * (float)m16[i][e]) * iw * (float)mg[i][e];
                u32x4 ov; ov.x = pk2h(r8[0], r8[1]); ov.y = pk2h(r8[2], r8[3]); ov.z = pk2h(r8[4], r8[5]); ov.w = pk2h(r8[6], r8[7]);
                *(u32x4*)((h16*)(P.ws + WS_OAB) + grow * 2048 + 1024 + coff) = ov;
            }
        }
        asm volatile("s_waitcnt lgkmcnt(0)" ::: "memory");
    }
    __syncthreads();
    PROF_E(15);
}
__device__ __forceinline__ DilUnit dil_part_unit(int idx) {
    const int cfg = idx >> 9, w_ = idx & 511, xcd = w_ & 7, lu = w_ >> 3, bhh = xcd * 4 + (lu >> 4), rb = lu & 15;
    DilUnit u; u.b = bhh >> 3; u.h = bhh & 7;
    if (cfg == 0) { u.dil = 4; u.pslot = 0; u.res = rb & 3; u.blk = rb >> 2; } else { u.dil = 16; u.pslot = 1; u.res = rb; u.blk = 0; }
    return u;
}
__device__ __forceinline__ DilUnit dil_last_unit(int idx) {
    const int xcd = idx & 7, lu = idx >> 3, bhh = xcd * 4 + (lu >> 4);
    DilUnit u; u.b = bhh >> 3; u.h = bhh & 7; u.dil = 1; u.pslot = 0; u.res = 0; u.blk = lu & 15;
    return u;
}
__device__ __forceinline__ void phase_dilated_part(const Params& P, LAS unsigned char* lds) {
    int idx = blockIdx.x; if (idx >= 1024) return;
    u32x4 kv[12];
    DilUnit u = dil_part_unit(idx);
    dil_load(kv, (const h16*)(P.ws + WS_KB) + (size_t)u.b * SEQ * 1024 + u.h * 128, u.blk * 256, u.dil, u.res, threadIdx.x);
    for (;;) {
        const int nidx = idx + gridDim.x; const bool hn = nidx < 1024; const DilUnit nu = dil_part_unit(hn ? nidx : idx);
        dilated_unit<false>(P, lds, u, kv, nu, hn);
        if (!hn) break;
        idx = nidx; u = nu;
    }
}
__device__ __forceinline__ void phase_dilated_last(const Params& P, LAS unsigned char* lds) {
    int idx = blockIdx.x; if (idx >= 512) return;
    u32x4 kv[12];
    DilUnit u = dil_last_unit(idx);
    dil_load(kv, (const h16*)(P.ws + WS_KB) + (size_t)u.b * SEQ * 1024 + u.h * 128, u.blk * 256, u.dil, u.res, threadIdx.x);
    for (;;) {
        const int nidx = idx + gridDim.x; const bool hn = nidx < 512; const DilUnit nu = dil_last_unit(hn ? nidx : idx);
        dilated_unit<true>(P, lds, u, kv, nu, hn);
        if (!hn) break;
        idx = nidx; u = nu;
    }
}

__device__ __forceinline__ void sparse_attn_query(const Params& P, LAS unsigned char* lds, int wid, int lane_in, int b, int row, int kvalid, const LAS unsigned short* list) {
    int lane = lane_in; asm volatile("" : "+v"(lane));
    LAS unsigned char* buf = lds + wid * SP_BUF;
    const int n = lane & 15, g = lane >> 4, q4 = n >> 2, p4 = n & 3, sub = lane >> 2, c4 = lane & 3;
    PROF_B(30);
    h16x8 qf[9];
    {
        const h16* ql = (const h16*)(P.ws + WS_QLAT) + ((size_t)row * 8 + (n & 7)) * 256 + 8 * g;
        const h16* qr = (const h16*)(P.ws + WS_QROPE) + ((size_t)row * 8 + (n & 7)) * 32 + 8 * g;
        const h16x8 z = {(h16)0.f, (h16)0.f, (h16)0.f, (h16)0.f, (h16)0.f, (h16)0.f, (h16)0.f, (h16)0.f};
#pragma unroll
        for (int ks = 0; ks < 8; ++ks) { const h16x8 v = *(const h16x8*)(ql + 32 * ks); qf[ks] = (n < 8) ? v : z; }
        { const h16x8 v = *(const h16x8*)qr; qf[8] = (n < 8) ? v : z; }
    }
    f32x4 oacc[16];
#pragma unroll
    for (int dt = 0; dt < 16; ++dt) oacc[dt] = (f32x4){0.f, 0.f, 0.f, 0.f};
    float m = -INFINITY, l = 0.f;
    const unsigned char* kvb = P.ws + WS_KVC + (size_t)b * SEQ * (KVW * 2) + 16 * c4;
    u32x4 stg[18];
#define SP_ISSUE(step_) do { unsigned i0 = list[32 * (step_) + sub], i1 = list[32 * (step_) + 16 + sub]; i0 = (i0 == 0xFFFFu) ? 0u : i0; i1 = (i1 == 0xFFFFu) ? 0u : i1; \
        const unsigned char* r0 = kvb + (size_t)i0 * 576; const unsigned char* r1 = kvb + (size_t)i1 * 576; \
        _Pragma("unroll") for (int cg = 0; cg < 9; ++cg) { stg[2 * cg] = *(const u32x4*)(r0 + 64 * cg); stg[2 * cg + 1] = *(const u32x4*)(r1 + 64 * cg); } } while (0)
    SP_ISSUE(0);
    PROF_E(30);
    for (int step = 0; step < 8; ++step) {
        PROF_B(31);
#pragma unroll
        for (int cg = 0; cg < 9; ++cg) { *(LAS u32x4*)(buf + SP_PITCH * sub + 64 * cg + 16 * c4) = stg[2 * cg]; *(LAS u32x4*)(buf + SP_PITCH * (16 + sub) + 64 * cg + 16 * c4) = stg[2 * cg + 1]; }
        if (step < 7) SP_ISSUE(step + 1);
        asm volatile("s_waitcnt lgkmcnt(0)" ::: "memory");
        PROF_E(31); PROF_B(32);
        __builtin_amdgcn_s_setprio(1);
        f32x4 s0 = (f32x4){0.f, 0.f, 0.f, 0.f}, s1 = (f32x4){0.f, 0.f, 0.f, 0.f};
#pragma unroll
        for (int ks = 0; ks < 9; ++ks) {
            const h16x8 a0 = *(const LAS h16x8*)(buf + SP_PITCH * n + 64 * ks + 16 * g), a1 = *(const LAS h16x8*)(buf + SP_PITCH * (16 + n) + 64 * ks + 16 * g);
            s0 = __builtin_amdgcn_mfma_f32_16x16x32_f16(a0, qf[ks], s0, 0, 0, 0); s1 = __builtin_amdgcn_mfma_f32_16x16x32_f16(a1, qf[ks], s1, 0, 0, 0);
        }
        PROF_E(32); PROF_B(33);
        float mx = -INFINITY;
#pragma unroll
        for (int r = 0; r < 4; ++r) { const int lp = 32 * step + 4 * g + r;
            s0[r] = (lp < kvalid) ? s0[r] : -INFINITY; s1[r] = (lp + 16 < kvalid) ? s1[r] : -INFINITY; mx = fmaxf(mx, fmaxf(s0[r], s1[r])); }
        mx = fmaxf(mx, __shfl_xor(mx, 16)); mx = fmaxf(mx, __shfl_xor(mx, 32));
        if (__builtin_amdgcn_ballot_w64(mx > m + 8.0f) != 0ull) {
            const float mnew = fmaxf(m, mx), alpha = __builtin_amdgcn_exp2f(m - mnew);
            m = mnew; l *= alpha;
#pragma unroll
            for (int dt = 0; dt < 16; ++dt) oacc[dt] = oacc[dt] * alpha;
        }
        h16x8 pf;
#pragma unroll
        for (int r = 0; r < 4; ++r) { const float p0 = __builtin_amdgcn_exp2f(s0[r] - m), p1 = __builtin_amdgcn_exp2f(s1[r] - m); l += p0 + p1; pf[r] = (h16)p0; pf[4 + r] = (h16)p1; }
        PROF_E(33); PROF_B(34);
#pragma unroll
        for (int dt = 0; dt < 16; ++dt) {
            const s16x4 t0 = __builtin_amdgcn_ds_read_tr16_b64_v4i16((LAS s16x4*)(buf + SP_PITCH * (4 * g + q4) + 32 * dt + 8 * p4));
            const s16x4 t1 = __builtin_amdgcn_ds_read_tr16_b64_v4i16((LAS s16x4*)(buf + SP_PITCH * (16 + 4 * g + q4) + 32 * dt + 8 * p4));
            typedef short s16x8 __attribute__((ext_vector_type(8)));
            const s16x8 v8 = {t0[0], t0[1], t0[2], t0[3], t1[0], t1[1], t1[2], t1[3]};
            oacc[dt] = __builtin_amdgcn_mfma_f32_16x16x32_f16(__builtin_bit_cast(h16x8, v8), pf, oacc[dt], 0, 0, 0);
        }
        __builtin_amdgcn_s_setprio(0);
        asm volatile("s_waitcnt lgkmcnt(0)" ::: "memory");
        PROF_E(34);
    }
#undef SP_ISSUE
    PROF_B(35);
    l += __shfl_xor(l, 16); l += __shfl_xor(l, 32);
    const float inv = 1.0f / l;
    if (n < 8) {
        h16* op = (h16*)(P.ws + WS_OLAT) + ((size_t)row * 8 + n) * 256 + 4 * g;
#pragma unroll
        for (int dt = 0; dt < 16; ++dt) { u32x2 w2; w2.x = pk2h(oacc[dt][0] * inv, oacc[dt][1] * inv); w2.y = pk2h(oacc[dt][2] * inv, oacc[dt][3] * inv); *(u32x2*)(op + 16 * dt) = w2; }
    }
    PROF_E(35);
}

constexpr int DS_QI = 0;
constexpr int DS_WQ = 36864;
constexpr int DS_CNTB = DS_WQ + 1024;
constexpr int DS_CGT = DS_CNTB + 1024;
constexpr int DS_CEQ = DS_CGT + 512;
constexpr int DS_PCNT = DS_CEQ + 512;
constexpr int DS_TCNT = DS_PCNT + 2048;
constexpr int DS_TLIST = DS_TCNT + 64;
constexpr int DS_TSC = DS_TLIST + 2048;
constexpr int DS_TK = DS_TSC + 4096;
constexpr int DS_LIST = SP_LIST;
constexpr int TIE_CAP = 64, TIE_FAST = 32;
__device__ __forceinline__ unsigned sortable_hi16(float s) { const unsigned bits = __float_as_uint(s + 0.0f); return ((bits & 0x80000000u) ? ~bits : (bits | 0x80000000u)) >> 16; }
typedef _Float16 h16x2v __attribute__((ext_vector_type(2)));
__device__ __forceinline__ unsigned pk_count_gt(unsigned acc, unsigned v, unsigned cm1pk) {
    unsigned d;
    asm("v_pk_sub_u16 %1, %2, %3 clamp\n\tv_pk_min_u16 %1, %1, %4\n\tv_pk_add_u16 %0, %0, %1" : "+v"(acc), "=&v"(d) : "v"(v), "v"(cm1pk), "v"(0x00010001u));
    return acc;
}
__device__ __forceinline__ unsigned pk_mask_gt(unsigned m, unsigned v, unsigned cm1pk) {
    unsigned d;
    asm("v_pk_sub_u16 %1, %2, %3 clamp\n\tv_pk_min_u16 %1, %1, %4\n\tv_lshl_or_b32 %0, %0, 1, %1" : "+v"(m), "=&v"(d) : "v"(v), "v"(cm1pk), "v"(0x00010001u));
    return m;
}
__device__ __forceinline__ unsigned wave_sum_u(unsigned v) {
    v += (unsigned)__builtin_amdgcn_update_dpp(0, (int)v, 0xB1, 0xF, 0xF, true);
    v += (unsigned)__builtin_amdgcn_update_dpp(0, (int)v, 0x4E, 0xF, 0xF, true);
    v += (unsigned)__builtin_amdgcn_update_dpp(0, (int)v, 0x141, 0xF, 0xF, true);
    v += (unsigned)__builtin_amdgcn_update_dpp(0, (int)v, 0x140, 0xF, 0xF, true);
    { const auto r = __builtin_amdgcn_permlane16_swap(v, v, false, false); v = r[0] + r[1]; }
    { const auto r = __builtin_amdgcn_permlane32_swap(v, v, false, false); v = r[0] + r[1]; }
    return v;
}
__device__ __forceinline__ void dsa_score_group(LAS unsigned char* lds, const h16x8 (&kf)[4][2], int grp, int w, int q, int kq, int tq, int ntile, unsigned (&c8)[8]) {
    const unsigned sw = (unsigned)((q >> 1) & 7);
    const LAS float* WQ = (const LAS float*)(lds + DS_WQ);
    const LAS unsigned char* qrow = lds + DS_QI + q * 128;
    const unsigned o0 = 16u * ((unsigned)kq ^ sw), o1 = 16u * ((unsigned)(4 + kq) ^ sw);
    const f32x4 zero4 = {0.f, 0.f, 0.f, 0.f};
    f32x4 acc[4];
    {
        const h16x8 a0 = *(const LAS h16x8*)(qrow + 16 * 2048 + o0), a1 = *(const LAS h16x8*)(qrow + 16 * 2048 + o1), b0 = *(const LAS h16x8*)(qrow + 17 * 2048 + o0), b1 = *(const LAS h16x8*)(qrow + 17 * 2048 + o1);
#pragma unroll
        for (int j = 0; j < 4; ++j) { acc[j] = __builtin_amdgcn_mfma_f32_16x16x32_f16(kf[j][0], a0, zero4, 0, 0, 0); acc[j] = __builtin_amdgcn_mfma_f32_16x16x32_f16(kf[j][1], a1, acc[j], 0, 0, 0);
            acc[j] = __builtin_amdgcn_mfma_f32_16x16x32_f16(kf[j][0], b0, acc[j], 0, 0, 0); acc[j] = __builtin_amdgcn_mfma_f32_16x16x32_f16(kf[j][1], b1, acc[j], 0, 0, 0); }
    }
#define DSA_MM(lg, qa, qb) do { _Pragma("unroll") for (int j = 0; j < 4; ++j) lg[j] = __builtin_amdgcn_mfma_f32_16x16x32_f16(kf[j][0], qa, zero4, 0, 0, 0); \
        _Pragma("unroll") for (int j = 0; j < 4; ++j) lg[j] = __builtin_amdgcn_mfma_f32_16x16x32_f16(kf[j][1], qb, lg[j], 0, 0, 0); } while (0)
#define DSA_ACC(lg, wv) do { _Pragma("unroll") for (int j = 0; j < 4; ++j) _Pragma("unroll") for (int r = 0; r < 4; ++r) \
        asm volatile("v_fma_f32 %0, |%1|, %2, %0" : "+v"(acc[j][r]) : "v"(lg[j][r]), "v"(wv)); } while (0)
#define DSA_MF0(d, a, b) asm volatile("v_mfma_f32_16x16x32_f16 %0, %1, %2, 0" : "=&v"(d) : "v"(a), "v"(b))
#define DSA_MF1(d, a, b) asm volatile("v_mfma_f32_16x16x32_f16 %0, %1, %2, %0" : "+v"(d) : "v"(a), "v"(b))
#define DSA_F2(lg, j, r, wv) do { asm volatile("v_fma_f32 %0, |%1|, %2, %0" : "+v"(acc[j][r]) : "v"(lg[j][r]), "v"(wv)); \
        asm volatile("v_fma_f32 %0, |%1|, %2, %0" : "+v"(acc[j][(r) + 1]) : "v"(lg[j][(r) + 1]), "v"(wv)); } while (0)
#define DSA_MMACC(ln, qa, qb, lo, wv) do { \
        DSA_MF0(ln[0], kf[0][0], qa); DSA_F2(lo, 0, 0, wv); DSA_MF0(ln[1], kf[1][0], qa); DSA_F2(lo, 0, 2, wv); \
        DSA_MF0(ln[2], kf[2][0], qa); DSA_F2(lo, 1, 0, wv); DSA_MF0(ln[3], kf[3][0], qa); DSA_F2(lo, 1, 2, wv); \
        DSA_MF1(ln[0], kf[0][1], qb); DSA_F2(lo, 2, 0, wv); DSA_MF1(ln[1], kf[1][1], qb); DSA_F2(lo, 2, 2, wv); \
        DSA_MF1(ln[2], kf[2][1], qb); DSA_F2(lo, 3, 0, wv); DSA_MF1(ln[3], kf[3][1], qb); DSA_F2(lo, 3, 2, wv); } while (0)
    f32x4 lgA[4], lgB[4];
    h16x8 qa0 = *(const LAS h16x8*)(qrow + o0), qa1 = *(const LAS h16x8*)(qrow + o1); float wa = WQ[q * 16];
    h16x8 qb0 = *(const LAS h16x8*)(qrow + 2048 + o0), qb1 = *(const LAS h16x8*)(qrow + 2048 + o1); float wb = WQ[q * 16 + 1];
    DSA_MM(lgA, qa0, qa1);
    for (int h = 0; h < 14; h += 2) {
        __builtin_amdgcn_sched_barrier(0);
        qa0 = *(const LAS h16x8*)(qrow + (h + 2) * 2048 + o0); qa1 = *(const LAS h16x8*)(qrow + (h + 2) * 2048 + o1); const float wa2 = WQ[q * 16 + h + 2];
        __builtin_amdgcn_sched_barrier(0);
        DSA_MMACC(lgB, qb0, qb1, lgA, wa);
        __builtin_amdgcn_sched_barrier(0);
        qb0 = *(const LAS h16x8*)(qrow + (h + 3) * 2048 + o0); qb1 = *(const LAS h16x8*)(qrow + (h + 3) * 2048 + o1); const float wb2 = WQ[q * 16 + h + 3];
        __builtin_amdgcn_sched_barrier(0);
        DSA_MMACC(lgA, qa0, qa1, lgB, wb);
        wa = wa2; wb = wb2;
    }
    __builtin_amdgcn_sched_barrier(0);
    DSA_MMACC(lgB, qb0, qb1, lgA, wa);
    asm volatile("s_nop 7\n\ts_nop 7" ::: );
    DSA_ACC(lgB, wb);
#undef DSA_MF0
#undef DSA_MF1
#undef DSA_F2
#undef DSA_MMACC
#undef DSA_MM
#undef DSA_ACC
    const int tt0 = w + 32 * grp;
#pragma unroll
    for (int j = 0; j < 4; ++j) { const int tt = tt0 + 8 * j; unsigned c4[4];
#pragma unroll
        for (int r = 0; r < 4; ++r) { const int k = 16 * tt + 4 * kq + r; c4[r] = (tt < ntile && k <= tq) ? sortable_hi16(acc[j][r]) : 0u; }
        c8[j * 2] = c4[0] | (c4[1] << 16); c8[j * 2 + 1] = c4[2] | (c4[3] << 16); }
}

__device__ __forceinline__ void dsa_select_unit(const Params& P, LAS unsigned char* lds, int b, int uq, int stages = 9) {
    int tid = threadIdx.x; asm volatile("" : "+v"(tid));
    const int lane = tid & 63, w = __builtin_amdgcn_readfirstlane(tid >> 6), q = lane & 15, kq = lane >> 4;
    const int t0 = 16 * uq, row0 = b * SEQ + t0, tq = t0 + q, ntile = uq + 1, Kq = (tq + 1 < 256) ? tq + 1 : 256;
    const h16* QIDX = (const h16*)(P.ws + WS_QIDX); const h16* KIDX = (const h16*)(P.ws + WS_KIDX) + (size_t)b * SEQ * 64; const float* WIDX = (const float*)(P.ws + WS_WIDX);
    LAS float* WQ = (LAS float*)(lds + DS_WQ); LAS unsigned* CNTB = (LAS unsigned*)(lds + DS_CNTB); LAS unsigned* CGT = (LAS unsigned*)(lds + DS_CGT); LAS unsigned* CEQ = (LAS unsigned*)(lds + DS_CEQ);
    LAS unsigned* PCNT = (LAS unsigned*)(lds + DS_PCNT); LAS unsigned* TCNT = (LAS unsigned*)(lds + DS_TCNT); LAS unsigned short* TLIST = (LAS unsigned short*)(lds + DS_TLIST);
    LAS float* TSC = (LAS float*)(lds + DS_TSC); LAS unsigned short* LIST = (LAS unsigned short*)(lds + DS_LIST);
    PROF_B(20);
#pragma unroll
    for (int i = 0; i < 4; ++i) { const int pc = 4 * w + i, head = pc >> 1, r = 8 * (pc & 1) + (lane >> 3), c = lane & 7;
        __builtin_amdgcn_global_load_lds((const unsigned*)(QIDX + (size_t)(row0 + r) * 1024 + head * 64 + 8 * (c ^ ((r >> 1) & 7))), (LAS unsigned*)(lds + DS_QI + pc * 1024), 16, 0, 0); }
    {
        const int r = tid >> 5, d2 = tid & 31; float a0 = 0.f, a1 = 0.f;
        const h16* qp = QIDX + (size_t)(row0 + r) * 1024 + 2 * d2; const float* wp = WIDX + (size_t)(row0 + r) * 16;
#pragma unroll
        for (int h = 0; h < 16; ++h) { const h16x2v qv = *(const h16x2v*)(qp + h * 64); const float wv = wp[h]; a0 += wv * (float)qv[0]; a1 += wv * (float)qv[1]; }
        const h16 h0 = (h16)a0, h1 = (h16)a1; const h16 l0 = (h16)(a0 - (float)h0), l1 = (h16)(a1 - (float)h1);
        const unsigned off = r * 128 + 16 * ((unsigned)(d2 >> 2) ^ (unsigned)((r >> 1) & 7)) + 4 * (d2 & 3);
        const h16x2v hv = {h0, h1}, lv = {l0, l1};
        *(LAS h16x2v*)(lds + DS_QI + 16 * 2048 + off) = hv; *(LAS h16x2v*)(lds + DS_QI + 17 * 2048 + off) = lv;
    }
    if (tid < 256) WQ[tid] = WIDX[(size_t)(row0 + (tid >> 4)) * 16 + (tid & 15)];
    if (tid < 16) TCNT[tid] = 0u;
    *(LAS u32x4*)(lds + DS_LIST + tid * 16) = (u32x4){0xFFFFFFFFu, 0xFFFFFFFFu, 0xFFFFFFFFu, 0xFFFFFFFFu};
    asm volatile("s_waitcnt vmcnt(0)" ::: "memory");
    __syncthreads();
    PROF_E(20); PROF_B(21);
    unsigned cs[64];
#pragma unroll
    for (int i = 0; i < 64; ++i) cs[i] = 0u;
    h16x8 kfA[4][2], kfB[4][2];
#define DSA_LOADK(kf, grp_) do { _Pragma("unroll") for (int j = 0; j < 4; ++j) { const int tt = w + 32 * (grp_) + 8 * j, ttc = tt < ntile ? tt : ntile - 1; \
        const h16* kp = KIDX + (size_t)(16 * ttc + q) * 64 + 8 * kq; kf[j][0] = *(const h16x8*)kp; kf[j][1] = *(const h16x8*)(kp + 32); } } while (0)
    DSA_LOADK(kfA, 0);
    for (int gp = 0; gp < 4; ++gp) {
        if (w + 64 * gp >= ntile) break;
        DSA_LOADK(kfB, 2 * gp + 1);
        unsigned ca[8], cb[8];
        dsa_score_group(lds, kfA, 2 * gp, w, q, kq, tq, ntile, ca);
        if (gp < 3) DSA_LOADK(kfA, 2 * gp + 2);
        if (w + 64 * gp + 32 < ntile) dsa_score_group(lds, kfB, 2 * gp + 1, w, q, kq, tq, ntile, cb);
        else {
#pragma unroll
            for (int i = 0; i < 8; ++i) cb[i] = 0u;
        }
#define CS_PUT(G) case G: _Pragma("unroll") for (int i = 0; i < 8; ++i) { cs[G * 16 + i] = ca[i]; cs[G * 16 + 8 + i] = cb[i]; } break;
        switch (gp) { CS_PUT(0) CS_PUT(1) CS_PUT(2) default: _Pragma("unroll") for (int i = 0; i < 8; ++i) { cs[48 + i] = ca[i]; cs[56 + i] = cb[i]; } break; }
#undef CS_PUT
    }
#undef DSA_LOADK
    if (stages < 2) { unsigned x = 0; _Pragma("unroll") for (int i = 0; i < 64; ++i) x ^= cs[i]; asm volatile("" :: "v"(x)); __syncthreads(); return; }
    PROF_E(21); PROF_B(22);
    constexpr int RB_OFF = DS_TK, RB_PITCH = 8208;
    unsigned ks[64];
    const int nj = __builtin_amdgcn_readfirstlane((t0 + 15) / 512 + 1);
#pragma unroll
    for (int i = 0; i < 64; ++i) ks[i] = 0u;
#pragma unroll
    for (int rnd = 0; rnd < 2; ++rnd) {
        if ((q >> 3) == rnd) {
#pragma unroll
            for (int grp = 0; grp < 8; ++grp) if (grp < nj) {
#pragma unroll
                for (int e = 0; e < 8; ++e) { const int i = 8 * grp + e, jj = (i >> 1) & 3; const int key0 = 16 * (w + 32 * grp + 8 * jj) + 4 * kq + 2 * (i & 1);
                    *(LAS unsigned*)(lds + RB_OFF + (q & 7) * RB_PITCH + key0 * 2) = cs[i]; }
            }
        }
        __syncthreads();
        if ((w >> 2) == rnd) {
#pragma unroll
            for (int qi = 0; qi < 2; ++qi)
#pragma unroll
                for (int j = 0; j < 8; ++j) if (j < nj) { const u32x4 v = *(const LAS u32x4*)(lds + RB_OFF + ((2 * w + qi) & 7) * RB_PITCH + (64 * j + lane) * 16);
                    ks[32 * qi + 4 * j] = v.x; ks[32 * qi + 4 * j + 1] = v.y; ks[32 * qi + 4 * j + 2] = v.z; ks[32 * qi + 4 * j + 3] = v.w; }
        }
        __syncthreads();
    }
    PROF_E(22); PROF_B(23);
    if (stages < 3) { unsigned x = 0; _Pragma("unroll") for (int i = 0; i < 64; ++i) x ^= ks[i]; asm volatile("" :: "v"(x)); __syncthreads(); return; }
    unsigned ntieq[2], needq[2], gtq[2];
#pragma unroll
    for (int qi = 0; qi < 2; ++qi) {
        const int ql = 2 * w + qi, K = (t0 + ql + 1 < 256) ? t0 + ql + 1 : 256;
        unsigned thr = 0u;
        for (int bit = 15; bit >= 0; --bit) {
            const unsigned cand = thr | (1u << bit), cm1 = (cand - 1u) * 0x00010001u; unsigned cp0 = 0u, cp1 = 0u, cp2 = 0u, cp3 = 0u;
#pragma unroll
            for (int i = 0; i < 32; i += 4) if ((i >> 2) < nj) { cp0 = pk_count_gt(cp0, ks[32 * qi + i], cm1); cp1 = pk_count_gt(cp1, ks[32 * qi + i + 1], cm1); cp2 = pk_count_gt(cp2, ks[32 * qi + i + 2], cm1); cp3 = pk_count_gt(cp3, ks[32 * qi + i + 3], cm1); }
            const unsigned cp = (cp0 + cp1) + (cp2 + cp3);
            const unsigned tot = wave_sum_u((cp & 0xFFFFu) + (cp >> 16));
            if (tot >= (unsigned)K) thr = cand;
        }
        unsigned mg[2], me[2];
        { const unsigned t0p = thr * 0x00010001u, t1p = (thr - 1u) * 0x00010001u;
#pragma unroll
          for (int m = 0; m < 2; ++m) { unsigned g_ = 0u, e_ = 0u;
              if (4 * m < nj) {
#pragma unroll
                  for (int ii = 0; ii < 16; ++ii) { g_ = pk_mask_gt(g_, ks[32 * qi + 16 * m + ii], t0p); e_ = pk_mask_gt(e_, ks[32 * qi + 16 * m + ii], t1p); } }
              mg[m] = g_; me[m] = e_ & ~g_; } }
        const unsigned cg = __popc(mg[0]) + __popc(mg[1]), ce = __popc(me[0]) + __popc(me[1]);
        unsigned pg = cg, pe = ce;
#pragma unroll
        for (int o = 1; o < 64; o <<= 1) { const unsigned ug = __shfl_up(pg, o), ue = __shfl_up(pe, o); if (lane >= o) { pg += ug; pe += ue; } }
        const unsigned gt_tot = __shfl(pg, 63), eq_tot = __shfl(pe, 63);
        unsigned pos = pg - cg, tpos = pe - ce;
        LAS unsigned short* lq = LIST + ql * 256;
#pragma unroll
        for (int m = 0; m < 2; ++m) {
            unsigned m_ = mg[m];
            while (__builtin_amdgcn_ballot_w64(m_ != 0u) != 0ull) {
                if (m_ != 0u) { const int bt = 31 - __builtin_clz(m_); const int hf = bt >> 4, i = 16 * m + 15 - (bt & 15);
                    lq[pos] = (unsigned short)(512 * (i >> 2) + 8 * lane + 2 * (i & 3) + hf); ++pos; m_ &= ~(1u << bt); }
            }
            unsigned e_ = me[m];
            while (__builtin_amdgcn_ballot_w64(e_ != 0u) != 0ull) {
                if (e_ != 0u) { const int bt = 31 - __builtin_clz(e_); const int hf = bt >> 4, i = 16 * m + 15 - (bt & 15);
                    if (tpos < (unsigned)TIE_CAP) TLIST[ql * TIE_CAP + tpos] = (unsigned short)(512 * (i >> 2) + 8 * lane + 2 * (i & 3) + hf);
                    ++tpos; e_ &= ~(1u << bt); }
            }
        }
        gtq[qi] = gt_tot; needq[qi] = (unsigned)K - gt_tot; ntieq[qi] = eq_tot < (unsigned)TIE_CAP ? eq_tot : (unsigned)TIE_CAP;
    }
    asm volatile("s_waitcnt lgkmcnt(0)" ::: "memory");
    PROF_E(23); PROF_B(24);
    if (stages < 4) { __syncthreads(); return; }
    {
        LAS unsigned char* tk = lds + DS_TK + w * 8192;
        const unsigned nt0 = (unsigned)__builtin_amdgcn_readfirstlane((int)ntieq[0]), nt1 = (unsigned)__builtin_amdgcn_readfirstlane((int)ntieq[1]);
        const unsigned nd0 = (unsigned)__builtin_amdgcn_readfirstlane((int)needq[0]), nd1 = (unsigned)__builtin_amdgcn_readfirstlane((int)needq[1]);
        const unsigned ne0 = (nd0 < nt0) ? nt0 : 0u, ne1 = (nd1 < nt1) ? nt1 : 0u;
        const bool fast = (ne0 <= (unsigned)TIE_FAST) && (ne1 <= (unsigned)TIE_FAST);
        __syncthreads();
        if (fast) {
            u32x4 kr[8];
#pragma unroll
            for (int i = 0; i < 8; ++i) { const int qi = i >> 2, tb = 8 * (i & 3); const unsigned ne = qi ? ne1 : ne0;
                if ((unsigned)tb < ne) { const unsigned ti = tb + (lane >> 3); const unsigned key = (ti < ne) ? TLIST[(2 * w + qi) * TIE_CAP + ti] : 0u;
                    kr[i] = *(const u32x4*)(KIDX + (size_t)key * 64 + 8 * (lane & 7)); } }
#pragma unroll
            for (int i = 0; i < 8; ++i) { const int qi = i >> 2, tb = 8 * (i & 3); const unsigned ne = qi ? ne1 : ne0;
                if ((unsigned)tb < ne) *(LAS u32x4*)(tk + i * 1024 + lane * 16) = kr[i]; }
            asm volatile("s_waitcnt lgkmcnt(0)" ::: "memory");
        }
#pragma unroll
        for (int qi = 0; qi < 2; ++qi) {
            const int ql = 2 * w + qi;
            const unsigned ntie = qi ? nt1 : nt0, ne = qi ? ne1 : ne0, needv = qi ? nd1 : nd0; const unsigned gtv = gtq[qi];
            const unsigned myk = (lane < (int)ntie) ? TLIST[ql * TIE_CAP + lane] : 0xFFFFu;
            if (ne == 0u) {
                if (lane < (int)ntie) LIST[ql * 256 + gtv + lane] = (unsigned short)myk;
            } else {
                const int hh = lane & 15, jj = lane >> 4;
                const LAS unsigned char* qb = lds + DS_QI + hh * 2048 + ql * 128; const unsigned swq = (unsigned)((ql >> 1) & 7);
                const float wh = WQ[ql * 16 + hh];
                h16x8 qv[8];
#pragma unroll
                for (int c = 0; c < 8; ++c) qv[c] = *(const LAS h16x8*)(qb + 16 * ((unsigned)c ^ swq));
                for (unsigned g0 = 0; g0 < ntie; g0 += 8) {
                    float sc2[2];
#pragma unroll
                    for (int u = 0; u < 2; ++u) {
                        const unsigned ti = g0 + 4 * u + jj; const unsigned key = (ti < ntie) ? TLIST[ql * TIE_CAP + ti] : 0u;
                        float dt = 0.f;
#pragma unroll
                        for (int c = 0; c < 8; ++c) {
                            h16x8 kv; if (fast) kv = *(const LAS h16x8*)(tk + qi * 4096 + (ti & 31) * 128 + 16 * c); else kv = *(const h16x8*)(KIDX + (size_t)key * 64 + 8 * c);
#pragma unroll
                            for (int e = 0; e < 8; e += 2) { const h16x2v a = {kv[e], kv[e + 1]}, bq = {qv[c][e], qv[c][e + 1]}; dt = __builtin_amdgcn_fdot2(a, bq, dt, false); } }
                        sc2[u] = wh * fmaxf(dt, 0.f);
                    }
#pragma unroll
                    for (int u = 0; u < 2; ++u) {
                        float sc = sc2[u];
                        sc += __int_as_float(__builtin_amdgcn_update_dpp(0, __float_as_int(sc), 0xB1, 0xF, 0xF, true));
                        sc += __int_as_float(__builtin_amdgcn_update_dpp(0, __float_as_int(sc), 0x4E, 0xF, 0xF, true));
                        sc += __int_as_float(__builtin_amdgcn_update_dpp(0, __float_as_int(sc), 0x141, 0xF, 0xF, true));
                        sc += __int_as_float(__builtin_amdgcn_update_dpp(0, __float_as_int(sc), 0x140, 0xF, 0xF, true));
                        const unsigned ti = g0 + 4 * u + jj;
                        if (hh == 0 && ti < ntie) TSC[ql * TIE_CAP + ti] = sc + 0.0f;
                    }
                }
                asm volatile("s_waitcnt lgkmcnt(0)" ::: "memory");
                const float mys = (lane < (int)ntie) ? TSC[ql * TIE_CAP + lane] : -INFINITY;
                unsigned rank = 0u;
                for (unsigned o = 0; o < ntie; ++o) { const float so = __int_as_float(__builtin_amdgcn_readlane(__float_as_int(mys), (int)o)); const unsigned ko = (unsigned)__builtin_amdgcn_readlane((int)myk, (int)o);
                    rank += (so > mys || (so == mys && ko < myk)) ? 1u : 0u; }
                if (lane < (int)ntie && rank < needv) LIST[ql * 256 + gtv + rank] = (unsigned short)myk;
            }
            if (lane == 0) ((LAS int*)(lds + LDS_SCR + 256))[ql] = (int)(gtv + (needv < ntie ? needv : ntie));
        }
    }
    __syncthreads();
    PROF_E(24);
}

__device__ __forceinline__ unsigned xb_xcc_id();
__device__ __forceinline__ void phase_dsa(const Params& P, LAS unsigned char* lds, int mode) {
    const int tid = threadIdx.x, lane = tid & 63, w = __builtin_amdgcn_readfirstlane(tid >> 6);
    unsigned* tick = (unsigned*)(P.ws + WS_CTL) + 2048 + (mode >> 8) * 64;
    LAS int* wi = (LAS int*)(lds + LDS_SCR + 512);
    const int pref = (int)(xb_xcc_id() >> 1) & 3;
    for (;;) {
        __syncthreads();
        if (tid == 0) { int got = -1;
            for (int a = 0; a < 4 && got < 0; ++a) { const int bb = (pref + a) & 3; const unsigned t = __hip_atomic_fetch_add(tick + bb * 16, 1u, __ATOMIC_RELAXED, __HIP_MEMORY_SCOPE_AGENT); if (t < 64u) got = bb * 64 + (int)t; }
            wi[0] = got; }
        __syncthreads();
        const int item = wi[0];
        if (item < 0) break;
        const int b = item >> 6, j = item & 63;
        for (int ui = 0; ui < 4; ++ui) {
            const int uq = (ui == 0) ? j : (ui == 1) ? 127 - j : (ui == 2) ? 128 + j : 255 - j;
            if (mode & 1) dsa_select_unit(P, lds, b, uq, (mode >> 4) & 15);
            if (mode & 2) for (int qi = 0; qi < 2; ++qi) { const int ql = 2 * w + qi, t = 16 * uq + ql;
                sparse_attn_query(P, lds, w, lane, b, b * SEQ + t, ((const LAS int*)(lds + LDS_SCR + 256))[ql], (const LAS unsigned short*)(lds + DS_LIST) + ql * 256); }
            __syncthreads();
        }
    }
}

#define XB_TMO      128
#define XB_XCNT(j)  (256  + 64 * (j))
#define XB_XSUB(j)  (1280 + 64 * (j))
#define XB_XGEN(j)  (2304 + 64 * (j))
#define XB_TOP      3328
#define XB_TOPGEN   3392
#define XCD_BAR_WORDS 3456
#define XB_SPIN_CAP (1u << 22)
__device__ __forceinline__ unsigned xb_ld(unsigned* p)              { return __hip_atomic_load(p, __ATOMIC_RELAXED, __HIP_MEMORY_SCOPE_AGENT); }
__device__ __forceinline__ unsigned xb_add(unsigned* p, unsigned v) { return __hip_atomic_fetch_add(p, v, __ATOMIC_RELAXED, __HIP_MEMORY_SCOPE_AGENT); }
__device__ __forceinline__ unsigned xb_xcc_id() { return (unsigned)__builtin_amdgcn_s_getreg((3 << 11) | 20) & 0xFu; }
#define XB_SPIN(cond, bar) do { unsigned _sp = 0; while (cond) { __builtin_amdgcn_s_sleep(1); \
    if ((++_sp & 255u) == 0u) { if (xb_ld(&(bar)[XB_TMO])) break; if (_sp > XB_SPIN_CAP) { atomicAdd(&(bar)[XB_TMO], 1u); break; } } } } while (0)
struct XcdBarrier { unsigned* bar; unsigned x; volatile LAS unsigned* st; };
__device__ __forceinline__ XcdBarrier xcd_barrier_post(unsigned* bar, volatile LAS unsigned* st) {
    XcdBarrier b; b.bar = bar; b.x = xb_xcc_id(); b.st = st;
    if (threadIdx.x == 0) (void)xb_add(&bar[XB_XCNT(b.x)], 1u);
    return b;
}
__device__ __forceinline__ void xcd_barrier_complete(unsigned* bar, unsigned x, unsigned& nloc, unsigned& nx) {
    const unsigned G = gridDim.x * gridDim.y * gridDim.z;
    unsigned sum, cnt, mine, sp = 0u;
    for (;;) {
        sum = 0u; cnt = 0u; mine = 0u;
#pragma unroll
        for (unsigned j = 0; j < 16; ++j) { const unsigned c = xb_ld(&bar[XB_XCNT(j)]); sum += c; cnt += (c > 0u) ? 1u : 0u; mine = (j == x) ? c : mine; }
        if (sum == G) break;
        __builtin_amdgcn_s_sleep(1);
        if ((++sp & 255u) == 0u) { if (xb_ld(&bar[XB_TMO])) break; if (sp > XB_SPIN_CAP) { atomicAdd(&bar[XB_TMO], 1u); break; } }
    }
    nloc = mine > 0u ? mine : 1u; nx = cnt > 0u ? cnt : 1u;
}
__device__ __forceinline__ void xcd_barrier(const XcdBarrier& b) {
    asm volatile("s_waitcnt vmcnt(0)" ::: "memory");
    __syncthreads();
    if (threadIdx.x == 0) {
        unsigned* bar = b.bar;
        __builtin_amdgcn_s_waitcnt(0);
        unsigned nloc = b.st[0], nx = b.st[1];
        if (nloc == 0u) { xcd_barrier_complete(bar, b.x, nloc, nx); b.st[0] = nloc; b.st[1] = nx; }
        const unsigned old = xb_add(&bar[XB_XSUB(b.x)], 1u);
        const unsigned gen = old / nloc;
        if (old + 1u == (gen + 1u) * nloc) {
            __builtin_amdgcn_fence(__ATOMIC_RELEASE, "agent");
            asm volatile("s_waitcnt vmcnt(0)" ::: "memory");
            const unsigned og = xb_add(&bar[XB_TOP], 1u);
            const unsigned tg = og / nx;
            if (og + 1u == (tg + 1u) * nx) xb_add(&bar[XB_TOPGEN], 1u);
            else XB_SPIN(xb_ld(&bar[XB_TOPGEN]) == tg, bar);
            __builtin_amdgcn_fence(__ATOMIC_ACQUIRE, "agent");
            xb_add(&bar[XB_XGEN(b.x)], 1u);
            asm volatile("s_waitcnt vmcnt(0)" ::: "memory");
        } else {
            XB_SPIN(xb_ld(&bar[XB_XGEN(b.x)]) == gen, bar);
            __builtin_amdgcn_fence(__ATOMIC_ACQUIRE, "agent");
            asm volatile("s_waitcnt vmcnt(0)" ::: "memory");
        }
    }
    __syncthreads();
}

#ifndef MK_N_LAUNCHES
#define MK_N_LAUNCHES 1
#endif
constexpr int N_PHASES = 8;
extern __shared__ __attribute__((aligned(16))) unsigned char dyn_lds[];
__global__ void __launch_bounds__(NTHR, 2) hybrid_fwd(Params P) {
    LAS unsigned char* lds = (LAS unsigned char*)dyn_lds;
    volatile LAS unsigned* MISC = (volatile LAS unsigned*)(lds + LDS_SCR);
    for (int u = threadIdx.x; u < (LDS_BYTES - LDS_SCR) / 4; u += NTHR) MISC[u] = 0u;
    __syncthreads();
    XcdBarrier bar = xcd_barrier_post((unsigned*)(P.ws + WS_CTL) + 4096 + P.ph_lo * XCD_BAR_WORDS, MISC + 8);
    const int lo = P.ph_lo, hi = P.ph_hi;
#ifndef PHASE_MASK
#define PHASE_MASK 0xFF
#endif
#define IN(k) (((PHASE_MASK >> (k)) & 1) && lo <= (k) && (k) < hi)
#define SEAM(k) do { if (IN(k) && IN((k) + 1)) xcd_barrier(bar); } while (0)
#ifndef REPEAT_MASK
#define REPEAT_MASK 0
#endif
#define REP(k) for (int rep_ = 0; rep_ < 1 + ((REPEAT_MASK >> (k)) & 1); ++rep_, (rep_ < 1 + ((REPEAT_MASK >> (k)) & 1) ? xcd_barrier(bar) : (void)0))
    if (IN(0)) REP(0) phase_prologue(P, lds);
    SEAM(0);
    if (IN(1)) REP(1) phase_h(P, lds);
    SEAM(1);
    if (IN(2)) REP(2) {
        pg8::Gemm g{(const h16*)(P.ws + WS_H), (const h16*)(P.ws + WS_W1T), T, NW1, DM, DM, DM, 0}; pg8::StaticOrder S; S.init(T, NW1, gridDim.x, blockIdx.x);
        EpiProj E{(h16*)(P.ws + WS_CQ), (h16*)(P.ws + WS_KVC), (h16*)(P.ws + WS_SGA), (h16*)(P.ws + WS_QB), (h16*)(P.ws + WS_KB), (h16*)(P.ws + WS_VB), (h16*)(P.ws + WS_SGB),
                  (float*)(P.ws + WS_SMALL), (float*)(P.ws + WS_SSQ), (const float*)(P.ws + WS_ROPE32)};
        pg8::gemm_phase(lds, g, S, E);
    }
    SEAM(2);
    if (IN(3)) {
        phase_rowops(P);
        REP(3) {
        { pg8::Gemm g{(const h16*)(P.ws + WS_CQ), (const h16*)(P.ws + WS_WQT), T, NQ, 512, 512, 512, 0}; pg8::StaticOrder S; S.init(T, NQ, gridDim.x, blockIdx.x);
          EpiQ E{(h16*)(P.ws + WS_QLAT), (h16*)(P.ws + WS_QROPE), (h16*)(P.ws + WS_QIDX), (const float*)(P.ws + WS_SSQ), (const float*)(P.ws + WS_ROPE32), (const float*)(P.ws + WS_ROPE16)};
          pg8::gemm_phase(lds, g, S, E); }
        __syncthreads();
        REP(8) phase_dilated_part(P, lds);
        }
    }
    SEAM(3);
#if DSA_PROBE == 0
    if (IN(4)) { phase_dsa(P, lds, 3 | 0x90); __syncthreads(); REP(4) phase_dilated_last(P, lds); }
#else
    if (IN(4)) { phase_dilated_last(P, lds); xcd_barrier(bar); phase_dsa(P, lds, 3 | 0x90); xcd_barrier(bar); phase_dsa(P, lds, 0x100 | (DSA_PROBE == 1 ? (3 | 0x90) : (1 | ((DSA_PROBE == 6 ? 1 : DSA_PROBE) << 4)))); }
#endif
    SEAM(4);
    if (IN(5)) REP(5) {
        pg8::Gemm g{(const h16*)(P.ws + WS_OLAT), (const h16*)(P.ws + WS_WUVT), T, 1024, 512, 2048, 512, 512}; pg8::StaticOrder S; S.init(T, 1024, gridDim.x, blockIdx.x);
        EpiOA E{(h16*)(P.ws + WS_OAB), (const h16*)(P.ws + WS_SGA)};
        pg8::gemm_phase(lds, g, S, E);
    }
    SEAM(5);
    if (IN(6)) REP(6) {
        pg8::Gemm g{(const h16*)(P.ws + WS_OAB), (const h16*)(P.ws + WS_WOT), T, DM, DM, DM, DM, 0}; pg8::StaticOrder S; S.init(T, DM, gridDim.x, blockIdx.x);
        EpiY E{(h16*)(P.ws + WS_Y), (float*)(P.ws + WS_SSY)};
        pg8::gemm_phase(lds, g, S, E);
    }
    SEAM(6);
    if (IN(7)) REP(7) phase_final(P, lds);
    if (PROF_SEL >= 0 && threadIdx.x == 0) { const unsigned long long t0 = __builtin_amdgcn_s_memrealtime(), d = *(LAS unsigned long long*)(lds + LDS_SCR + 136);
        while (__builtin_amdgcn_s_memrealtime() - t0 < d) __builtin_amdgcn_s_sleep(8); }
#undef IN
#undef SEAM
}

extern "C" void kernel_launch(void* const* d_in, const int* in_sizes, int n_in, void* d_out, int out_size, void* d_ws, size_t ws_size, hipStream_t stream) {
    static int grid = 0;
    if (grid == 0) {
        if (n_in != 14 || in_sizes[0] != T * DM || out_size != T * DM || ws_size < WS_END) { fprintf(stderr, "kernel_launch: unexpected shapes (n_in %d, in0 %d, out %d, ws %zu)\n", n_in, n_in > 0 ? in_sizes[0] : -1, out_size, ws_size); grid = -1; return; }
        int dev = 0, cus = 0, per_cu = 0;
        if (hipGetDevice(&dev) != hipSuccess || hipDeviceGetAttribute(&cus, hipDeviceAttributeMultiprocessorCount, dev) != hipSuccess) { grid = -1; return; }
        if (hipFuncSetAttribute((const void*)hybrid_fwd, hipFuncAttributeMaxDynamicSharedMemorySize, LDS_BYTES) != hipSuccess) { fprintf(stderr, "kernel_launch: hipFuncSetAttribute failed\n"); grid = -1; return; }
        if (hipOccupancyMaxActiveBlocksPerMultiprocessor(&per_cu, (const void*)hybrid_fwd, NTHR, LDS_BYTES) != hipSuccess || per_cu < 1) { fprintf(stderr, "kernel_launch: occupancy query says %d blocks per CU\n", per_cu); }
        (void)hipGetLastError();
        grid = cus;
    }
    if (grid < 0) return;
    (void)hipMemsetAsync((char*)d_ws + WS_CTL, 0, 1 * MiB, stream);
    Params P{};
    P.x = (const float*)d_in[0]; P.c = (const float*)d_in[1]; P.w_ada = (const float*)d_in[2]; P.b_ada = (const float*)d_in[3]; P.g_pre = (const float*)d_in[4]; P.g_post = (const float*)d_in[5];
    P.w_in = (const float*)d_in[6]; P.g_q = (const float*)d_in[7]; P.g_kv = (const float*)d_in[8]; P.w_uq = (const float*)d_in[9]; P.w_uq_idx = (const float*)d_in[10]; P.w_uk = (const float*)d_in[11];
    P.w_uv = (const float*)d_in[12]; P.w_out = (const float*)d_in[13]; P.out = (float*)d_out; P.ws = (unsigned char*)d_ws;
#if MK_N_LAUNCHES == 1
    P.ph_lo = 0; P.ph_hi = N_PHASES;
    hipLaunchKernelGGL(hybrid_fwd, dim3(grid), dim3(NTHR), LDS_BYTES, stream, P);
#else
    for (int k = 0; k < N_PHASES; ++k) { P.ph_lo = k; P.ph_hi = k + 1; hipLaunchKernelGGL(hybrid_fwd, dim3(grid), dim3(NTHR), LDS_BYTES, stream, P); }
#endif
}
```
